# Optimizing an MI355X kernel written in HIP

```python
import math
import jax, jax.numpy as jnp
from jax import lax
import numpy as np

D_MODEL = 1024
BATCH = 4
SEQ = 8192
DEPTH = 2

GRID_W = 64
CTX_LEN = 256
ROPE_THETA = 10000.0
NORM_EPS = 1e-6
NEG_INF = -1e30
Q_BLOCK = 128

HEAD_DIM = 64
A_HEADS = 8
A_KV_HEADS = 2
B_HEADS = 8
B_KV_HEADS = 2
WINDOW = 128
A_Q_W = A_HEADS * HEAD_DIM
A_KV_W = A_KV_HEADS * HEAD_DIM
B_Q_W = B_HEADS * HEAD_DIM
B_KV_W = B_KV_HEADS * HEAD_DIM
EVEN_WIDTHS = (A_Q_W, A_KV_W, A_KV_W, B_Q_W, B_KV_W, B_KV_W)
EVEN_IN_W = sum(EVEN_WIDTHS)
EVEN_OUT_W = (A_HEADS + B_HEADS) * HEAD_DIM

C_HEADS = 8
C_Q_LORA = 384
C_KV_LORA = 256
C_NOPE = 128
C_ROPE = 64
C_V = 128
C_IN_W = C_Q_LORA + C_KV_LORA + C_ROPE

PEER_HEADS = 8
PEER_KEYS = 128
PEER_EXPERTS = PEER_KEYS * PEER_KEYS
PEER_KEY_DIM = 256
PEER_TOPK = 16
PEER_BLOCK = 128

N_EVEN = (DEPTH + 1) // 2
N_ODD = DEPTH // 2

kernel_name = "hybrid_gqa_swa_mla_peer_prefix_dit"


def rmsnorm(x, g):
    xf = x.astype(jnp.float32)
    y = xf * lax.rsqrt(jnp.mean(xf * xf, axis=-1, keepdims=True) + NORM_EPS)
    return (y * g.astype(jnp.float32)).astype(x.dtype)


def modulate(h, shift, scale):
    return h * (1.0 + scale) + shift


def axial_rope_tables(rows, rot_dim):
    row = jnp.repeat(jnp.arange(rows, dtype=jnp.float32), GRID_W)
    col = jnp.tile(jnp.arange(GRID_W, dtype=jnp.float32), rows)
    half = rot_dim // 2
    inv = ROPE_THETA ** (-jnp.arange(0, half, 2, dtype=jnp.float32) / half)
    ang = jnp.concatenate([row[:, None] * inv, col[:, None] * inv], axis=-1)
    return jnp.cos(ang), jnp.sin(ang)


def apply_rope(x, cos, sin):
    xf = x.astype(jnp.float32)
    x1, x2 = xf[..., 0::2], xf[..., 1::2]
    cs, sn = cos[None, :, None, :], sin[None, :, None, :]
    out = jnp.stack([x1 * cs - x2 * sn, x1 * sn + x2 * cs], axis=-1).reshape(x.shape)
    return out.astype(x.dtype)


def attend(q, k, v, scale, mask=None, sink=None):
    B, Tq, Hq, dq = q.shape
    Hkv = k.shape[2]
    G = Hq // Hkv
    qg = q.reshape(B, Tq, Hkv, G, dq).astype(jnp.float32)
    s = jnp.einsum('bqhgd,bkhd->bhgqk', qg, k.astype(jnp.float32)) * scale
    if mask is not None:
        s = jnp.where(mask, s, NEG_INF)
    if sink is not None:
        sk = jnp.broadcast_to(sink.astype(jnp.float32).reshape(1, Hkv, G, 1, 1), s.shape[:-1] + (1,))
        s = jnp.concatenate([sk, s], axis=-1)
    p = jax.nn.softmax(s, axis=-1)
    if sink is not None:
        p = p[..., 1:]
    o = jnp.einsum('bhgqk,bkhd->bqhgd', p, v.astype(jnp.float32))
    return o.reshape(B, Tq, Hq, v.shape[-1]).astype(q.dtype)


def blocked_global(q, k, v, scale):
    B, S, Hq, dq = q.shape
    nb = S // Q_BLOCK
    qb = q.reshape(B, nb, Q_BLOCK, Hq, dq).swapaxes(0, 1)
    ob = lax.map(lambda qi: attend(qi, k, v, scale), qb)
    return ob.swapaxes(0, 1).reshape(B, S, Hq, v.shape[-1])


def blocked_window(q, k_lat, v_lat, k_ctx, v_ctx, sink, scale):
    B, S, Hq, dq = q.shape
    nb = S // Q_BLOCK
    span = Q_BLOCK + 2 * WINDOW
    n_ctx = k_ctx.shape[1]
    pad = ((0, 0), (WINDOW, WINDOW), (0, 0), (0, 0))
    kp, vp = jnp.pad(k_lat, pad), jnp.pad(v_lat, pad)
    qb = q.reshape(B, nb, Q_BLOCK, Hq, dq).swapaxes(0, 1)

    def one(args):
        i, qi = args
        start = i * Q_BLOCK
        kw = lax.dynamic_slice_in_dim(kp, start, span, axis=1)
        vw = lax.dynamic_slice_in_dim(vp, start, span, axis=1)
        q_t = start + jnp.arange(Q_BLOCK)
        k_t = start - WINDOW + jnp.arange(span)
        band = ((jnp.abs(k_t[None, :] - q_t[:, None]) <= WINDOW)
                & (k_t[None, :] >= 0) & (k_t[None, :] < S))
        mask = jnp.concatenate([jnp.ones((Q_BLOCK, n_ctx), dtype=bool), band], axis=1)
        return attend(qi, jnp.concatenate([k_ctx, kw], axis=1),
                      jnp.concatenate([v_ctx, vw], axis=1), scale, mask, sink)

    ob = lax.map(one, (jnp.arange(nb), qb))
    return ob.swapaxes(0, 1).reshape(B, S, Hq, v_lat.shape[-1])


def even_heads(h, w_in, a_qn, a_kn, b_qn, b_kn, rope):
    B, T, _ = h.shape
    offsets = np.cumsum(EVEN_WIDTHS)[:-1].tolist()
    aq, ak, av, bq, bk, bv = jnp.split(h @ w_in, offsets, axis=-1)
    heads = lambda t, n: t.reshape(B, T, n, HEAD_DIM)
    aq, ak = rmsnorm(heads(aq, A_HEADS), a_qn), rmsnorm(heads(ak, A_KV_HEADS), a_kn)
    bq, bk = rmsnorm(heads(bq, B_HEADS), b_qn), rmsnorm(heads(bk, B_KV_HEADS), b_kn)
    av, bv = heads(av, A_KV_HEADS), heads(bv, B_KV_HEADS)
    if rope is not None:
        aq, ak, bq, bk = (apply_rope(t, *rope) for t in (aq, ak, bq, bk))
    return aq, ak, av, bq, bk, bv


def mixer_even(h_ctx, h_lat, w_in, w_out, a_qn, a_kn, b_qn, b_kn, b_sink, rope, ctx_out):
    caq, cak, cav, cbq, cbk, cbv = even_heads(h_ctx, w_in, a_qn, a_kn, b_qn, b_kn, None)
    laq, lak, lav, lbq, lbk, lbv = even_heads(h_lat, w_in, a_qn, a_kn, b_qn, b_kn, rope)
    scale = HEAD_DIM ** -0.5
    B, S = h_lat.shape[:2]
    oa = blocked_global(laq, jnp.concatenate([cak, lak], axis=1),
                        jnp.concatenate([cav, lav], axis=1), scale)
    ob = blocked_window(lbq, lbk, lbv, cbk, cbv, b_sink, scale)
    o_lat = jnp.concatenate([oa.reshape(B, S, A_Q_W), ob.reshape(B, S, B_Q_W)], axis=-1) @ w_out
    o_ctx = None
    if ctx_out:
        T = h_ctx.shape[1]
        oa_c = attend(caq, cak, cav, scale)
        ob_c = attend(cbq, cbk, cbv, scale, sink=b_sink)
        o_ctx = jnp.concatenate([oa_c.reshape(B, T, A_Q_W), ob_c.reshape(B, T, B_Q_W)], axis=-1) @ w_out
    return o_ctx, o_lat


def mla_heads(h, w_in, q_a_norm, kv_a_norm, w_uq, w_ukv, qn_nope, qn_rope, kn_nope, kn_rope, rope):
    B, T, _ = h.shape
    p = h @ w_in
    cq = rmsnorm(p[..., :C_Q_LORA], q_a_norm)
    ckv = rmsnorm(p[..., C_Q_LORA:C_Q_LORA + C_KV_LORA], kv_a_norm)
    k_pe = rmsnorm(p[..., C_Q_LORA + C_KV_LORA:].reshape(B, T, 1, C_ROPE), kn_rope)
    q = (cq @ w_uq).reshape(B, T, C_HEADS, C_NOPE + C_ROPE)
    kv = (ckv @ w_ukv).reshape(B, T, C_HEADS, C_NOPE + C_V)
    q_nope, q_pe = rmsnorm(q[..., :C_NOPE], qn_nope), rmsnorm(q[..., C_NOPE:], qn_rope)
    k_nope, v = rmsnorm(kv[..., :C_NOPE], kn_nope), kv[..., C_NOPE:]
    if rope is not None:
        q_pe, k_pe = apply_rope(q_pe, *rope), apply_rope(k_pe, *rope)
    q = jnp.concatenate([q_nope, q_pe], axis=-1)
    k = jnp.concatenate([k_nope, jnp.broadcast_to(k_pe, (B, T, C_HEADS, C_ROPE))], axis=-1)
    return q, k, v


def mixer_mla(h_ctx, h_lat, w_in, q_a_norm, kv_a_norm, w_uq, w_ukv,
              qn_nope, qn_rope, kn_nope, kn_rope, w_out, rope, ctx_out):
    args = (w_in, q_a_norm, kv_a_norm, w_uq, w_ukv, qn_nope, qn_rope, kn_nope, kn_rope)
    cq, ck, cv = mla_heads(h_ctx, *args, None)
    lq, lk, lv = mla_heads(h_lat, *args, rope)
    scale = (C_NOPE + C_ROPE) ** -0.5
    B, S = h_lat.shape[:2]
    o_lat = blocked_global(lq, jnp.concatenate([ck, lk], axis=1),
                           jnp.concatenate([cv, lv], axis=1), scale)
    o_lat = o_lat.reshape(B, S, C_HEADS * C_V) @ w_out
    o_ctx = None
    if ctx_out:
        o_ctx = attend(cq, ck, cv, scale).reshape(B, h_ctx.shape[1], C_HEADS * C_V) @ w_out
    return o_ctx, o_lat


def peer_ffn(h, w_query, sub_keys, expert_u, expert_v):
    B, T, D = h.shape
    tokens = h.reshape(-1, PEER_BLOCK, D)

    def block(hb):
        q = (hb @ w_query).reshape(PEER_BLOCK, PEER_HEADS, 2, PEER_KEY_DIM // 2)
        s = jnp.einsum('thpk,hpnk->thpn', q.astype(jnp.float32), sub_keys.astype(jnp.float32))
        s_top, i_top = lax.top_k(s, PEER_TOPK)
        cand = (s_top[:, :, 0, :, None] + s_top[:, :, 1, None, :]).reshape(PEER_BLOCK, PEER_HEADS, -1)
        cand_idx = (i_top[:, :, 0, :, None] * PEER_KEYS + i_top[:, :, 1, None, :]).reshape(PEER_BLOCK, PEER_HEADS, -1)
        best, pos = lax.top_k(cand, PEER_TOPK)
        expert = jnp.take_along_axis(cand_idx, pos, axis=-1)
        g = jax.nn.softmax(best, axis=-1)
        u = expert_u[expert]
        v = expert_v[expert]
        a = jax.nn.gelu(jnp.einsum('td,thkd->thk', hb, u).astype(jnp.float32), approximate=False)
        return jnp.einsum('thk,thkd->td', (g * a).astype(hb.dtype), v)

    return lax.map(block, tokens).reshape(B, T, D)


def setup_inputs(seed: int = 0) -> dict:
    key = jax.random.key(seed)
    ks = iter(jax.random.split(key, 40))
    nrm = lambda shape, s: jax.random.normal(next(ks), shape, jnp.float32) * s
    gain = lambda shape: 1.0 + nrm(shape, 0.05)
    D = D_MODEL
    return {
        "x": nrm((BATCH, SEQ, D), 1.0),
        "c": nrm((BATCH, D), 1.0),
        "ctx": nrm((BATCH, CTX_LEN, D), 1.0),
        "c_ctx": nrm((D,), 1.0),
        "mod_w": nrm((DEPTH, D, 6 * D), D ** -0.5),
        "mod_b": nrm((DEPTH, 6 * D), 0.02),
        "mix_norm": gain((DEPTH, D)),
        "ffn_norm": gain((DEPTH, D)),
        "even_w_in": nrm((N_EVEN, D, EVEN_IN_W), D ** -0.5),
        "even_w_out": nrm((N_EVEN, EVEN_OUT_W, D), EVEN_OUT_W ** -0.5),
        "a_q_norm": gain((N_EVEN, HEAD_DIM)),
        "a_k_norm": gain((N_EVEN, HEAD_DIM)),
        "b_q_norm": gain((N_EVEN, HEAD_DIM)),
        "b_k_norm": gain((N_EVEN, HEAD_DIM)),
        "b_sink": nrm((N_EVEN, B_HEADS), 0.5),
        "mla_w_in": nrm((N_ODD, D, C_IN_W), D ** -0.5),
        "mla_q_a_norm": gain((N_ODD, C_Q_LORA)),
        "mla_kv_a_norm": gain((N_ODD, C_KV_LORA)),
        "mla_w_uq": nrm((N_ODD, C_Q_LORA, C_HEADS * (C_NOPE + C_ROPE)), C_Q_LORA ** -0.5),
        "mla_w_ukv": nrm((N_ODD, C_KV_LORA, C_HEADS * (C_NOPE + C_V)), C_KV_LORA ** -0.5),
        "mla_q_nope_norm": gain((N_ODD, C_NOPE)),
        "mla_q_rope_norm": gain((N_ODD, C_ROPE)),
        "mla_k_nope_norm": gain((N_ODD, C_NOPE)),
        "mla_k_rope_norm": gain((N_ODD, C_ROPE)),
        "mla_w_out": nrm((N_ODD, C_HEADS * C_V, D), (C_HEADS * C_V) ** -0.5),
        "peer_w_query": nrm((DEPTH, D, PEER_HEADS * PEER_KEY_DIM), D ** -0.5),
        "peer_sub_keys": nrm((DEPTH, PEER_HEADS, 2, PEER_KEYS, PEER_KEY_DIM // 2), (PEER_KEY_DIM // 2) ** -0.5),
        "peer_u": nrm((DEPTH, PEER_EXPERTS, D), D ** -0.5),
        "peer_v": nrm((DEPTH, PEER_EXPERTS, D), PEER_HEADS ** -0.5),
    }


def reference(x, c, ctx, c_ctx, mod_w, mod_b, mix_norm, ffn_norm,
              even_w_in, even_w_out, a_q_norm, a_k_norm, b_q_norm, b_k_norm, b_sink,
              mla_w_in, mla_q_a_norm, mla_kv_a_norm, mla_w_uq, mla_w_ukv,
              mla_q_nope_norm, mla_q_rope_norm, mla_k_nope_norm, mla_k_rope_norm, mla_w_out,
              peer_w_query, peer_sub_keys, peer_u, peer_v):
    n_lat = x.shape[1]
    rows = n_lat // GRID_W
    rope_attn = axial_rope_tables(rows, HEAD_DIM)
    rope_mla = axial_rope_tables(rows, C_ROPE)
    for l in range(DEPTH):
        ctx_out = l < DEPTH - 1
        lat_mod = [m[:, None, :] for m in jnp.split(jax.nn.silu(c) @ mod_w[l] + mod_b[l], 6, axis=-1)]
        ctx_mod = jnp.split(jax.nn.silu(c_ctx) @ mod_w[l] + mod_b[l], 6, axis=-1)
        h_lat = modulate(rmsnorm(x, mix_norm[l]), lat_mod[0], lat_mod[1])
        h_ctx = modulate(rmsnorm(ctx, mix_norm[l]), ctx_mod[0], ctx_mod[1])
        if l % 2 == 0:
            e = l // 2
            o_ctx, o_lat = mixer_even(h_ctx, h_lat, even_w_in[e], even_w_out[e], a_q_norm[e], a_k_norm[e],
                                      b_q_norm[e], b_k_norm[e], b_sink[e], rope_attn, ctx_out)
        else:
            o = l // 2
            o_ctx, o_lat = mixer_mla(h_ctx, h_lat, mla_w_in[o], mla_q_a_norm[o], mla_kv_a_norm[o],
                                     mla_w_uq[o], mla_w_ukv[o], mla_q_nope_norm[o], mla_q_rope_norm[o],
                                     mla_k_nope_norm[o], mla_k_rope_norm[o], mla_w_out[o], rope_mla, ctx_out)
        x = x + lat_mod[2] * o_lat
        x = x + lat_mod[5] * peer_ffn(modulate(rmsnorm(x, ffn_norm[l]), lat_mod[3], lat_mod[4]),
                                      peer_w_query[l], peer_sub_keys[l], peer_u[l], peer_v[l])
        if ctx_out:
            ctx = ctx + ctx_mod[2] * o_ctx
            ctx = ctx + ctx_mod[5] * peer_ffn(modulate(rmsnorm(ctx, ffn_norm[l]), ctx_mod[3], ctx_mod[4]),
                                              peer_w_query[l], peer_sub_keys[l], peer_u[l], peer_v[l])
    return x
```

```cpp
#include <hip/hip_runtime.h>
#include <stdint.h>

typedef __bf16 bf16;
typedef __bf16 bf16x8 __attribute__((ext_vector_type(8)));
typedef __bf16 bf16x4 __attribute__((ext_vector_type(4)));
typedef __bf16 bf16x2 __attribute__((ext_vector_type(2)));
typedef float f32x16 __attribute__((ext_vector_type(16)));
typedef unsigned u32x4 __attribute__((ext_vector_type(4)));
#define LAS __attribute__((address_space(3)))
#define DI __device__ __forceinline__

constexpr int DM = 1024, NB = 4, SEQ = 8192, NCX = 256;
constexpr int NLAT = NB * SEQ, NCTXT = NB * NCX, NTOK = NLAT + NCTXT, NKEY = SEQ + NCX;
constexpr float EPS = 1e-6f;
constexpr float LOG2E = 1.4426950408889634f;

DI int crow(int i, int h) { return (i & 3) + 8 * (i >> 2) + 4 * h; }
DI f32x16 mfma32(bf16x8 a, bf16x8 b, f32x16 c) { return __builtin_amdgcn_mfma_f32_32x32x16_bf16(a, b, c, 0, 0, 0); }
DI float silu(float v) { return v / (1.f + __expf(-v)); }

__global__ __launch_bounds__(256) void mod_kernel(const float* __restrict__ c, const float* __restrict__ c_ctx,
                                                  const float* __restrict__ mod_w, const float* __restrict__ mod_b,
                                                  float* __restrict__ mod) {
  __shared__ float sv[5][1024];
  __shared__ float part[4][5][64];
  const int tid = threadIdx.x, l = blockIdx.y;
  for (int i = tid; i < 5 * 1024; i += 256) {
    const int b = i >> 10, k = i & 1023;
    const float v = b < 4 ? c[b * 1024 + k] : c_ctx[k];
    sv[b][k] = silu(v);
  }
  __syncthreads();
  const int nn = tid & 63, kg = tid >> 6;
  const int n = blockIdx.x * 64 + nn;
  const float* w = mod_w + (size_t)l * 1024 * 6144 + n;
  float a0 = 0, a1 = 0, a2 = 0, a3 = 0, a4 = 0;
  for (int k = kg * 256; k < kg * 256 + 256; ++k) {
    const float wv = w[(size_t)k * 6144];
    a0 += sv[0][k] * wv; a1 += sv[1][k] * wv; a2 += sv[2][k] * wv; a3 += sv[3][k] * wv; a4 += sv[4][k] * wv;
  }
  part[kg][0][nn] = a0; part[kg][1][nn] = a1; part[kg][2][nn] = a2; part[kg][3][nn] = a3; part[kg][4][nn] = a4;
  __syncthreads();
  for (int i = tid; i < 5 * 64; i += 256) {
    const int b = i >> 6, j = i & 63;
    const float s = part[0][b][j] + part[1][b][j] + part[2][b][j] + part[3][b][j];
    mod[((size_t)l * 5 + b) * 6144 + blockIdx.x * 64 + j] = s + mod_b[(size_t)l * 6144 + blockIdx.x * 64 + j];
  }
}

__global__ void rope_kernel(float* __restrict__ cs, float* __restrict__ sn) {
  const int idx = blockIdx.x * blockDim.x + threadIdx.x;
  if (idx >= SEQ * 32) return;
  const int t = idx >> 5, i = idx & 31;
  const int row = t >> 6, col = t & 63;
  const int fi = i & 15;
  const float inv = powf(10000.f, -(float)(2 * fi) / 32.f);
  const float ang = (i < 16 ? (float)row : (float)col) * inv;
  cs[idx] = cosf(ang);
  sn[idx] = sinf(ang);
}

__global__ void transpose_convert_kernel(const float* __restrict__ W, bf16* __restrict__ Wt, int K, int N, int Npad) {
  __shared__ float tile[32][33];
  const int tx = threadIdx.x, ty = threadIdx.y;
  const int n0 = blockIdx.x * 32, k0 = blockIdx.y * 32;
  for (int j = ty; j < 32; j += 8) {
    const int k = k0 + j, n = n0 + tx;
    tile[j][tx] = (n < N) ? W[(size_t)k * N + n] : 0.f;
  }
  __syncthreads();
  for (int j = ty; j < 32; j += 8) {
    const int n = n0 + j, k = k0 + tx;
    Wt[(size_t)n * K + k] = (bf16)tile[tx][j];
  }
}

__global__ void convert_kernel(const float4* __restrict__ src, bf16x4* __restrict__ dst, size_t n4) {
  for (size_t i = blockIdx.x * (size_t)blockDim.x + threadIdx.x; i < n4; i += (size_t)gridDim.x * blockDim.x) {
    const float4 v = src[i];
    bf16x4 o; o[0] = (bf16)v.x; o[1] = (bf16)v.y; o[2] = (bf16)v.z; o[3] = (bf16)v.w;
    dst[i] = o;
  }
}

__global__ __launch_bounds__(256) void norm_mod_kernel(const float* __restrict__ src_lat, const float* __restrict__ src_ctx,
                                                       const float* __restrict__ gain, const float* __restrict__ modl, int chunk,
                                                       bf16* __restrict__ H) {
  __shared__ float red[4];
  const int row = blockIdx.x, tid = threadIdx.x;
  const float* src; int b;
  if (row < NLAT) { src = src_lat + (size_t)row * DM; b = row / SEQ; } else { src = src_ctx + (size_t)(row - NLAT) * DM; b = 4; }
  const float4 v = ((const float4*)src)[tid];
  float ss = v.x * v.x + v.y * v.y + v.z * v.z + v.w * v.w;
  for (int o = 32; o > 0; o >>= 1) ss += __shfl_xor(ss, o);
  if ((tid & 63) == 0) red[tid >> 6] = ss;
  __syncthreads();
  ss = red[0] + red[1] + red[2] + red[3];
  const float rs = rsqrtf(ss * (1.f / DM) + EPS);
  const float4 g = ((const float4*)gain)[tid];
  const float4 sh = ((const float4*)(modl + (size_t)b * 6144 + chunk * 1024))[tid];
  const float4 sc = ((const float4*)(modl + (size_t)b * 6144 + (chunk + 1) * 1024))[tid];
  bf16x4 o;
  o[0] = (bf16)(v.x * rs * g.x * (1.f + sc.x) + sh.x);
  o[1] = (bf16)(v.y * rs * g.y * (1.f + sc.y) + sh.y);
  o[2] = (bf16)(v.z * rs * g.z * (1.f + sc.z) + sh.z);
  o[3] = (bf16)(v.w * rs * g.w * (1.f + sc.w) + sh.w);
  ((bf16x4*)(H + (size_t)row * DM))[tid] = o;
}

constexpr int GBM = 128, GBN = 128, GBK = 64, GLD = 72;
enum { EPI_BF16 = 0, EPI_RESID = 1 };
struct GemmEpi {
  bf16* Cb; int ldc; int rowmap;
  float* out_lat; const float* res_lat; float* out_ctx; const float* res_ctx; const float* modl; int gchunk;
};

template <int EPI>
__global__ __launch_bounds__(256, 2) void gemm_kernel(const bf16* __restrict__ A, int lda, const bf16* __restrict__ Bt, int K, GemmEpi e) {
  __shared__ __attribute__((aligned(16))) bf16 As[2][GBM * GLD];
  __shared__ __attribute__((aligned(16))) bf16 Bs[2][GBN * GLD];
  const int tid = threadIdx.x, lane = tid & 63, wave = tid >> 6, wm = wave >> 1, wn = wave & 1;
  const int r = lane & 31, h = lane >> 5;
  const int m0 = blockIdx.y * GBM, n0 = blockIdx.x * GBN;
  const int sc = tid & 7, sr = tid >> 3;
  const bf16* Ag = A + (size_t)(m0 + sr) * lda + sc * 8;
  const bf16* Bg = Bt + (size_t)(n0 + sr) * K + sc * 8;
  u32x4 ra[4], rb[4];
  f32x16 acc[2][2];
#pragma unroll
  for (int i = 0; i < 2; ++i)
#pragma unroll
    for (int j = 0; j < 2; ++j)
#pragma unroll
      for (int q = 0; q < 16; ++q) acc[i][j][q] = 0.f;
  const int nt = K / GBK;
#pragma unroll
  for (int i = 0; i < 4; ++i) { ra[i] = *(const u32x4*)(Ag + (size_t)i * 32 * lda); rb[i] = *(const u32x4*)(Bg + (size_t)i * 32 * K); }
#pragma unroll
  for (int i = 0; i < 4; ++i) { *(u32x4*)(&As[0][(sr + 32 * i) * GLD + sc * 8]) = ra[i]; *(u32x4*)(&Bs[0][(sr + 32 * i) * GLD + sc * 8]) = rb[i]; }
  __syncthreads();
  for (int t = 0; t < nt; ++t) {
    if (t + 1 < nt) {
#pragma unroll
      for (int i = 0; i < 4; ++i) {
        ra[i] = *(const u32x4*)(Ag + (size_t)i * 32 * lda + (t + 1) * GBK);
        rb[i] = *(const u32x4*)(Bg + (size_t)i * 32 * K + (t + 1) * GBK);
      }
    }
    const bf16* as = &As[t & 1][(wm * 64 + r) * GLD + 8 * h];
    const bf16* bs = &Bs[t & 1][(wn * 64 + r) * GLD + 8 * h];
#pragma unroll
    for (int ks = 0; ks < 4; ++ks) {
      const bf16x8 a0 = *(const bf16x8*)(as + ks * 16), a1 = *(const bf16x8*)(as + 32 * GLD + ks * 16);
      const bf16x8 b0 = *(const bf16x8*)(bs + ks * 16), b1 = *(const bf16x8*)(bs + 32 * GLD + ks * 16);
      acc[0][0] = mfma32(a0, b0, acc[0][0]);
      acc[0][1] = mfma32(a0, b1, acc[0][1]);
      acc[1][0] = mfma32(a1, b0, acc[1][0]);
      acc[1][1] = mfma32(a1, b1, acc[1][1]);
    }
    if (t + 1 < nt) {
      const int nb = (t + 1) & 1;
#pragma unroll
      for (int i = 0; i < 4; ++i) { *(u32x4*)(&As[nb][(sr + 32 * i) * GLD + sc * 8]) = ra[i]; *(u32x4*)(&Bs[nb][(sr + 32 * i) * GLD + sc * 8]) = rb[i]; }
    }
    __syncthreads();
  }
#pragma unroll
  for (int mi = 0; mi < 2; ++mi)
#pragma unroll
    for (int ni = 0; ni < 2; ++ni)
#pragma unroll
      for (int i = 0; i < 16; ++i) {
        const int row = m0 + wm * 64 + mi * 32 + crow(i, h);
        const int col = n0 + wn * 64 + ni * 32 + r;
        const float v = acc[mi][ni][i];
        if constexpr (EPI == EPI_BF16) {
          int orow = row;
          if (e.rowmap) orow = row < NLAT ? (row / SEQ) * NKEY + NCX + (row % SEQ) : ((row - NLAT) / NCX) * NKEY + ((row - NLAT) % NCX);
          e.Cb[(size_t)orow * e.ldc + col] = (bf16)v;
        } else {
          if (row < NLAT) {
            const int b = row / SEQ;
            const float g = e.modl[(size_t)b * 6144 + e.gchunk * 1024 + col];
            e.out_lat[(size_t)row * DM + col] = e.res_lat[(size_t)row * DM + col] + g * v;
          } else {
            const int rc = row - NLAT;
            const float g = e.modl[(size_t)4 * 6144 + e.gchunk * 1024 + col];
            e.out_ctx[(size_t)rc * DM + col] = e.res_ctx[(size_t)rc * DM + col] + g * v;
          }
        }
      }
}

struct Post0 {
  const bf16* P;
  const float *aqn, *akn, *bqn, *bkn, *cs, *sn;
  bf16 *QA, *QB, *CQA, *CQB, *KA, *VA, *KB, *VB;
};
__global__ __launch_bounds__(768) void qkv_post0_kernel(Post0 p) {
  const int row = blockIdx.x, i = threadIdx.x;
  const int slot = i >> 5, pi = i & 31;
  const bf16x2 pv = *(const bf16x2*)(p.P + (size_t)row * 1536 + slot * 64 + 2 * pi);
  float v0 = (float)pv[0], v1 = (float)pv[1];
  const bool lat = row < NLAT;
  int b, t;
  if (lat) { b = row / SEQ; t = row % SEQ; } else { const int rc = row - NLAT; b = rc / NCX; t = rc % NCX; }
  const int key = lat ? NCX + t : t;
  const bool isv = (slot == 10 || slot == 11 || slot == 22 || slot == 23);
  if (!isv) {
    float ss = v0 * v0 + v1 * v1;
    for (int o = 16; o > 0; o >>= 1) ss += __shfl_xor(ss, o);
    const float rs = rsqrtf(ss * (1.f / 64.f) + EPS);
    const float* g = slot < 8 ? p.aqn : slot < 10 ? p.akn : slot < 20 ? p.bqn : p.bkn;
    v0 = v0 * rs * g[2 * pi]; v1 = v1 * rs * g[2 * pi + 1];
    if (lat) {
      const float c = p.cs[t * 32 + pi], s = p.sn[t * 32 + pi];
      const float o0 = v0 * c - v1 * s, o1 = v0 * s + v1 * c;
      v0 = o0; v1 = o1;
    }
  }
  bf16x2 ov; ov[0] = (bf16)v0; ov[1] = (bf16)v1;
  bf16* dst;
  if (slot < 8) dst = lat ? p.QA + ((size_t)(b * 8 + slot) * SEQ + t) * 64 : p.CQA + ((size_t)(b * 8 + slot) * NCX + t) * 64;
  else if (slot < 10) dst = p.KA + ((size_t)(b * 2 + slot - 8) * NKEY + key) * 64;
  else if (slot < 12) dst = p.VA + ((size_t)(b * 2 + slot - 10) * NKEY + key) * 64;
  else if (slot < 20) dst = lat ? p.QB + ((size_t)(b * 8 + slot - 12) * SEQ + t) * 64 : p.CQB + ((size_t)(b * 8 + slot - 12) * NCX + t) * 64;
  else if (slot < 22) dst = p.KB + ((size_t)(b * 2 + slot - 20) * NKEY + key) * 64;
  else dst = p.VB + ((size_t)(b * 2 + slot - 22) * NKEY + key) * 64;
  *(bf16x2*)(dst + 2 * pi) = ov;
}

struct AttnParams {
  const bf16* Q; long q_bs, q_hs; int q_ts;
  const bf16* K; long k_bs, k_hs; int k_ts;
  const bf16* K2; long k2_bs; int k2_ts;
  const bf16* V; long v_bs, v_hs; int v_ts;
  bf16* O; int o_row0, o_bs, o_col0;
  const float* sink;
  int nkeys;
  int G;
  int window;
  float scale_log2;
};

template <int DQK, int DV, int DSPLIT>
__global__ __launch_bounds__(256, 2) void attn_kernel(AttnParams p) {
  constexpr int KLD = DQK + 8, VLD = DV + 32;
  constexpr int KCH = DQK / 8, VCH = DV / 8;
  constexpr int KPT = 64 * KCH / 256, VPT = 64 * VCH / 256;
  constexpr int NKS = DQK / 16, NDB = DV / 32;
  __shared__ __attribute__((aligned(16))) bf16 Ks[64 * KLD];
  __shared__ __attribute__((aligned(16))) bf16 Vs[64 * VLD];
  const int tid = threadIdx.x, lane = tid & 63, wave = tid >> 6;
  const int r = lane & 31, h = lane >> 5;
  const int q0 = blockIdx.x * 128, head = blockIdx.y, b = blockIdx.z;
  const int hkv = head / p.G;
  const int tq = q0 + wave * 32 + r;

  bf16x8 qf[NKS];
  {
    const bf16* qp = p.Q + (size_t)b * p.q_bs + (size_t)head * p.q_hs + (size_t)tq * p.q_ts + 8 * h;
#pragma unroll
    for (int ks = 0; ks < NKS; ++ks) qf[ks] = *(const bf16x8*)(qp + ks * 16);
  }
  int ntiles, lo = 0;
  if (p.window) {
    lo = q0 - 128 < 0 ? 0 : q0 - 128;
    const int hi = q0 + 256 > SEQ ? SEQ : q0 + 256;
    ntiles = 4 + (hi - lo) / 64;
  } else {
    ntiles = p.nkeys / 64;
  }
  const bf16* Kb = p.K + (size_t)b * p.k_bs + (size_t)hkv * p.k_hs;
  const bf16* K2b = (DSPLIT < DQK) ? p.K2 + (size_t)b * p.k2_bs : nullptr;
  const bf16* Vb = p.V + (size_t)b * p.v_bs + (size_t)hkv * p.v_hs;

  u32x4 rk[KPT], rv[VPT];
  auto key0_of = [&](int j) -> int { return p.window ? (j < 4 ? j * 64 : NCX + lo + (j - 4) * 64) : j * 64; };
#define ATTN_GLOAD(j)                                                                                          \
  {                                                                                                            \
    const int k0_ = key0_of(j);                                                                                \
    _Pragma("unroll") for (int i = 0; i < KPT; ++i) {                                                          \
      const int ci = tid + 256 * i, row = ci / KCH, c = ci % KCH;                                              \
      if (DSPLIT == DQK || c * 8 < DSPLIT) rk[i] = *(const u32x4*)(Kb + (size_t)(k0_ + row) * p.k_ts + c * 8); \
      else rk[i] = *(const u32x4*)(K2b + (size_t)(k0_ + row) * p.k2_ts + (c * 8 - DSPLIT));                   \
    }                                                                                                          \
    _Pragma("unroll") for (int i = 0; i < VPT; ++i) {                                                          \
      const int ci = tid + 256 * i, row = ci / VCH, c = ci % VCH;                                              \
      rv[i] = *(const u32x4*)(Vb + (size_t)(k0_ + row) * p.v_ts + c * 8);                                      \
    }                                                                                                          \
  }

  f32x16 o[NDB];
#pragma unroll
  for (int d = 0; d < NDB; ++d)
#pragma unroll
    for (int i = 0; i < 16; ++i) o[d][i] = 0.f;
  float m = -1e30f, l = 0.f;

  const int i16 = lane & 15, q4 = i16 >> 2, p4 = i16 & 3, g1 = (lane >> 4) & 1;

  ATTN_GLOAD(0);
  for (int j = 0; j < ntiles; ++j) {
    __syncthreads();
#pragma unroll
    for (int i = 0; i < KPT; ++i) { const int ci = tid + 256 * i, row = ci / KCH, c = ci % KCH; *(u32x4*)(&Ks[row * KLD + c * 8]) = rk[i]; }
#pragma unroll
    for (int i = 0; i < VPT; ++i) { const int ci = tid + 256 * i, row = ci / VCH, c = ci % VCH; *(u32x4*)(&Vs[row * VLD + c * 8]) = rv[i]; }
    __syncthreads();
    if (j + 1 < ntiles) ATTN_GLOAD(j + 1);

    f32x16 s[2];
#pragma unroll
    for (int mb = 0; mb < 2; ++mb) {
#pragma unroll
      for (int i = 0; i < 16; ++i) s[mb][i] = 0.f;
#pragma unroll
      for (int ks = 0; ks < NKS; ++ks) {
        const bf16x8 a = *(const bf16x8*)(&Ks[(mb * 32 + r) * KLD + ks * 16 + 8 * h]);
        s[mb] = mfma32(a, qf[ks], s[mb]);
      }
    }
    const bool band = p.window && j >= 4;
    const int pos0 = lo + (j - 4) * 64;
    float mx = -1e30f;
#pragma unroll
    for (int mb = 0; mb < 2; ++mb)
#pragma unroll
      for (int i = 0; i < 16; ++i) {
        float x = s[mb][i] * p.scale_log2;
        if (band) {
          const int dlt = pos0 + mb * 32 + crow(i, h) - tq;
          if (dlt > 128 || dlt < -128) x = -1e30f;
        }
        s[mb][i] = x;
        mx = fmaxf(mx, x);
      }
    mx = fmaxf(mx, __shfl_xor(mx, 32));
    const float mn = fmaxf(m, mx);
    const float alpha = __builtin_amdgcn_exp2f(m - mn);
    m = mn;
    float ls = 0.f;
#pragma unroll
    for (int mb = 0; mb < 2; ++mb)
#pragma unroll
      for (int i = 0; i < 16; ++i) {
        const float e = __builtin_amdgcn_exp2f(s[mb][i] - mn);
        s[mb][i] = e;
        ls += e;
      }
    l = l * alpha + ls;
#pragma unroll
    for (int d = 0; d < NDB; ++d)
#pragma unroll
      for (int i = 0; i < 16; ++i) o[d][i] *= alpha;
    bf16x8 pf[2][2];
#pragma unroll
    for (int mb = 0; mb < 2; ++mb)
#pragma unroll
      for (int s2 = 0; s2 < 2; ++s2)
#pragma unroll
        for (int jj = 0; jj < 8; ++jj) pf[mb][s2][jj] = (bf16)s[mb][8 * s2 + jj];
#pragma unroll
    for (int d = 0; d < NDB; ++d)
#pragma unroll
      for (int mb = 0; mb < 2; ++mb)
#pragma unroll
        for (int s2 = 0; s2 < 2; ++s2) {
          const int kb = mb * 32 + 16 * s2 + 4 * h;
          const bf16* vp = &Vs[(kb + q4) * VLD + d * 32 + 16 * g1 + 4 * p4];
          const bf16x4 vlo = __builtin_amdgcn_ds_read_tr16_b64_v4bf16((LAS bf16x4*)(vp));
          const bf16x4 vhi = __builtin_amdgcn_ds_read_tr16_b64_v4bf16((LAS bf16x4*)(vp + 8 * VLD));
          const bf16x8 a = __builtin_shufflevector(vlo, vhi, 0, 1, 2, 3, 4, 5, 6, 7);
          o[d] = mfma32(a, pf[mb][s2], o[d]);
        }
  }
#undef ATTN_GLOAD
  float lt = l + __shfl_xor(l, 32);
  if (p.sink) lt += __builtin_amdgcn_exp2f(p.sink[head] * LOG2E - m);
  const float inv = 1.f / lt;
  bf16* op = p.O + (size_t)(p.o_row0 + b * p.o_bs + tq) * DM + p.o_col0 + head * DV;
#pragma unroll
  for (int d = 0; d < NDB; ++d)
#pragma unroll
    for (int g = 0; g < 4; ++g) {
      bf16x4 ov;
#pragma unroll
      for (int jj = 0; jj < 4; ++jj) ov[jj] = (bf16)(o[d][4 * g + jj] * inv);
      *(bf16x4*)(op + d * 32 + 8 * g + 4 * h) = ov;
    }
}

struct PairTab { int i[50]; int j[50]; };
constexpr PairTab make_pairs() {
  PairTab t{}; int c = 0;
  for (int i = 0; i < 16; ++i) for (int j = 0; j < 16; ++j) if ((i + 1) * (j + 1) <= 16) { t.i[c] = i; t.j[c] = j; ++c; }
  return t;
}
constexpr PairTab PAIRS = make_pairs();
DI float as_f(unsigned u) { return __builtin_bit_cast(float, u); }
DI unsigned as_u(float f) { return __builtin_bit_cast(unsigned, f); }

__global__ __launch_bounds__(256, 2) void peer_select_kernel(const bf16* __restrict__ QP, const bf16* __restrict__ SK,
                                                             int* __restrict__ IDX, float* __restrict__ GW) {
  __shared__ unsigned lidx[4][64][9];
  const int tid = threadIdx.x, lane = tid & 63, wave = tid >> 6;
  const int r = lane & 31, h = lane >> 5;
  const int tok = blockIdx.x * 32 + r;
  const int head = blockIdx.y * 4 + wave;
  const float INF = __builtin_inff();
  float top[2][16];
#pragma unroll
  for (int p = 0; p < 2; ++p) {
    const bf16* qp = QP + (size_t)tok * 2048 + (head * 2 + p) * 128 + 8 * h;
    const bf16* kp = SK + ((size_t)(head * 2 + p) * 128 + r) * 128 + 8 * h;
    f32x16 acc[4];
#pragma unroll
    for (int nb = 0; nb < 4; ++nb)
#pragma unroll
      for (int i = 0; i < 16; ++i) acc[nb][i] = 0.f;
#pragma unroll
    for (int ks = 0; ks < 8; ++ks) {
      const bf16x8 bq = *(const bf16x8*)(qp + ks * 16);
#pragma unroll
      for (int nb = 0; nb < 4; ++nb) {
        const bf16x8 a = *(const bf16x8*)(kp + (size_t)nb * 32 * 128 + ks * 16);
        acc[nb] = mfma32(a, bq, acc[nb]);
      }
    }
#pragma unroll
    for (int nb = 0; nb < 4; ++nb)
#pragma unroll
      for (int i = 0; i < 16; ++i) acc[nb][i] = as_f((as_u(acc[nb][i]) & 0xFFFFFF80u) | (unsigned)(nb * 32 + crow(i, h)));
    float prev = INF;
#pragma unroll
    for (int k = 0; k < 16; ++k) {
      float best = -INF;
#pragma unroll
      for (int nb = 0; nb < 4; ++nb)
#pragma unroll
        for (int i = 0; i < 16; ++i) { const float v = acc[nb][i]; best = fmaxf(best, v < prev ? v : -INF); }
      best = fmaxf(best, __shfl_xor(best, 32));
      top[p][k] = best; prev = best;
    }
  }
  float cand[50];
#pragma unroll
  for (int c = 0; c < 50; ++c) {
    const float sum = top[0][PAIRS.i[c]] + top[1][PAIRS.j[c]];
    cand[c] = as_f((as_u(sum) & 0xFFFFFF00u) | (unsigned)(PAIRS.i[c] * 16 + PAIRS.j[c]));
  }
  float best2[16];
  {
    float prev = INF;
#pragma unroll
    for (int k = 0; k < 16; ++k) {
      float best = -INF;
#pragma unroll
      for (int c = 0; c < 50; ++c) { const float v = cand[c]; best = fmaxf(best, v < prev ? v : -INF); }
      best2[k] = best; prev = best;
    }
  }
  float ex[16], sum = 0.f;
#pragma unroll
  for (int k = 0; k < 16; ++k) { ex[k] = __expf(best2[k] - best2[0]); sum += ex[k]; }
  const float inv = 1.f / sum;
  unsigned* my = lidx[wave][lane];
#pragma unroll
  for (int q = 0; q < 4; ++q) {
    my[q] = (as_u(top[0][4 * q]) & 0x7Fu) | ((as_u(top[0][4 * q + 1]) & 0x7Fu) << 8) | ((as_u(top[0][4 * q + 2]) & 0x7Fu) << 16) | ((as_u(top[0][4 * q + 3]) & 0x7Fu) << 24);
    my[4 + q] = (as_u(top[1][4 * q]) & 0x7Fu) | ((as_u(top[1][4 * q + 1]) & 0x7Fu) << 8) | ((as_u(top[1][4 * q + 2]) & 0x7Fu) << 16) | ((as_u(top[1][4 * q + 3]) & 0x7Fu) << 24);
  }
#pragma unroll
  for (int k = 0; k < 16; ++k) {
    const unsigned code = as_u(best2[k]) & 0xFFu;
    const unsigned i = code >> 4, j = code & 15u;
    const unsigned e0 = (my[i >> 2] >> ((i & 3u) * 8u)) & 0x7Fu;
    const unsigned e1 = (my[4 + (j >> 2)] >> ((j & 3u) * 8u)) & 0x7Fu;
    if (h == 0) {
      IDX[(size_t)tok * 128 + head * 16 + k] = (int)(e0 * 128u + e1);
      GW[(size_t)tok * 128 + head * 16 + k] = ex[k] * inv;
    }
  }
}

typedef float f32x4v __attribute__((ext_vector_type(4)));
DI float gelu_exact(float x) { return 0.5f * x * (1.f + erff(x * 0.70710678118654752f)); }

__global__ __launch_bounds__(256, 2) void peer_apply_kernel(const bf16* __restrict__ H2, const int* __restrict__ IDX, const float* __restrict__ GW,
                                                            const bf16* __restrict__ U, const bf16* __restrict__ V,
                                                            float* __restrict__ x_lat, float* __restrict__ x_ctx, const float* __restrict__ modl) {
  const int tid = threadIdx.x, lane = tid & 63, wave = tid >> 6;
  const int token = blockIdx.x * 4 + wave;
  const int col16 = lane & 15, kq = lane >> 4;
  __shared__ __attribute__((aligned(16))) bf16 hs[4][DM];
  {
    const bf16* hp = H2 + (size_t)token * DM;
    *(u32x4*)(&hs[wave][8 * lane]) = *(const u32x4*)(hp + 8 * lane);
    *(u32x4*)(&hs[wave][512 + 8 * lane]) = *(const u32x4*)(hp + 512 + 8 * lane);
  }
  __syncthreads();
  const bf16* hbp = &hs[wave][8 * kq];
  const int id0 = IDX[(size_t)token * 128 + lane], id1 = IDX[(size_t)token * 128 + 64 + lane];
  float y[16];
#pragma unroll
  for (int i = 0; i < 16; ++i) y[i] = 0.f;
  for (int g = 0; g < 8; ++g) {
    const int idsel = g < 4 ? id0 : id1;
    const int e = __shfl(idsel, ((g * 16) & 63) + col16);
    const bf16* up = U + (size_t)e * DM + 8 * kq;
    f32x4v c = {0.f, 0.f, 0.f, 0.f};
#pragma unroll 1
    for (int s0 = 0; s0 < 32; s0 += 16) {
#pragma unroll
      for (int s = 0; s < 16; ++s) {
        const bf16x8 a = *(const bf16x8*)(up + 32 * (s0 + s));
        c = __builtin_amdgcn_mfma_f32_16x16x32_bf16(a, *(const bf16x8*)(hbp + 32 * (s0 + s)), c, 0, 0, 0);
      }
    }
    const float4 gw = *(const float4*)(GW + (size_t)token * 128 + g * 16 + kq * 4);
    float w[4];
    w[0] = gelu_exact(c[0]) * gw.x; w[1] = gelu_exact(c[1]) * gw.y; w[2] = gelu_exact(c[2]) * gw.z; w[3] = gelu_exact(c[3]) * gw.w;
#pragma unroll 1
    for (int q = 0; q < 4; ++q)
#pragma unroll
      for (int rg = 0; rg < 4; ++rg) {
        const float ws = as_f((unsigned)__builtin_amdgcn_readlane((int)as_u(w[rg]), q * 16));
        const int es = __builtin_amdgcn_readlane(idsel, ((g * 16) & 63) + q * 4 + rg);
        const bf16* vp = V + (size_t)es * DM + 8 * lane;
        const bf16x8 v0 = *(const bf16x8*)(vp), v1 = *(const bf16x8*)(vp + 512);
#pragma unroll
        for (int j = 0; j < 8; ++j) { y[j] += ws * (float)v0[j]; y[8 + j] += ws * (float)v1[j]; }
      }
  }
  float* xr; int b;
  if (token < NLAT) { xr = x_lat + (size_t)token * DM; b = token / SEQ; } else { xr = x_ctx + (size_t)(token - NLAT) * DM; b = 4; }
  const float* gate = modl + (size_t)b * 6144 + 5 * 1024;
#pragma unroll
  for (int half = 0; half < 2; ++half) {
    const int col = half * 512 + 8 * lane;
#pragma unroll
    for (int q = 0; q < 2; ++q) {
      float4 xv = *(float4*)(xr + col + 4 * q);
      const float4 gv = *(const float4*)(gate + col + 4 * q);
      xv.x += gv.x * y[half * 8 + 4 * q + 0]; xv.y += gv.y * y[half * 8 + 4 * q + 1];
      xv.z += gv.z * y[half * 8 + 4 * q + 2]; xv.w += gv.w * y[half * 8 + 4 * q + 3];
      *(float4*)(xr + col + 4 * q) = xv;
    }
  }
}

__global__ __launch_bounds__(384) void mla_post1_kernel(bf16* __restrict__ P1, const float* __restrict__ qan, const float* __restrict__ kvan,
                                                        const float* __restrict__ krn, const float* __restrict__ cs, const float* __restrict__ sn,
                                                        bf16* __restrict__ KPE) {
  __shared__ float red[6];
  const int row = blockIdx.x, i = threadIdx.x, lane = i & 63, wave = i >> 6;
  const bool active = i < 352;
  const int e0 = 2 * i;
  bf16* pr = P1 + (size_t)row * 768;
  float v0 = 0.f, v1 = 0.f;
  if (active) { const bf16x2 pv = *(const bf16x2*)(pr + e0); v0 = (float)pv[0]; v1 = (float)pv[1]; }
  float ss = v0 * v0 + v1 * v1;
  for (int o = 32; o > 0; o >>= 1) ss += __shfl_xor(ss, o);
  if (lane == 0) red[wave] = ss;
  __syncthreads();
  if (!active) return;
  if (wave < 3) {
    const float rs = rsqrtf((red[0] + red[1] + red[2]) * (1.f / 384.f) + EPS);
    bf16x2 ov; ov[0] = (bf16)(v0 * rs * qan[e0]); ov[1] = (bf16)(v1 * rs * qan[e0 + 1]);
    *(bf16x2*)(pr + e0) = ov;
  } else if (wave < 5) {
    const float rs = rsqrtf((red[3] + red[4]) * (1.f / 256.f) + EPS);
    bf16x2 ov; ov[0] = (bf16)(v0 * rs * kvan[e0 - 384]); ov[1] = (bf16)(v1 * rs * kvan[e0 - 383]);
    *(bf16x2*)(pr + e0) = ov;
  } else {
    const int pi = i - 320;
    const float rs = rsqrtf(red[5] * (1.f / 64.f) + EPS);
    float y0 = v0 * rs * krn[2 * pi], y1 = v1 * rs * krn[2 * pi + 1];
    int orow;
    if (row < NLAT) {
      const int b = row / SEQ, t = row % SEQ;
      const float c = cs[t * 32 + pi], s = sn[t * 32 + pi];
      const float o0 = y0 * c - y1 * s, o1 = y0 * s + y1 * c;
      y0 = o0; y1 = o1;
      orow = b * NKEY + NCX + t;
    } else {
      const int rc = row - NLAT;
      orow = (rc / NCX) * NKEY + (rc % NCX);
    }
    bf16x2 ov; ov[0] = (bf16)y0; ov[1] = (bf16)y1;
    *(bf16x2*)(KPE + (size_t)orow * 64 + 2 * pi) = ov;
  }
}

__global__ __launch_bounds__(512) void mla_qpost_kernel(bf16* __restrict__ Q, const float* __restrict__ qnn, const float* __restrict__ qnr,
                                                        const float* __restrict__ cs, const float* __restrict__ sn) {
  const int row = blockIdx.x, lane = threadIdx.x & 63, head = threadIdx.x >> 6;
  const int t = row % SEQ;
  bf16* qp = Q + (size_t)row * 1536 + head * 192;
  const bf16x2 nv = *(const bf16x2*)(qp + 2 * lane);
  float v0 = (float)nv[0], v1 = (float)nv[1];
  float ss = v0 * v0 + v1 * v1;
  for (int o = 32; o > 0; o >>= 1) ss += __shfl_xor(ss, o);
  const float rs = rsqrtf(ss * (1.f / 128.f) + EPS);
  bf16x2 ov; ov[0] = (bf16)(v0 * rs * qnn[2 * lane]); ov[1] = (bf16)(v1 * rs * qnn[2 * lane + 1]);
  float p0 = 0.f, p1 = 0.f;
  if (lane < 32) { const bf16x2 pv = *(const bf16x2*)(qp + 128 + 2 * lane); p0 = (float)pv[0]; p1 = (float)pv[1]; }
  float s2 = p0 * p0 + p1 * p1;
  for (int o = 32; o > 0; o >>= 1) s2 += __shfl_xor(s2, o);
  const float rs2 = rsqrtf(s2 * (1.f / 64.f) + EPS);
  *(bf16x2*)(qp + 2 * lane) = ov;
  if (lane < 32) {
    const float y0 = p0 * rs2 * qnr[2 * lane], y1 = p1 * rs2 * qnr[2 * lane + 1];
    const float c = cs[t * 32 + lane], s = sn[t * 32 + lane];
    bf16x2 pv; pv[0] = (bf16)(y0 * c - y1 * s); pv[1] = (bf16)(y0 * s + y1 * c);
    *(bf16x2*)(qp + 128 + 2 * lane) = pv;
  }
}

__global__ __launch_bounds__(512) void mla_kpost_kernel(bf16* __restrict__ KV, const float* __restrict__ knn) {
  const int row = blockIdx.x, lane = threadIdx.x & 63, head = threadIdx.x >> 6;
  bf16* kp = KV + (size_t)row * 2048 + head * 256;
  const bf16x2 nv = *(const bf16x2*)(kp + 2 * lane);
  const float v0 = (float)nv[0], v1 = (float)nv[1];
  float ss = v0 * v0 + v1 * v1;
  for (int o = 32; o > 0; o >>= 1) ss += __shfl_xor(ss, o);
  const float rs = rsqrtf(ss * (1.f / 128.f) + EPS);
  bf16x2 ov; ov[0] = (bf16)(v0 * rs * knn[2 * lane]); ov[1] = (bf16)(v1 * rs * knn[2 * lane + 1]);
  *(bf16x2*)(kp + 2 * lane) = ov;
}

static inline size_t align_up(size_t v, size_t a) { return (v + a - 1) / a * a; }

extern "C" void kernel_launch(void* const* d_in, const int* in_sizes, int n_in,
                              void* d_out, int out_size, void* d_ws, size_t ws_size,
                              hipStream_t stream) {
  const float* x = (const float*)d_in[0];
  const float* c = (const float*)d_in[1];
  const float* ctx = (const float*)d_in[2];
  const float* c_ctx = (const float*)d_in[3];
  const float* mod_w = (const float*)d_in[4];
  const float* mod_b = (const float*)d_in[5];
  const float* mix_norm = (const float*)d_in[6];
  const float* ffn_norm = (const float*)d_in[7];
  const float* even_w_in = (const float*)d_in[8];
  const float* even_w_out = (const float*)d_in[9];
  const float* a_q_norm = (const float*)d_in[10];
  const float* a_k_norm = (const float*)d_in[11];
  const float* b_q_norm = (const float*)d_in[12];
  const float* b_k_norm = (const float*)d_in[13];
  const float* b_sink = (const float*)d_in[14];
  const float* mla_w_in = (const float*)d_in[15];
  const float* mla_q_a_norm = (const float*)d_in[16];
  const float* mla_kv_a_norm = (const float*)d_in[17];
  const float* mla_w_uq = (const float*)d_in[18];
  const float* mla_w_ukv = (const float*)d_in[19];
  const float* mla_q_nope_norm = (const float*)d_in[20];
  const float* mla_q_rope_norm = (const float*)d_in[21];
  const float* mla_k_nope_norm = (const float*)d_in[22];
  const float* mla_k_rope_norm = (const float*)d_in[23];
  const float* mla_w_out = (const float*)d_in[24];
  const float* peer_w_query = (const float*)d_in[25];
  const float* peer_sub_keys = (const float*)d_in[26];
  const float* peer_u = (const float*)d_in[27];
  const float* peer_v = (const float*)d_in[28];
  float* out = (float*)d_out;

  char* w = (char*)d_ws;
  size_t off = 0;
  auto take = [&](size_t bytes) { char* p = w + off; off = align_up(off + bytes, 256); return p; };
  float* MOD = (float*)take(2 * 5 * 6144 * 4);
  float* RCS = (float*)take((size_t)SEQ * 32 * 4);
  float* RSN = (float*)take((size_t)SEQ * 32 * 4);
  float* CTXS = (float*)take((size_t)NCTXT * DM * 4);
  bf16* W_EIN = (bf16*)take((size_t)1536 * 1024 * 2);
  bf16* W_EOUT = (bf16*)take((size_t)1024 * 1024 * 2);
  bf16* W_PQ = (bf16*)take((size_t)2 * 2048 * 1024 * 2);
  bf16* W_MIN = (bf16*)take((size_t)768 * 1024 * 2);
  bf16* W_UQ = (bf16*)take((size_t)1536 * 384 * 2);
  bf16* W_UKV = (bf16*)take((size_t)2048 * 256 * 2);
  bf16* W_MOUT = (bf16*)take((size_t)1024 * 1024 * 2);
  bf16* SKB = (bf16*)take((size_t)2 * 16 * 128 * 128 * 2);
  bf16* HA = (bf16*)take((size_t)NTOK * DM * 2);
  bf16* HB = (bf16*)take((size_t)NTOK * DM * 2);
  bf16* UB = (bf16*)take((size_t)16384 * 1024 * 2);
  bf16* VB2 = (bf16*)take((size_t)16384 * 1024 * 2);
  int* IDX = (int*)take((size_t)NTOK * 128 * 4);
  float* GW = (float*)take((size_t)NTOK * 128 * 4);
  char* R = take((size_t)250 * 1024 * 1024);
  bf16* P0 = (bf16*)R;
  bf16* QA = (bf16*)(R + (size_t)NTOK * 1536 * 2);
  bf16* QB = QA + (size_t)NB * 8 * SEQ * 64;
  bf16* CQA = QB + (size_t)NB * 8 * SEQ * 64;
  bf16* CQB = CQA + (size_t)NB * 8 * NCX * 64;
  bf16* KA = CQB + (size_t)NB * 8 * NCX * 64;
  bf16* VA = KA + (size_t)NB * 2 * NKEY * 64;
  bf16* KB = VA + (size_t)NB * 2 * NKEY * 64;
  bf16* VB = KB + (size_t)NB * 2 * NKEY * 64;
  bf16* QP = (bf16*)R;
  bf16* KPE = (bf16*)R;
  bf16* QRAW = KPE + (size_t)NB * NKEY * 64;
  bf16* KVRAW = QRAW + (size_t)NLAT * 1536;
  bf16* P1 = HB;

  mod_kernel<<<dim3(96, 2), 256, 0, stream>>>(c, c_ctx, mod_w, mod_b, MOD);
  rope_kernel<<<SEQ * 32 / 256, 256, 0, stream>>>(RCS, RSN);
  transpose_convert_kernel<<<dim3(1536 / 32, 1024 / 32), dim3(32, 8), 0, stream>>>(even_w_in, W_EIN, 1024, 1536, 1536);
  transpose_convert_kernel<<<dim3(1024 / 32, 1024 / 32), dim3(32, 8), 0, stream>>>(even_w_out, W_EOUT, 1024, 1024, 1024);
  for (int l = 0; l < 2; ++l)
    transpose_convert_kernel<<<dim3(2048 / 32, 1024 / 32), dim3(32, 8), 0, stream>>>(peer_w_query + (size_t)l * 1024 * 2048, W_PQ + (size_t)l * 2048 * 1024, 1024, 2048, 2048);
  transpose_convert_kernel<<<dim3(768 / 32, 1024 / 32), dim3(32, 8), 0, stream>>>(mla_w_in, W_MIN, 1024, 704, 768);
  transpose_convert_kernel<<<dim3(1536 / 32, 384 / 32), dim3(32, 8), 0, stream>>>(mla_w_uq, W_UQ, 384, 1536, 1536);
  transpose_convert_kernel<<<dim3(2048 / 32, 256 / 32), dim3(32, 8), 0, stream>>>(mla_w_ukv, W_UKV, 256, 2048, 2048);
  transpose_convert_kernel<<<dim3(1024 / 32, 1024 / 32), dim3(32, 8), 0, stream>>>(mla_w_out, W_MOUT, 1024, 1024, 1024);
  convert_kernel<<<512, 256, 0, stream>>>((const float4*)peer_sub_keys, (bf16x4*)SKB, (size_t)2 * 16 * 128 * 128 / 4);

  const float* MOD0 = MOD;
  norm_mod_kernel<<<NTOK, 256, 0, stream>>>(x, ctx, mix_norm, MOD0, 0, HA);
  {
    GemmEpi e{}; e.Cb = P0; e.ldc = 1536;
    gemm_kernel<EPI_BF16><<<dim3(1536 / GBN, NTOK / GBM), 256, 0, stream>>>(HA, 1024, W_EIN, 1024, e);
  }
  {
    Post0 p{}; p.P = P0; p.aqn = a_q_norm; p.akn = a_k_norm; p.bqn = b_q_norm; p.bkn = b_k_norm; p.cs = RCS; p.sn = RSN;
    p.QA = QA; p.QB = QB; p.CQA = CQA; p.CQB = CQB; p.KA = KA; p.VA = VA; p.KB = KB; p.VB = VB;
    qkv_post0_kernel<<<NTOK, 768, 0, stream>>>(p);
  }
  const float sc64 = 0.125f * LOG2E;
  {
    AttnParams p{}; p.Q = QA; p.q_bs = (long)8 * SEQ * 64; p.q_hs = (long)SEQ * 64; p.q_ts = 64;
    p.K = KA; p.k_bs = (long)2 * NKEY * 64; p.k_hs = (long)NKEY * 64; p.k_ts = 64;
    p.V = VA; p.v_bs = p.k_bs; p.v_hs = p.k_hs; p.v_ts = 64;
    p.O = HB; p.o_row0 = 0; p.o_bs = SEQ; p.o_col0 = 0; p.sink = nullptr; p.nkeys = NKEY; p.G = 4; p.window = 0; p.scale_log2 = sc64;
    attn_kernel<64, 64, 64><<<dim3(SEQ / 128, 8, NB), 256, 0, stream>>>(p);
    p.Q = CQA; p.q_bs = (long)8 * NCX * 64; p.q_hs = (long)NCX * 64; p.o_row0 = NLAT; p.o_bs = NCX; p.nkeys = NCX;
    attn_kernel<64, 64, 64><<<dim3(NCX / 128, 8, NB), 256, 0, stream>>>(p);
  }
  {
    AttnParams p{}; p.Q = QB; p.q_bs = (long)8 * SEQ * 64; p.q_hs = (long)SEQ * 64; p.q_ts = 64;
    p.K = KB; p.k_bs = (long)2 * NKEY * 64; p.k_hs = (long)NKEY * 64; p.k_ts = 64;
    p.V = VB; p.v_bs = p.k_bs; p.v_hs = p.k_hs; p.v_ts = 64;
    p.O = HB; p.o_row0 = 0; p.o_bs = SEQ; p.o_col0 = 512; p.sink = b_sink; p.nkeys = NKEY; p.G = 4; p.window = 1; p.scale_log2 = sc64;
    attn_kernel<64, 64, 64><<<dim3(SEQ / 128, 8, NB), 256, 0, stream>>>(p);
    p.Q = CQB; p.q_bs = (long)8 * NCX * 64; p.q_hs = (long)NCX * 64; p.o_row0 = NLAT; p.o_bs = NCX; p.nkeys = NCX; p.window = 0;
    attn_kernel<64, 64, 64><<<dim3(NCX / 128, 8, NB), 256, 0, stream>>>(p);
  }
  {
    GemmEpi e{}; e.out_lat = out; e.res_lat = x; e.out_ctx = CTXS; e.res_ctx = ctx; e.modl = MOD0; e.gchunk = 2;
    gemm_kernel<EPI_RESID><<<dim3(1024 / GBN, NTOK / GBM), 256, 0, stream>>>(HB, 1024, W_EOUT, 1024, e);
  }
  convert_kernel<<<2048, 256, 0, stream>>>((const float4*)peer_u, (bf16x4*)UB, (size_t)16384 * 1024 / 4);
  convert_kernel<<<2048, 256, 0, stream>>>((const float4*)peer_v, (bf16x4*)VB2, (size_t)16384 * 1024 / 4);
  norm_mod_kernel<<<NTOK, 256, 0, stream>>>(out, CTXS, ffn_norm, MOD0, 3, HA);
  {
    GemmEpi e{}; e.Cb = QP; e.ldc = 2048;
    gemm_kernel<EPI_BF16><<<dim3(2048 / GBN, NTOK / GBM), 256, 0, stream>>>(HA, 1024, W_PQ, 1024, e);
  }
  peer_select_kernel<<<dim3(NTOK / 32, 2), 256, 0, stream>>>(QP, SKB, IDX, GW);
  peer_apply_kernel<<<NTOK / 4, 256, 0, stream>>>(HA, IDX, GW, UB, VB2, out, CTXS, MOD0);

  const float* MOD1 = MOD + 5 * 6144;
  norm_mod_kernel<<<NTOK, 256, 0, stream>>>(out, CTXS, mix_norm + 1024, MOD1, 0, HA);
  {
    GemmEpi e{}; e.Cb = P1; e.ldc = 768;
    gemm_kernel<EPI_BF16><<<dim3(768 / GBN, NTOK / GBM), 256, 0, stream>>>(HA, 1024, W_MIN, 1024, e);
  }
  mla_post1_kernel<<<NTOK, 384, 0, stream>>>(P1, mla_q_a_norm, mla_kv_a_norm, mla_k_rope_norm, RCS, RSN, KPE);
  {
    GemmEpi e{}; e.Cb = QRAW; e.ldc = 1536;
    gemm_kernel<EPI_BF16><<<dim3(1536 / GBN, NLAT / GBM), 256, 0, stream>>>(P1, 768, W_UQ, 384, e);
  }
  {
    GemmEpi e{}; e.Cb = KVRAW; e.ldc = 2048; e.rowmap = 1;
    gemm_kernel<EPI_BF16><<<dim3(2048 / GBN, NTOK / GBM), 256, 0, stream>>>(P1 + 384, 768, W_UKV, 256, e);
  }
  mla_qpost_kernel<<<NLAT, 512, 0, stream>>>(QRAW, mla_q_nope_norm, mla_q_rope_norm, RCS, RSN);
  mla_kpost_kernel<<<NB * NKEY, 512, 0, stream>>>(KVRAW, mla_k_nope_norm);
  {
    AttnParams p{}; p.Q = QRAW; p.q_bs = (long)SEQ * 1536; p.q_hs = 192; p.q_ts = 1536;
    p.K = KVRAW; p.k_bs = (long)NKEY * 2048; p.k_hs = 256; p.k_ts = 2048;
    p.K2 = KPE; p.k2_bs = (long)NKEY * 64; p.k2_ts = 64;
    p.V = KVRAW + 128; p.v_bs = (long)NKEY * 2048; p.v_hs = 256; p.v_ts = 2048;
    p.O = HA; p.o_row0 = 0; p.o_bs = SEQ; p.o_col0 = 0; p.sink = nullptr; p.nkeys = NKEY; p.G = 1; p.window = 0;
    p.scale_log2 = 0.07216878364870322f * LOG2E;
    attn_kernel<192, 128, 128><<<dim3(SEQ / 128, 8, NB), 256, 0, stream>>>(p);
  }
  {
    GemmEpi e{}; e.out_lat = out; e.res_lat = out; e.out_ctx = CTXS; e.res_ctx = CTXS; e.modl = MOD1; e.gchunk = 2;
    gemm_kernel<EPI_RESID><<<dim3(1024 / GBN, NLAT / GBM), 256, 0, stream>>>(HA, 1024, W_MOUT, 1024, e);
  }
  convert_kernel<<<2048, 256, 0, stream>>>((const float4*)(peer_u + (size_t)16384 * 1024), (bf16x4*)UB, (size_t)16384 * 1024 / 4);
  convert_kernel<<<2048, 256, 0, stream>>>((const float4*)(peer_v + (size_t)16384 * 1024), (bf16x4*)VB2, (size_t)16384 * 1024 / 4);
  norm_mod_kernel<<<NLAT, 256, 0, stream>>>(out, CTXS, ffn_norm + 1024, MOD1, 3, HB);
  {
    GemmEpi e{}; e.Cb = QP; e.ldc = 2048;
    gemm_kernel<EPI_BF16><<<dim3(2048 / GBN, NLAT / GBM), 256, 0, stream>>>(HB, 1024, W_PQ + (size_t)2048 * 1024, 1024, e);
  }
  peer_select_kernel<<<dim3(NLAT / 32, 2), 256, 0, stream>>>(QP, SKB + (size_t)16 * 128 * 128, IDX, GW);
  peer_apply_kernel<<<NLAT / 4, 256, 0, stream>>>(HB, IDX, GW, UB, VB2, out, CTXS, MOD1);
}
```

```cpp
#include <hip/hip_runtime.h>
#include <stdint.h>

typedef __bf16 bf16;
typedef __bf16 bf16x8 __attribute__((ext_vector_type(8)));
typedef __bf16 bf16x4 __attribute__((ext_vector_type(4)));
typedef __bf16 bf16x2 __attribute__((ext_vector_type(2)));
typedef float f32x16 __attribute__((ext_vector_type(16)));
typedef unsigned u32x4 __attribute__((ext_vector_type(4)));
#define LAS __attribute__((address_space(3)))
#define DI __device__ __forceinline__

constexpr int DM = 1024, NB = 4, SEQ = 8192, NCX = 256;
constexpr int NLAT = NB * SEQ, NCTXT = NB * NCX, NTOK = NLAT + NCTXT, NKEY = SEQ + NCX;
constexpr float EPS = 1e-6f;
constexpr float LOG2E = 1.4426950408889634f;

DI int crow(int i, int h) { return (i & 3) + 8 * (i >> 2) + 4 * h; }
DI f32x16 mfma32(bf16x8 a, bf16x8 b, f32x16 c) { return __builtin_amdgcn_mfma_f32_32x32x16_bf16(a, b, c, 0, 0, 0); }
DI float silu(float v) { return v / (1.f + __expf(-v)); }


#define XB_TMO      128
#define XB_XCNT(j)  (256  + 64 * (j))
#define XB_XSUB(j)  (1280 + 64 * (j))
#define XB_XGEN(j)  (2304 + 64 * (j))
#define XB_TOP      3328
#define XB_TOPGEN   3392
#define XCD_BAR_WORDS 3456
#define XB_SPIN_CAP (1u << 18)

__device__ __forceinline__ unsigned xb_ld(unsigned* p)              { return __hip_atomic_load(p, __ATOMIC_RELAXED, __HIP_MEMORY_SCOPE_AGENT); }
__device__ __forceinline__ unsigned xb_add(unsigned* p, unsigned v) { return __hip_atomic_fetch_add(p, v, __ATOMIC_RELAXED, __HIP_MEMORY_SCOPE_AGENT); }
__device__ __forceinline__ unsigned xb_xcc_id() { return (unsigned)__builtin_amdgcn_s_getreg((3 << 11) | 20) & 0xFu; }
#define XB_SPIN(cond, bar) do { unsigned _sp = 0; while (cond) { __builtin_amdgcn_s_sleep(1); \
    if ((++_sp & 255u) == 0u) { if (xb_ld(&(bar)[XB_TMO])) break; if (_sp > XB_SPIN_CAP) { atomicAdd(&(bar)[XB_TMO], 1u); break; } } } } while (0)

struct XcdBarrier { unsigned* bar; unsigned x; volatile LAS unsigned* st; };

__device__ __forceinline__ XcdBarrier xcd_barrier_post(unsigned* bar, volatile LAS unsigned* st) {
    XcdBarrier b; b.bar = bar; b.x = xb_xcc_id(); b.st = st;
    if (threadIdx.x == 0) (void)xb_add(&bar[XB_XCNT(b.x)], 1u);
    return b;
}
__device__ __forceinline__ void xcd_barrier_complete(unsigned* bar, unsigned x, unsigned& nloc, unsigned& nx) {
    const unsigned G = gridDim.x * gridDim.y * gridDim.z;
    unsigned sum, cnt, mine, sp = 0u;
    for (;;) {
        sum = 0u; cnt = 0u; mine = 0u;
#pragma unroll
        for (unsigned j = 0; j < 16; ++j) { const unsigned c = xb_ld(&bar[XB_XCNT(j)]); sum += c; cnt += (c > 0u) ? 1u : 0u; mine = (j == x) ? c : mine; }
        if (sum == G) break;
        __builtin_amdgcn_s_sleep(1);
        if ((++sp & 255u) == 0u) { if (xb_ld(&bar[XB_TMO])) break; if (sp > XB_SPIN_CAP) { atomicAdd(&bar[XB_TMO], 1u); break; } }
    }
    nloc = mine > 0u ? mine : 1u; nx = cnt > 0u ? cnt : 1u;
}
__device__ __forceinline__ void xcd_barrier(const XcdBarrier& b) {
    asm volatile("s_waitcnt vmcnt(0)" ::: "memory");
    __syncthreads();
    if (threadIdx.x == 0) {
        unsigned* bar = b.bar;
        __builtin_amdgcn_s_waitcnt(0);
        unsigned nloc = b.st[0], nx = b.st[1];
        if (nloc == 0u) { xcd_barrier_complete(bar, b.x, nloc, nx); b.st[0] = nloc; b.st[1] = nx; }
        const unsigned old = xb_add(&bar[XB_XSUB(b.x)], 1u);
        const unsigned gen = old / nloc;
        if (old + 1u == (gen + 1u) * nloc) {
            __builtin_amdgcn_fence(__ATOMIC_RELEASE, "agent");
            asm volatile("s_waitcnt vmcnt(0)" ::: "memory");
            const unsigned og = xb_add(&bar[XB_TOP], 1u);
            const unsigned tg = og / nx;
            if (og + 1u == (tg + 1u) * nx) xb_add(&bar[XB_TOPGEN], 1u);
            else XB_SPIN(xb_ld(&bar[XB_TOPGEN]) == tg, bar);
            __builtin_amdgcn_fence(__ATOMIC_ACQUIRE, "agent");
            xb_add(&bar[XB_XGEN(b.x)], 1u);
            asm volatile("s_waitcnt vmcnt(0)" ::: "memory");
        } else {
            XB_SPIN(xb_ld(&bar[XB_XGEN(b.x)]) == gen, bar);
            __builtin_amdgcn_fence(__ATOMIC_ACQUIRE, "agent");
            asm volatile("s_waitcnt vmcnt(0)" ::: "memory");
        }
    }
    __syncthreads();
}

constexpr int SMEM_BYTES = 73728;

DI void mod_item(int item, const float* __restrict__ c, const float* __restrict__ c_ctx, const float* __restrict__ mod_w,
                 const float* __restrict__ mod_b, float* __restrict__ mod, char* smem) {
  float (*sv)[1024] = (float (*)[1024])smem;
  float (*part)[5][64] = (float (*)[5][64])(smem + 5 * 1024 * 4);
  const int tid = threadIdx.x, l = item / 96, bx = item % 96;
  for (int i = tid; i < 5 * 1024; i += 256) {
    const int b = i >> 10, k = i & 1023;
    const float v = b < 4 ? c[b * 1024 + k] : c_ctx[k];
    sv[b][k] = silu(v);
  }
  __syncthreads();
  const int nn = tid & 63, kg = tid >> 6;
  const int n = bx * 64 + nn;
  const float* w = mod_w + (size_t)l * 1024 * 6144 + n;
  float a0 = 0, a1 = 0, a2 = 0, a3 = 0, a4 = 0;
  for (int k = kg * 256; k < kg * 256 + 256; ++k) {
    const float wv = w[(size_t)k * 6144];
    a0 += sv[0][k] * wv; a1 += sv[1][k] * wv; a2 += sv[2][k] * wv; a3 += sv[3][k] * wv; a4 += sv[4][k] * wv;
  }
  part[kg][0][nn] = a0; part[kg][1][nn] = a1; part[kg][2][nn] = a2; part[kg][3][nn] = a3; part[kg][4][nn] = a4;
  __syncthreads();
  for (int i = tid; i < 5 * 64; i += 256) {
    const int b = i >> 6, j = i & 63;
    const float s = part[0][b][j] + part[1][b][j] + part[2][b][j] + part[3][b][j];
    mod[((size_t)l * 5 + b) * 6144 + bx * 64 + j] = s + mod_b[(size_t)l * 6144 + bx * 64 + j];
  }
  __syncthreads();
}

DI void rope_phase(float* __restrict__ cs, float* __restrict__ sn) {
  for (int idx = blockIdx.x * 256 + threadIdx.x; idx < SEQ * 32; idx += gridDim.x * 256) {
    const int t = idx >> 5, i = idx & 31;
    const int row = t >> 6, col = t & 63;
    const int fi = i & 15;
    const float inv = powf(10000.f, -(float)(2 * fi) / 32.f);
    const float ang = (i < 16 ? (float)row : (float)col) * inv;
    cs[idx] = cosf(ang);
    sn[idx] = sinf(ang);
  }
}

DI void transpose_item(int item, const float* __restrict__ W, bf16* __restrict__ Wt, int K, int N, int Npad, char* smem) {
  float (*tile)[33] = (float (*)[33])smem;
  const int tx = threadIdx.x & 31, ty = threadIdx.x >> 5;
  const int ntn = Npad / 32;
  const int n0 = (item % ntn) * 32, k0 = (item / ntn) * 32;
  for (int j = ty; j < 32; j += 8) {
    const int k = k0 + j, n = n0 + tx;
    tile[j][tx] = (n < N) ? W[(size_t)k * N + n] : 0.f;
  }
  __syncthreads();
  for (int j = ty; j < 32; j += 8) {
    const int n = n0 + j, k = k0 + tx;
    Wt[(size_t)n * K + k] = (bf16)tile[tx][j];
  }
  __syncthreads();
}
DI void transpose_phase(const float* __restrict__ W, bf16* __restrict__ Wt, int K, int N, int Npad, char* smem) {
  const int nitems = (Npad / 32) * (K / 32);
  for (int item = blockIdx.x; item < nitems; item += gridDim.x) transpose_item(item, W, Wt, K, N, Npad, smem);
}

DI void convert_phase(const float4* __restrict__ src, bf16x4* __restrict__ dst, size_t n4) {
  for (size_t i = blockIdx.x * (size_t)256 + threadIdx.x; i < n4; i += (size_t)gridDim.x * 256) {
    const float4 v = src[i];
    bf16x4 o; o[0] = (bf16)v.x; o[1] = (bf16)v.y; o[2] = (bf16)v.z; o[3] = (bf16)v.w;
    dst[i] = o;
  }
}

DI void norm_mod_item(int row, const float* __restrict__ src_lat, const float* __restrict__ src_ctx, const float* __restrict__ gain,
                      const float* __restrict__ modl, int chunk, bf16* __restrict__ H, char* smem) {
  float* red = (float*)smem;
  const int tid = threadIdx.x;
  const float* src; int b;
  if (row < NLAT) { src = src_lat + (size_t)row * DM; b = row / SEQ; } else { src = src_ctx + (size_t)(row - NLAT) * DM; b = 4; }
  const float4 v = ((const float4*)src)[tid];
  float ss = v.x * v.x + v.y * v.y + v.z * v.z + v.w * v.w;
  for (int o = 32; o > 0; o >>= 1) ss += __shfl_xor(ss, o);
  if ((tid & 63) == 0) red[tid >> 6] = ss;
  __syncthreads();
  ss = red[0] + red[1] + red[2] + red[3];
  const float rs = rsqrtf(ss * (1.f / DM) + EPS);
  const float4 g = ((const float4*)gain)[tid];
  const float4 sh = ((const float4*)(modl + (size_t)b * 6144 + chunk * 1024))[tid];
  const float4 sc = ((const float4*)(modl + (size_t)b * 6144 + (chunk + 1) * 1024))[tid];
  bf16x4 o;
  o[0] = (bf16)(v.x * rs * g.x * (1.f + sc.x) + sh.x);
  o[1] = (bf16)(v.y * rs * g.y * (1.f + sc.y) + sh.y);
  o[2] = (bf16)(v.z * rs * g.z * (1.f + sc.z) + sh.z);
  o[3] = (bf16)(v.w * rs * g.w * (1.f + sc.w) + sh.w);
  ((bf16x4*)(H + (size_t)row * DM))[tid] = o;
  __syncthreads();
}

constexpr int GBM = 128, GBN = 128, GBK = 64, GLD = 72;
enum { EPI_BF16 = 0, EPI_RESID = 1 };
struct GemmEpi {
  bf16* Cb; int ldc; int rowmap;
  float* out_lat; const float* res_lat; float* out_ctx; const float* res_ctx; const float* modl; int gchunk;
};

template <int EPI>
DI void gemm_tile(const bf16* __restrict__ A, int lda, const bf16* __restrict__ Bt, int K, const GemmEpi& e, int m0, int n0, char* smem) {
  bf16* As = (bf16*)smem;
  bf16* Bs = (bf16*)(smem + 2 * GBM * GLD * 2);
  const int tid = threadIdx.x, lane = tid & 63, wave = tid >> 6, wm = wave >> 1, wn = wave & 1;
  const int r = lane & 31, h = lane >> 5;
  const int sc = tid & 7, sr = tid >> 3;
  const bf16* Ag = A + (size_t)(m0 + sr) * lda + sc * 8;
  const bf16* Bg = Bt + (size_t)(n0 + sr) * K + sc * 8;
  u32x4 ra[4], rb[4];
  f32x16 acc[2][2];
#pragma unroll
  for (int i = 0; i < 2; ++i)
#pragma unroll
    for (int j = 0; j < 2; ++j)
#pragma unroll
      for (int q = 0; q < 16; ++q) acc[i][j][q] = 0.f;
  const int nt = K / GBK;
#pragma unroll
  for (int i = 0; i < 4; ++i) { ra[i] = *(const u32x4*)(Ag + (size_t)i * 32 * lda); rb[i] = *(const u32x4*)(Bg + (size_t)i * 32 * K); }
#pragma unroll
  for (int i = 0; i < 4; ++i) { *(u32x4*)(&As[(sr + 32 * i) * GLD + sc * 8]) = ra[i]; *(u32x4*)(&Bs[(sr + 32 * i) * GLD + sc * 8]) = rb[i]; }
  __syncthreads();
  for (int t = 0; t < nt; ++t) {
    if (t + 1 < nt) {
#pragma unroll
      for (int i = 0; i < 4; ++i) {
        ra[i] = *(const u32x4*)(Ag + (size_t)i * 32 * lda + (t + 1) * GBK);
        rb[i] = *(const u32x4*)(Bg + (size_t)i * 32 * K + (t + 1) * GBK);
      }
    }
    const bf16* as = As + (t & 1) * GBM * GLD + (wm * 64 + r) * GLD + 8 * h;
    const bf16* bs = Bs + (t & 1) * GBN * GLD + (wn * 64 + r) * GLD + 8 * h;
#pragma unroll
    for (int ks = 0; ks < 4; ++ks) {
      const bf16x8 a0 = *(const bf16x8*)(as + ks * 16), a1 = *(const bf16x8*)(as + 32 * GLD + ks * 16);
      const bf16x8 b0 = *(const bf16x8*)(bs + ks * 16), b1 = *(const bf16x8*)(bs + 32 * GLD + ks * 16);
      acc[0][0] = mfma32(a0, b0, acc[0][0]);
      acc[0][1] = mfma32(a0, b1, acc[0][1]);
      acc[1][0] = mfma32(a1, b0, acc[1][0]);
      acc[1][1] = mfma32(a1, b1, acc[1][1]);
    }
    if (t + 1 < nt) {
      const int nb = (t + 1) & 1;
#pragma unroll
      for (int i = 0; i < 4; ++i) {
        *(u32x4*)(&As[nb * GBM * GLD + (sr + 32 * i) * GLD + sc * 8]) = ra[i];
        *(u32x4*)(&Bs[nb * GBN * GLD + (sr + 32 * i) * GLD + sc * 8]) = rb[i];
      }
    }
    __syncthreads();
  }
#pragma unroll
  for (int mi = 0; mi < 2; ++mi)
#pragma unroll
    for (int ni = 0; ni < 2; ++ni)
#pragma unroll
      for (int i = 0; i < 16; ++i) {
        const int row = m0 + wm * 64 + mi * 32 + crow(i, h);
        const int col = n0 + wn * 64 + ni * 32 + r;
        const float v = acc[mi][ni][i];
        if constexpr (EPI == EPI_BF16) {
          int orow = row;
          if (e.rowmap) orow = row < NLAT ? (row / SEQ) * NKEY + NCX + (row % SEQ) : ((row - NLAT) / NCX) * NKEY + ((row - NLAT) % NCX);
          e.Cb[(size_t)orow * e.ldc + col] = (bf16)v;
        } else {
          if (row < NLAT) {
            const int b = row / SEQ;
            const float g = e.modl[(size_t)b * 6144 + e.gchunk * 1024 + col];
            e.out_lat[(size_t)row * DM + col] = e.res_lat[(size_t)row * DM + col] + g * v;
          } else {
            const int rc = row - NLAT;
            const float g = e.modl[(size_t)4 * 6144 + e.gchunk * 1024 + col];
            e.out_ctx[(size_t)rc * DM + col] = e.res_ctx[(size_t)rc * DM + col] + g * v;
          }
        }
      }
}
template <int EPI>
DI void gemm_phase(const bf16* __restrict__ A, int lda, const bf16* __restrict__ Bt, int K, const GemmEpi& e, int M, int N, char* smem) {
  const int ntn = N / GBN, nitems = (M / GBM) * ntn;
  for (int item = blockIdx.x; item < nitems; item += gridDim.x) {
    gemm_tile<EPI>(A, lda, Bt, K, e, (item / ntn) * GBM, (item % ntn) * GBN, smem);
  }
}

struct Post0 {
  const bf16* P;
  const float *aqn, *akn, *bqn, *bkn, *cs, *sn;
  bf16 *QA, *QB, *CQA, *CQB, *KA, *VA, *KB, *VB;
};
DI void qkv_post0_item(int row, const Post0& p) {
  const bool lat = row < NLAT;
  int b, t;
  if (lat) { b = row / SEQ; t = row % SEQ; } else { const int rc = row - NLAT; b = rc / NCX; t = rc % NCX; }
  const int key = lat ? NCX + t : t;
#pragma unroll
  for (int it = 0; it < 3; ++it) {
    const int i = threadIdx.x + 256 * it;
    const int slot = i >> 5, pi = i & 31;
    const bf16x2 pv = *(const bf16x2*)(p.P + (size_t)row * 1536 + slot * 64 + 2 * pi);
    float v0 = (float)pv[0], v1 = (float)pv[1];
    const bool isv = (slot == 10 || slot == 11 || slot == 22 || slot == 23);
    float ss = v0 * v0 + v1 * v1;
    for (int o = 16; o > 0; o >>= 1) ss += __shfl_xor(ss, o);
    if (!isv) {
      const float rs = rsqrtf(ss * (1.f / 64.f) + EPS);
      const float* g = slot < 8 ? p.aqn : slot < 10 ? p.akn : slot < 20 ? p.bqn : p.bkn;
      v0 = v0 * rs * g[2 * pi]; v1 = v1 * rs * g[2 * pi + 1];
      if (lat) {
        const float c = p.cs[t * 32 + pi], s = p.sn[t * 32 + pi];
        const float o0 = v0 * c - v1 * s, o1 = v0 * s + v1 * c;
        v0 = o0; v1 = o1;
      }
    }
    bf16x2 ov; ov[0] = (bf16)v0; ov[1] = (bf16)v1;
    bf16* dst;
    if (slot < 8) dst = lat ? p.QA + ((size_t)(b * 8 + slot) * SEQ + t) * 64 : p.CQA + ((size_t)(b * 8 + slot) * NCX + t) * 64;
    else if (slot < 10) dst = p.KA + ((size_t)(b * 2 + slot - 8) * NKEY + key) * 64;
    else if (slot < 12) dst = p.VA + ((size_t)(b * 2 + slot - 10) * NKEY + key) * 64;
    else if (slot < 20) dst = lat ? p.QB + ((size_t)(b * 8 + slot - 12) * SEQ + t) * 64 : p.CQB + ((size_t)(b * 8 + slot - 12) * NCX + t) * 64;
    else if (slot < 22) dst = p.KB + ((size_t)(b * 2 + slot - 20) * NKEY + key) * 64;
    else dst = p.VB + ((size_t)(b * 2 + slot - 22) * NKEY + key) * 64;
    *(bf16x2*)(dst + 2 * pi) = ov;
  }
}

struct AttnParams {
  const bf16* Q; long q_bs, q_hs; int q_ts;
  const bf16* K; long k_bs, k_hs; int k_ts;
  const bf16* K2; long k2_bs; int k2_ts;
  const bf16* V; long v_bs, v_hs; int v_ts;
  bf16* O; int o_row0, o_bs, o_col0;
  const float* sink;
  int nkeys;
  int G;
  int window;
  float scale_log2;
};

template <int DQK, int DV, int DSPLIT, int VBUFS>
DI void attn_item(const AttnParams& p, int qblk, int head, int b, char* smem) {
  constexpr int KCH = DQK / 8, VCH = DV / 8;
  constexpr int KPW = KCH / 4, VPW = VCH / 4;
  constexpr int KBYTES = 64 * DQK * 2, VBYTES = 64 * DV * 2;
  constexpr int NKS = DQK / 16, NDB = DV / 32;
  char* Kbase = smem;
  char* Vbase = smem + 2 * KBYTES;
  const int tid = threadIdx.x, lane = tid & 63, wave = tid >> 6;
  const int wave_u = __builtin_amdgcn_readfirstlane(wave);
  const int r = lane & 31, h = lane >> 5;
  const int q0 = qblk * 128;
  const int hkv = head / p.G;
  const int tq = q0 + wave * 32 + r;

  bf16x8 qf[NKS];
  {
    const bf16* qp = p.Q + (size_t)b * p.q_bs + (size_t)head * p.q_hs + (size_t)tq * p.q_ts + 8 * h;
#pragma unroll
    for (int ks = 0; ks < NKS; ++ks) qf[ks] = *(const bf16x8*)(qp + ks * 16);
  }
  int ntiles, lo = 0;
  if (p.window) {
    lo = q0 - 128 < 0 ? 0 : q0 - 128;
    const int hi = q0 + 256 > SEQ ? SEQ : q0 + 256;
    ntiles = 4 + (hi - lo) / 64;
  } else {
    ntiles = p.nkeys / 64;
  }
  const bf16* Kb = p.K + (size_t)b * p.k_bs + (size_t)hkv * p.k_hs;
  const bf16* K2b = (DSPLIT < DQK) ? p.K2 + (size_t)b * p.k2_bs : nullptr;
  const bf16* Vb = p.V + (size_t)b * p.v_bs + (size_t)hkv * p.v_hs;

  auto key0_of = [&](int j) -> int { return p.window ? (j < 4 ? j * 64 : NCX + lo + (j - 4) * 64) : j * 64; };
  auto issue_k = [&](int j, int buf) {
    const int k0 = key0_of(j);
#pragma unroll
    for (int i = 0; i < KPW; ++i) {
      const int I = wave_u + 4 * i;
      const int L = 64 * I + lane, row = L / KCH, slot = L % KCH;
      const int c = (slot & ~7) | ((slot ^ (row >> 1)) & 7);
      const bf16* src;
      if (DSPLIT == DQK || c * 8 < DSPLIT) src = Kb + (size_t)(k0 + row) * p.k_ts + c * 8;
      else src = K2b + (size_t)(k0 + row) * p.k2_ts + (c * 8 - DSPLIT);
      __builtin_amdgcn_global_load_lds((const unsigned*)src, (LAS unsigned*)(Kbase + buf * KBYTES + I * 1024), 16, 0, 0);
    }
  };
  auto issue_v = [&](int j, int buf) {
    const int k0 = key0_of(j);
#pragma unroll
    for (int i = 0; i < VPW; ++i) {
      const int I = wave_u + 4 * i;
      const int L = 64 * I + lane, row = L / VCH, slot = L % VCH;
      const int f = (DV == 128) ? (((row & 3) << 2) | ((row >> 2) & 3)) : (((row >> 1) & 1) << 2);
      const int ch = slot ^ f;
      const bf16* src = Vb + (size_t)(k0 + row) * p.v_ts + ch * 8;
      __builtin_amdgcn_global_load_lds((const unsigned*)src, (LAS unsigned*)(Vbase + buf * VBYTES + I * 1024), 16, 0, 0);
    }
  };

  f32x16 o[NDB];
#pragma unroll
  for (int d = 0; d < NDB; ++d)
#pragma unroll
    for (int i = 0; i < 16; ++i) o[d][i] = 0.f;
  float m = -1e30f, l = 0.f;
  const int i16 = lane & 15, q4 = i16 >> 2, p4 = i16 & 3, g1 = (lane >> 4) & 1;
  const int kswz = (r >> 1) & 7;

  __syncthreads();
  issue_k(0, 0);
  if (VBUFS == 2) issue_v(0, 0);
  for (int j = 0; j < ntiles; ++j) {
    asm volatile("s_waitcnt vmcnt(0)" ::: "memory");
    __syncthreads();
    if (VBUFS == 1) issue_v(j, 0);
    if (j + 1 < ntiles) { issue_k(j + 1, (j + 1) & 1); if (VBUFS == 2) issue_v(j + 1, (j + 1) & 1); }
    const bf16* Ks = (const bf16*)(Kbase + (j & 1) * KBYTES);
    const bf16* Vs = (const bf16*)(Vbase + (VBUFS == 2 ? (j & 1) * VBYTES : 0));

    f32x16 s[2];
#pragma unroll
    for (int mb = 0; mb < 2; ++mb) {
#pragma unroll
      for (int i = 0; i < 16; ++i) s[mb][i] = 0.f;
#pragma unroll
      for (int ks = 0; ks < NKS; ++ks) {
        const int c = 2 * ks + h;
        const int slot = (c & ~7) | ((c ^ kswz) & 7);
        const bf16x8 a = *(const bf16x8*)(&Ks[(mb * 32 + r) * DQK + 8 * slot]);
        s[mb] = mfma32(a, qf[ks], s[mb]);
      }
    }
    const bool band = p.window && j >= 4;
    const int pos0 = lo + (j - 4) * 64;
    float mx = -1e30f;
#pragma unroll
    for (int mb = 0; mb < 2; ++mb)
#pragma unroll
      for (int i = 0; i < 16; ++i) {
        float x = s[mb][i] * p.scale_log2;
        if (band) {
          const int dlt = pos0 + mb * 32 + crow(i, h) - tq;
          if (dlt > 128 || dlt < -128) x = -1e30f;
        }
        s[mb][i] = x;
        mx = fmaxf(mx, x);
      }
    mx = fmaxf(mx, __shfl_xor(mx, 32));
    const float mn = fmaxf(m, mx);
    const float alpha = __builtin_amdgcn_exp2f(m - mn);
    m = mn;
    float ls = 0.f;
#pragma unroll
    for (int mb = 0; mb < 2; ++mb)
#pragma unroll
      for (int i = 0; i < 16; ++i) {
        const float ev = __builtin_amdgcn_exp2f(s[mb][i] - mn);
        s[mb][i] = ev;
        ls += ev;
      }
    l = l * alpha + ls;
#pragma unroll
    for (int d = 0; d < NDB; ++d)
#pragma unroll
      for (int i = 0; i < 16; ++i) o[d][i] *= alpha;
    bf16x8 pf[2][2];
#pragma unroll
    for (int mb = 0; mb < 2; ++mb)
#pragma unroll
      for (int s2 = 0; s2 < 2; ++s2)
#pragma unroll
        for (int jj = 0; jj < 8; ++jj) pf[mb][s2][jj] = (bf16)s[mb][8 * s2 + jj];
    if (VBUFS == 1) {
      asm volatile("s_waitcnt vmcnt(0)" ::: "memory");
      __syncthreads();
    }
#pragma unroll
    for (int d = 0; d < NDB; ++d)
#pragma unroll
      for (int mb = 0; mb < 2; ++mb)
#pragma unroll
        for (int s2 = 0; s2 < 2; ++s2) {
          const int row = mb * 32 + 16 * s2 + 4 * h + q4;
          const int ch = d * 4 + 2 * g1 + (p4 >> 1);
          const int f0 = (DV == 128) ? ((q4 << 2) | ((row >> 2) & 3)) : (((row >> 1) & 1) << 2);
          const int f1 = (DV == 128) ? ((q4 << 2) | (((row + 8) >> 2) & 3)) : ((((row + 8) >> 1) & 1) << 2);
          const bf16* v0p = &Vs[row * DV + 8 * (ch ^ f0) + 4 * (p4 & 1)];
          const bf16* v1p = &Vs[(row + 8) * DV + 8 * (ch ^ f1) + 4 * (p4 & 1)];
          const bf16x4 vlo = __builtin_amdgcn_ds_read_tr16_b64_v4bf16((LAS bf16x4*)(v0p));
          const bf16x4 vhi = __builtin_amdgcn_ds_read_tr16_b64_v4bf16((LAS bf16x4*)(v1p));
          const bf16x8 a = __builtin_shufflevector(vlo, vhi, 0, 1, 2, 3, 4, 5, 6, 7);
          o[d] = mfma32(a, pf[mb][s2], o[d]);
        }
  }
  float lt = l + __shfl_xor(l, 32);
  if (p.sink) lt += __builtin_amdgcn_exp2f(p.sink[head] * LOG2E - m);
  const float inv = 1.f / lt;
  bf16* op = p.O + (size_t)(p.o_row0 + b * p.o_bs + tq) * DM + p.o_col0 + head * DV;
#pragma unroll
  for (int d = 0; d < NDB; ++d)
#pragma unroll
    for (int g = 0; g < 4; ++g) {
      bf16x4 ov;
#pragma unroll
      for (int jj = 0; jj < 4; ++jj) ov[jj] = (bf16)(o[d][4 * g + jj] * inv);
      *(bf16x4*)(op + d * 32 + 8 * g + 4 * h) = ov;
    }
}

struct PairTab { int i[50]; int j[50]; };
constexpr PairTab make_pairs() {
  PairTab t{}; int c = 0;
  for (int i = 0; i < 16; ++i) for (int j = 0; j < 16; ++j) if ((i + 1) * (j + 1) <= 16) { t.i[c] = i; t.j[c] = j; ++c; }
  return t;
}
constexpr PairTab PAIRS = make_pairs();
DI float as_f(unsigned u) { return __builtin_bit_cast(float, u); }
DI unsigned as_u(float f) { return __builtin_bit_cast(unsigned, f); }

DI void peer_select_item(int tile, int hhalf, const bf16* __restrict__ QP, const bf16* __restrict__ SK,
                         int* __restrict__ IDX, float* __restrict__ GW, char* smem) {
  unsigned (*lidx)[64][9] = (unsigned (*)[64][9])smem;
  const int tid = threadIdx.x, lane = tid & 63, wave = tid >> 6;
  const int r = lane & 31, h = lane >> 5;
  const int tok = tile * 32 + r;
  const int head = hhalf * 4 + wave;
  const float INF = __builtin_inff();
  float top[2][16];
#pragma unroll
  for (int p = 0; p < 2; ++p) {
    const bf16* qp = QP + (size_t)tok * 2048 + (head * 2 + p) * 128 + 8 * h;
    const bf16* kp = SK + ((size_t)(head * 2 + p) * 128 + r) * 128 + 8 * h;
    f32x16 acc[4];
#pragma unroll
    for (int nb = 0; nb < 4; ++nb)
#pragma unroll
      for (int i = 0; i < 16; ++i) acc[nb][i] = 0.f;
#pragma unroll 2
    for (int ks = 0; ks < 8; ++ks) {
      const bf16x8 bq = *(const bf16x8*)(qp + ks * 16);
#pragma unroll
      for (int nb = 0; nb < 4; ++nb) {
        const bf16x8 a = *(const bf16x8*)(kp + (size_t)nb * 32 * 128 + ks * 16);
        acc[nb] = mfma32(a, bq, acc[nb]);
      }
    }
#pragma unroll
    for (int nb = 0; nb < 4; ++nb)
#pragma unroll
      for (int i = 0; i < 16; ++i) acc[nb][i] = as_f((as_u(acc[nb][i]) & 0xFFFFFF80u) | (unsigned)(nb * 32 + crow(i, h)));
    float prev = INF;
#pragma unroll
    for (int k = 0; k < 16; ++k) {
      float best = -INF;
#pragma unroll
      for (int nb = 0; nb < 4; ++nb)
#pragma unroll
        for (int i = 0; i < 16; ++i) { const float v = acc[nb][i]; best = fmaxf(best, v < prev ? v : -INF); }
      best = fmaxf(best, __shfl_xor(best, 32));
      top[p][k] = best; prev = best;
    }
  }
  float cand[50];
#pragma unroll
  for (int c = 0; c < 50; ++c) {
    const float sum = top[0][PAIRS.i[c]] + top[1][PAIRS.j[c]];
    cand[c] = as_f((as_u(sum) & 0xFFFFFF00u) | (unsigned)(PAIRS.i[c] * 16 + PAIRS.j[c]));
  }
  float best2[16];
  {
    float prev = INF;
#pragma unroll
    for (int k = 0; k < 16; ++k) {
      float best = -INF;
#pragma unroll
      for (int c = 0; c < 50; ++c) { const float v = cand[c]; best = fmaxf(best, v < prev ? v : -INF); }
      best2[k] = best; prev = best;
    }
  }
  float ex[16], sum = 0.f;
#pragma unroll
  for (int k = 0; k < 16; ++k) { ex[k] = __expf(best2[k] - best2[0]); sum += ex[k]; }
  const float inv = 1.f / sum;
  unsigned* my = lidx[wave][lane];
#pragma unroll
  for (int q = 0; q < 4; ++q) {
    my[q] = (as_u(top[0][4 * q]) & 0x7Fu) | ((as_u(top[0][4 * q + 1]) & 0x7Fu) << 8) | ((as_u(top[0][4 * q + 2]) & 0x7Fu) << 16) | ((as_u(top[0][4 * q + 3]) & 0x7Fu) << 24);
    my[4 + q] = (as_u(top[1][4 * q]) & 0x7Fu) | ((as_u(top[1][4 * q + 1]) & 0x7Fu) << 8) | ((as_u(top[1][4 * q + 2]) & 0x7Fu) << 16) | ((as_u(top[1][4 * q + 3]) & 0x7Fu) << 24);
  }
#pragma unroll
  for (int k = 0; k < 16; ++k) {
    const unsigned code = as_u(best2[k]) & 0xFFu;
    const unsigned i = code >> 4, j = code & 15u;
    const unsigned e0 = (my[i >> 2] >> ((i & 3u) * 8u)) & 0x7Fu;
    const unsigned e1 = (my[4 + (j >> 2)] >> ((j & 3u) * 8u)) & 0x7Fu;
    if (h == 0) {
      IDX[(size_t)tok * 128 + head * 16 + k] = (int)(e0 * 128u + e1);
      GW[(size_t)tok * 128 + head * 16 + k] = ex[k] * inv;
    }
  }
}

typedef float f32x4v __attribute__((ext_vector_type(4)));
DI float gelu_exact(float x) { return 0.5f * x * (1.f + erff(x * 0.70710678118654752f)); }

DI void peer_apply_item(int item, const bf16* __restrict__ H2, const int* __restrict__ IDX, const float* __restrict__ GW,
                        const bf16* __restrict__ U, const bf16* __restrict__ V,
                        float* __restrict__ x_lat, float* __restrict__ x_ctx, const float* __restrict__ modl, char* smem) {
  bf16 (*hs)[DM] = (bf16 (*)[DM])smem;
  const int tid = threadIdx.x, lane = tid & 63, wave = tid >> 6;
  const int token = item * 4 + wave;
  const int col16 = lane & 15, kq = lane >> 4;
  __syncthreads();
  {
    const bf16* hp = H2 + (size_t)token * DM;
    *(u32x4*)(&hs[wave][8 * lane]) = *(const u32x4*)(hp + 8 * lane);
    *(u32x4*)(&hs[wave][512 + 8 * lane]) = *(const u32x4*)(hp + 512 + 8 * lane);
  }
  __syncthreads();
  const bf16* hbp = &hs[wave][8 * kq];
  const int id0 = IDX[(size_t)token * 128 + lane], id1 = IDX[(size_t)token * 128 + 64 + lane];
  float y[16];
#pragma unroll
  for (int i = 0; i < 16; ++i) y[i] = 0.f;
  for (int g = 0; g < 8; ++g) {
    const int idsel = g < 4 ? id0 : id1;
    const int e = __shfl(idsel, ((g * 16) & 63) + col16);
    const bf16* up = U + (size_t)e * DM + 8 * kq;
    f32x4v c = {0.f, 0.f, 0.f, 0.f};
#pragma unroll 1
    for (int s0 = 0; s0 < 32; s0 += 16) {
#pragma unroll
      for (int s = 0; s < 16; ++s) {
        const bf16x8 a = *(const bf16x8*)(up + 32 * (s0 + s));
        c = __builtin_amdgcn_mfma_f32_16x16x32_bf16(a, *(const bf16x8*)(hbp + 32 * (s0 + s)), c, 0, 0, 0);
      }
    }
    const float4 gw = *(const float4*)(GW + (size_t)token * 128 + g * 16 + kq * 4);
    float w[4];
    w[0] = gelu_exact(c[0]) * gw.x; w[1] = gelu_exact(c[1]) * gw.y; w[2] = gelu_exact(c[2]) * gw.z; w[3] = gelu_exact(c[3]) * gw.w;
#pragma unroll 1
    for (int q = 0; q < 4; ++q)
#pragma unroll
      for (int rg = 0; rg < 4; ++rg) {
        const float ws = as_f((unsigned)__builtin_amdgcn_readlane((int)as_u(w[rg]), q * 16));
        const int es = __builtin_amdgcn_readlane(idsel, ((g * 16) & 63) + q * 4 + rg);
        const bf16* vp = V + (size_t)es * DM + 8 * lane;
        const bf16x8 v0 = *(const bf16x8*)(vp), v1 = *(const bf16x8*)(vp + 512);
#pragma unroll
        for (int j = 0; j < 8; ++j) { y[j] += ws * (float)v0[j]; y[8 + j] += ws * (float)v1[j]; }
      }
  }
  float* xr; int b;
  if (token < NLAT) { xr = x_lat + (size_t)token * DM; b = token / SEQ; } else { xr = x_ctx + (size_t)(token - NLAT) * DM; b = 4; }
  const float* gate = modl + (size_t)b * 6144 + 5 * 1024;
#pragma unroll
  for (int half = 0; half < 2; ++half) {
    const int col = half * 512 + 8 * lane;
#pragma unroll
    for (int q = 0; q < 2; ++q) {
      float4 xv = *(float4*)(xr + col + 4 * q);
      const float4 gv = *(const float4*)(gate + col + 4 * q);
      xv.x += gv.x * y[half * 8 + 4 * q + 0]; xv.y += gv.y * y[half * 8 + 4 * q + 1];
      xv.z += gv.z * y[half * 8 + 4 * q + 2]; xv.w += gv.w * y[half * 8 + 4 * q + 3];
      *(float4*)(xr + col + 4 * q) = xv;
    }
  }
}

DI void mla_post1_item(int row, bf16* __restrict__ P1, const float* __restrict__ qan, const float* __restrict__ kvan,
                       const float* __restrict__ krn, const float* __restrict__ cs, const float* __restrict__ sn,
                       bf16* __restrict__ KPE, char* smem) {
  float* red = (float*)smem;
  const int tid = threadIdx.x, lane = tid & 63, wave = tid >> 6;
  bf16* pr = P1 + (size_t)row * 768;
  const int pa = tid, pb = tid + 256;
  const bool actb = pb < 352;
  const bf16x2 va = *(const bf16x2*)(pr + 2 * pa);
  float a0 = (float)va[0], a1 = (float)va[1];
  float b0 = 0.f, b1 = 0.f;
  if (actb) { const bf16x2 vb = *(const bf16x2*)(pr + 2 * pb); b0 = (float)vb[0]; b1 = (float)vb[1]; }
  float sa = a0 * a0 + a1 * a1, sb = b0 * b0 + b1 * b1;
  for (int o = 32; o > 0; o >>= 1) { sa += __shfl_xor(sa, o); sb += __shfl_xor(sb, o); }
  if (lane == 0) { red[wave] = sa; red[4 + wave] = sb; }
  __syncthreads();
  const float ss_q = red[0] + red[1] + red[2], ss_kv = red[3] + red[4], ss_kr = red[5];
  {
    const int e0 = 2 * pa;
    bf16x2 ov;
    if (wave < 3) { const float rs = rsqrtf(ss_q * (1.f / 384.f) + EPS); ov[0] = (bf16)(a0 * rs * qan[e0]); ov[1] = (bf16)(a1 * rs * qan[e0 + 1]); }
    else { const float rs = rsqrtf(ss_kv * (1.f / 256.f) + EPS); ov[0] = (bf16)(a0 * rs * kvan[e0 - 384]); ov[1] = (bf16)(a1 * rs * kvan[e0 - 383]); }
    *(bf16x2*)(pr + e0) = ov;
  }
  if (actb) {
    const int e0 = 2 * pb;
    if (wave == 0) {
      const float rs = rsqrtf(ss_kv * (1.f / 256.f) + EPS);
      bf16x2 ov; ov[0] = (bf16)(b0 * rs * kvan[e0 - 384]); ov[1] = (bf16)(b1 * rs * kvan[e0 - 383]);
      *(bf16x2*)(pr + e0) = ov;
    } else {
      const int pi = pb - 320;
      const float rs = rsqrtf(ss_kr * (1.f / 64.f) + EPS);
      float y0 = b0 * rs * krn[2 * pi], y1 = b1 * rs * krn[2 * pi + 1];
      int orow;
      if (row < NLAT) {
        const int b = row / SEQ, t = row % SEQ;
        const float c = cs[t * 32 + pi], s = sn[t * 32 + pi];
        const float o0 = y0 * c - y1 * s, o1 = y0 * s + y1 * c;
        y0 = o0; y1 = o1;
        orow = b * NKEY + NCX + t;
      } else {
        const int rc = row - NLAT;
        orow = (rc / NCX) * NKEY + (rc % NCX);
      }
      bf16x2 ov; ov[0] = (bf16)y0; ov[1] = (bf16)y1;
      *(bf16x2*)(KPE + (size_t)orow * 64 + 2 * pi) = ov;
    }
  }
  __syncthreads();
}

DI void mla_qpost_item(int row, bf16* __restrict__ Q, const float* __restrict__ qnn, const float* __restrict__ qnr,
                       const float* __restrict__ cs, const float* __restrict__ sn) {
  const int lane = threadIdx.x & 63, wave = threadIdx.x >> 6;
  const int t = row % SEQ;
#pragma unroll
  for (int hh = 0; hh < 2; ++hh) {
    const int head = wave + 4 * hh;
    bf16* qp = Q + (size_t)row * 1536 + head * 192;
    const bf16x2 nv = *(const bf16x2*)(qp + 2 * lane);
    float v0 = (float)nv[0], v1 = (float)nv[1];
    float ss = v0 * v0 + v1 * v1;
    for (int o = 32; o > 0; o >>= 1) ss += __shfl_xor(ss, o);
    const float rs = rsqrtf(ss * (1.f / 128.f) + EPS);
    bf16x2 ov; ov[0] = (bf16)(v0 * rs * qnn[2 * lane]); ov[1] = (bf16)(v1 * rs * qnn[2 * lane + 1]);
    float p0 = 0.f, p1 = 0.f;
    if (lane < 32) { const bf16x2 pv = *(const bf16x2*)(qp + 128 + 2 * lane); p0 = (float)pv[0]; p1 = (float)pv[1]; }
    float s2 = p0 * p0 + p1 * p1;
    for (int o = 32; o > 0; o >>= 1) s2 += __shfl_xor(s2, o);
    const float rs2 = rsqrtf(s2 * (1.f / 64.f) + EPS);
    *(bf16x2*)(qp + 2 * lane) = ov;
    if (lane < 32) {
      const float y0 = p0 * rs2 * qnr[2 * lane], y1 = p1 * rs2 * qnr[2 * lane + 1];
      const float c = cs[t * 32 + lane], s = sn[t * 32 + lane];
      bf16x2 pv; pv[0] = (bf16)(y0 * c - y1 * s); pv[1] = (bf16)(y0 * s + y1 * c);
      *(bf16x2*)(qp + 128 + 2 * lane) = pv;
    }
  }
}

DI void mla_kpost_item(int row, bf16* __restrict__ KV, const float* __restrict__ knn) {
  const int lane = threadIdx.x & 63, wave = threadIdx.x >> 6;
#pragma unroll
  for (int hh = 0; hh < 2; ++hh) {
    const int head = wave + 4 * hh;
    bf16* kp = KV + (size_t)row * 2048 + head * 256;
    const bf16x2 nv = *(const bf16x2*)(kp + 2 * lane);
    const float v0 = (float)nv[0], v1 = (float)nv[1];
    float ss = v0 * v0 + v1 * v1;
    for (int o = 32; o > 0; o >>= 1) ss += __shfl_xor(ss, o);
    const float rs = rsqrtf(ss * (1.f / 128.f) + EPS);
    bf16x2 ov; ov[0] = (bf16)(v0 * rs * knn[2 * lane]); ov[1] = (bf16)(v1 * rs * knn[2 * lane + 1]);
    *(bf16x2*)(kp + 2 * lane) = ov;
  }
}

struct MegaParams {
  const float *x, *c, *ctx, *c_ctx, *mod_w, *mod_b, *mix_norm, *ffn_norm, *even_w_in, *even_w_out, *a_q_norm, *a_k_norm, *b_q_norm,
      *b_k_norm, *b_sink, *mla_w_in, *mla_q_a_norm, *mla_kv_a_norm, *mla_w_uq, *mla_w_ukv, *mla_q_nope_norm, *mla_q_rope_norm,
      *mla_k_nope_norm, *mla_k_rope_norm, *mla_w_out, *peer_w_query, *peer_sub_keys, *peer_u, *peer_v;
  float* out;
  unsigned* bar;
  float *MOD, *RCS, *RSN, *CTXS;
  bf16 *W_EIN, *W_EOUT, *W_PQ, *W_MIN, *W_UQ, *W_UKV, *W_MOUT, *SKB, *HA, *HB, *UB, *VB2;
  int* IDX;
  float* GW;
  char* R;
};

__global__ __launch_bounds__(256, 2) void mega_kernel(MegaParams p) {
  __shared__ __attribute__((aligned(16))) char smem[SMEM_BYTES];
  __shared__ uint4 xb_words;
  if (threadIdx.x == 0) xb_words = make_uint4(0u, 0u, 0u, 0u);
  __syncthreads();
  XcdBarrier bar = xcd_barrier_post(p.bar, (volatile LAS unsigned*)&xb_words);
  const int G = gridDim.x, bid = blockIdx.x;

  bf16* P0 = (bf16*)p.R;
  bf16* QA = (bf16*)(p.R + (size_t)NTOK * 1536 * 2);
  bf16* QB = QA + (size_t)NB * 8 * SEQ * 64;
  bf16* CQA = QB + (size_t)NB * 8 * SEQ * 64;
  bf16* CQB = CQA + (size_t)NB * 8 * NCX * 64;
  bf16* KA = CQB + (size_t)NB * 8 * NCX * 64;
  bf16* VA = KA + (size_t)NB * 2 * NKEY * 64;
  bf16* KB = VA + (size_t)NB * 2 * NKEY * 64;
  bf16* VB = KB + (size_t)NB * 2 * NKEY * 64;
  bf16* QP = (bf16*)p.R;
  bf16* KPE = (bf16*)p.R;
  bf16* QRAW = KPE + (size_t)NB * NKEY * 64;
  bf16* KVRAW = QRAW + (size_t)NLAT * 1536;
  bf16* P1 = p.HB;
  const float* MOD0 = p.MOD;
  const float* MOD1 = p.MOD + 5 * 6144;

  for (int item = bid; item < 192; item += G) mod_item(item, p.c, p.c_ctx, p.mod_w, p.mod_b, p.MOD, smem);
  rope_phase(p.RCS, p.RSN);
  transpose_phase(p.even_w_in, p.W_EIN, 1024, 1536, 1536, smem);
  transpose_phase(p.even_w_out, p.W_EOUT, 1024, 1024, 1024, smem);
  transpose_phase(p.peer_w_query, p.W_PQ, 1024, 2048, 2048, smem);
  transpose_phase(p.peer_w_query + (size_t)1024 * 2048, p.W_PQ + (size_t)2048 * 1024, 1024, 2048, 2048, smem);
  transpose_phase(p.mla_w_in, p.W_MIN, 1024, 704, 768, smem);
  transpose_phase(p.mla_w_uq, p.W_UQ, 384, 1536, 1536, smem);
  transpose_phase(p.mla_w_ukv, p.W_UKV, 256, 2048, 2048, smem);
  transpose_phase(p.mla_w_out, p.W_MOUT, 1024, 1024, 1024, smem);
  convert_phase((const float4*)p.peer_sub_keys, (bf16x4*)p.SKB, (size_t)2 * 16 * 128 * 128 / 4);
  convert_phase((const float4*)p.peer_u, (bf16x4*)p.UB, (size_t)16384 * 1024 / 4);
  convert_phase((const float4*)p.peer_v, (bf16x4*)p.VB2, (size_t)16384 * 1024 / 4);
  xcd_barrier(bar);

  for (int row = bid; row < NTOK; row += G) norm_mod_item(row, p.x, p.ctx, p.mix_norm, MOD0, 0, p.HA, smem);
  xcd_barrier(bar);
  {
    GemmEpi e{}; e.Cb = P0; e.ldc = 1536;
    gemm_phase<EPI_BF16>(p.HA, 1024, p.W_EIN, 1024, e, NTOK, 1536, smem);
  }
  xcd_barrier(bar);
  {
    Post0 q{}; q.P = P0; q.aqn = p.a_q_norm; q.akn = p.a_k_norm; q.bqn = p.b_q_norm; q.bkn = p.b_k_norm; q.cs = p.RCS; q.sn = p.RSN;
    q.QA = QA; q.QB = QB; q.CQA = CQA; q.CQB = CQB; q.KA = KA; q.VA = VA; q.KB = KB; q.VB = VB;
    for (int row = bid; row < NTOK; row += G) qkv_post0_item(row, q);
  }
  xcd_barrier(bar);
  {
    for (int item = bid; item < 4224; item += G) {
      AttnParams a{};
      const bool isB = (item >= 2048 && item < 4096) || item >= 4160;
      const bool isC = item >= 4096;
      a.q_ts = 64; a.k_ts = 64; a.v_ts = 64; a.G = 4; a.scale_log2 = 0.125f * LOG2E;
      a.K = isB ? KB : KA; a.V = isB ? VB : VA;
      a.k_bs = (long)2 * NKEY * 64; a.k_hs = (long)NKEY * 64; a.v_bs = a.k_bs; a.v_hs = a.k_hs;
      a.O = p.HB; a.o_col0 = isB ? 512 : 0; a.sink = isB ? p.b_sink : nullptr;
      int qblk, head, b;
      if (!isC) {
        const int li = item & 2047;
        qblk = li & 63; head = (li >> 6) & 7; b = li >> 9;
        a.Q = isB ? QB : QA; a.q_bs = (long)8 * SEQ * 64; a.q_hs = (long)SEQ * 64;
        a.o_row0 = 0; a.o_bs = SEQ; a.nkeys = NKEY; a.window = isB ? 1 : 0;
      } else {
        const int li = (item - 4096) & 63;
        qblk = li & 1; head = (li >> 1) & 7; b = li >> 4;
        a.Q = isB ? CQB : CQA; a.q_bs = (long)8 * NCX * 64; a.q_hs = (long)NCX * 64;
        a.o_row0 = NLAT; a.o_bs = NCX; a.nkeys = NCX; a.window = 0;
      }
      attn_item<64, 64, 64, 2>(a, qblk, head, b, smem);
    }
  }
  xcd_barrier(bar);
  {
    GemmEpi e{}; e.out_lat = p.out; e.res_lat = p.x; e.out_ctx = p.CTXS; e.res_ctx = p.ctx; e.modl = MOD0; e.gchunk = 2;
    gemm_phase<EPI_RESID>(p.HB, 1024, p.W_EOUT, 1024, e, NTOK, 1024, smem);
  }
  xcd_barrier(bar);
  for (int row = bid; row < NTOK; row += G) norm_mod_item(row, p.out, p.CTXS, p.ffn_norm, MOD0, 3, p.HA, smem);
  xcd_barrier(bar);
  {
    GemmEpi e{}; e.Cb = QP; e.ldc = 2048;
    gemm_phase<EPI_BF16>(p.HA, 1024, p.W_PQ, 1024, e, NTOK, 2048, smem);
  }
  xcd_barrier(bar);
#ifndef SKIP_SEL
  for (int item = bid; item < (NTOK / 32) * 2; item += G) peer_select_item(item >> 1, item & 1, QP, p.SKB, p.IDX, p.GW, smem);
#endif
  xcd_barrier(bar);
  for (int item = bid; item < NTOK / 4; item += G) peer_apply_item(item, p.HA, p.IDX, p.GW, p.UB, p.VB2, p.out, p.CTXS, MOD0, smem);
  xcd_barrier(bar);

  for (int row = bid; row < NTOK; row += G) norm_mod_item(row, p.out, p.CTXS, p.mix_norm + 1024, MOD1, 0, p.HA, smem);
  convert_phase((const float4*)(p.peer_u + (size_t)16384 * 1024), (bf16x4*)p.UB, (size_t)16384 * 1024 / 4);
  convert_phase((const float4*)(p.peer_v + (size_t)16384 * 1024), (bf16x4*)p.VB2, (size_t)16384 * 1024 / 4);
  xcd_barrier(bar);
  {
    GemmEpi e{}; e.Cb = P1; e.ldc = 768;
    gemm_phase<EPI_BF16>(p.HA, 1024, p.W_MIN, 1024, e, NTOK, 768, smem);
  }
  xcd_barrier(bar);
  for (int row = bid; row < NTOK; row += G) mla_post1_item(row, P1, p.mla_q_a_norm, p.mla_kv_a_norm, p.mla_k_rope_norm, p.RCS, p.RSN, KPE, smem);
  xcd_barrier(bar);
  {
    GemmEpi e{}; e.Cb = QRAW; e.ldc = 1536;
    gemm_phase<EPI_BF16>(P1, 768, p.W_UQ, 384, e, NLAT, 1536, smem);
    GemmEpi e2{}; e2.Cb = KVRAW; e2.ldc = 2048; e2.rowmap = 1;
    gemm_phase<EPI_BF16>(P1 + 384, 768, p.W_UKV, 256, e2, NTOK, 2048, smem);
  }
  xcd_barrier(bar);
  for (int row = bid; row < NLAT; row += G) mla_qpost_item(row, QRAW, p.mla_q_nope_norm, p.mla_q_rope_norm, p.RCS, p.RSN);
  for (int row = bid; row < NB * NKEY; row += G) mla_kpost_item(row, KVRAW, p.mla_k_nope_norm);
  xcd_barrier(bar);
  {
    AttnParams a{}; a.Q = QRAW; a.q_bs = (long)SEQ * 1536; a.q_hs = 192; a.q_ts = 1536;
    a.K = KVRAW; a.k_bs = (long)NKEY * 2048; a.k_hs = 256; a.k_ts = 2048;
    a.K2 = KPE; a.k2_bs = (long)NKEY * 64; a.k2_ts = 64;
    a.V = KVRAW + 128; a.v_bs = (long)NKEY * 2048; a.v_hs = 256; a.v_ts = 2048;
    a.O = p.HA; a.o_row0 = 0; a.o_bs = SEQ; a.o_col0 = 0; a.sink = nullptr; a.nkeys = NKEY; a.G = 1; a.window = 0;
    a.scale_log2 = 0.07216878364870322f * LOG2E;
#ifndef SKIP_MLA
    for (int item = bid; item < 2048; item += G) attn_item<192, 128, 128, 1>(a, item & 63, (item >> 6) & 7, item >> 9, smem);
#endif
  }
  xcd_barrier(bar);
  {
    GemmEpi e{}; e.out_lat = p.out; e.res_lat = p.out; e.out_ctx = p.CTXS; e.res_ctx = p.CTXS; e.modl = MOD1; e.gchunk = 2;
    gemm_phase<EPI_RESID>(p.HA, 1024, p.W_MOUT, 1024, e, NLAT, 1024, smem);
  }
  xcd_barrier(bar);
  for (int row = bid; row < NLAT; row += G) norm_mod_item(row, p.out, p.CTXS, p.ffn_norm + 1024, MOD1, 3, p.HB, smem);
  xcd_barrier(bar);
  {
    GemmEpi e{}; e.Cb = QP; e.ldc = 2048;
    gemm_phase<EPI_BF16>(p.HB, 1024, p.W_PQ + (size_t)2048 * 1024, 1024, e, NLAT, 2048, smem);
  }
  xcd_barrier(bar);
#ifndef SKIP_SEL
  for (int item = bid; item < (NLAT / 32) * 2; item += G) peer_select_item(item >> 1, item & 1, QP, p.SKB + (size_t)16 * 128 * 128, p.IDX, p.GW, smem);
#endif
  xcd_barrier(bar);
  for (int item = bid; item < NLAT / 4; item += G) peer_apply_item(item, p.HB, p.IDX, p.GW, p.UB, p.VB2, p.out, p.CTXS, MOD1, smem);
}

static inline size_t align_up(size_t v, size_t a) { return (v + a - 1) / a * a; }

extern "C" void kernel_launch(void* const* d_in, const int* in_sizes, int n_in,
                              void* d_out, int out_size, void* d_ws, size_t ws_size,
                              hipStream_t stream) {
  MegaParams p{};
  const float** fp = (const float**)&p;
  for (int i = 0; i < 29; ++i) fp[i] = (const float*)d_in[i];
  p.out = (float*)d_out;
  char* w = (char*)d_ws;
  size_t off = 0;
  auto take = [&](size_t bytes) { char* q = w + off; off = align_up(off + bytes, 256); return q; };
  p.bar = (unsigned*)take(XCD_BAR_WORDS * 4);
  p.MOD = (float*)take(2 * 5 * 6144 * 4);
  p.RCS = (float*)take((size_t)SEQ * 32 * 4);
  p.RSN = (float*)take((size_t)SEQ * 32 * 4);
  p.CTXS = (float*)take((size_t)NCTXT * DM * 4);
  p.W_EIN = (bf16*)take((size_t)1536 * 1024 * 2);
  p.W_EOUT = (bf16*)take((size_t)1024 * 1024 * 2);
  p.W_PQ = (bf16*)take((size_t)2 * 2048 * 1024 * 2);
  p.W_MIN = (bf16*)take((size_t)768 * 1024 * 2);
  p.W_UQ = (bf16*)take((size_t)1536 * 384 * 2);
  p.W_UKV = (bf16*)take((size_t)2048 * 256 * 2);
  p.W_MOUT = (bf16*)take((size_t)1024 * 1024 * 2);
  p.SKB = (bf16*)take((size_t)2 * 16 * 128 * 128 * 2);
  p.HA = (bf16*)take((size_t)NTOK * DM * 2);
  p.HB = (bf16*)take((size_t)NTOK * DM * 2);
  p.UB = (bf16*)take((size_t)16384 * 1024 * 2);
  p.VB2 = (bf16*)take((size_t)16384 * 1024 * 2);
  p.IDX = (int*)take((size_t)NTOK * 128 * 4);
  p.GW = (float*)take((size_t)NTOK * 128 * 4);
  p.R = take((size_t)250 * 1024 * 1024);

  static int grid = 0;
  if (!grid) {
    int dev = 0, cus = 0, per_cu = 0;
    hipGetDevice(&dev);
    hipDeviceGetAttribute(&cus, hipDeviceAttributeMultiprocessorCount, dev);
    hipOccupancyMaxActiveBlocksPerMultiprocessor(&per_cu, mega_kernel, 256, 0);
    if (per_cu > 2) per_cu = 2;
    if (per_cu < 1) per_cu = 1;
    grid = cus * per_cu;
  }
  hipMemsetAsync(p.bar, 0, XCD_BAR_WORDS * 4, stream);
  mega_kernel<<<grid, 256, 0, stream>>>(p);
}
```

```cpp
#include <hip/hip_runtime.h>
#include <stdint.h>

typedef __bf16 bf16;
typedef __bf16 bf16x8 __attribute__((ext_vector_type(8)));
typedef __bf16 bf16x4 __attribute__((ext_vector_type(4)));
typedef __bf16 bf16x2 __attribute__((ext_vector_type(2)));
typedef float f32x16 __attribute__((ext_vector_type(16)));
typedef unsigned u32x4 __attribute__((ext_vector_type(4)));
#define LAS __attribute__((address_space(3)))
#define DI __device__ __forceinline__

constexpr int DM = 1024, NB = 4, SEQ = 8192, NCX = 256;
constexpr int NLAT = NB * SEQ, NCTXT = NB * NCX, NTOK = NLAT + NCTXT, NKEY = SEQ + NCX;
constexpr float EPS = 1e-6f;
constexpr float LOG2E = 1.4426950408889634f;

DI int crow(int i, int h) { return (i & 3) + 8 * (i >> 2) + 4 * h; }
DI f32x16 mfma32(bf16x8 a, bf16x8 b, f32x16 c) { return __builtin_amdgcn_mfma_f32_32x32x16_bf16(a, b, c, 0, 0, 0); }
DI float silu(float v) { return v / (1.f + __expf(-v)); }


#define XB_TMO      128
#define XB_XCNT(j)  (256  + 64 * (j))
#define XB_XSUB(j)  (1280 + 64 * (j))
#define XB_XGEN(j)  (2304 + 64 * (j))
#define XB_TOP      3328
#define XB_TOPGEN   3392
#define XCD_BAR_WORDS 3456
#define XB_SPIN_CAP (1u << 18)

__device__ __forceinline__ unsigned xb_ld(unsigned* p)              { return __hip_atomic_load(p, __ATOMIC_RELAXED, __HIP_MEMORY_SCOPE_AGENT); }
__device__ __forceinline__ unsigned xb_add(unsigned* p, unsigned v) { return __hip_atomic_fetch_add(p, v, __ATOMIC_RELAXED, __HIP_MEMORY_SCOPE_AGENT); }
__device__ __forceinline__ unsigned xb_xcc_id() { return (unsigned)__builtin_amdgcn_s_getreg((3 << 11) | 20) & 0xFu; }
#define XB_SPIN(cond, bar) do { unsigned _sp = 0; while (cond) { __builtin_amdgcn_s_sleep(1); \
    if ((++_sp & 255u) == 0u) { if (xb_ld(&(bar)[XB_TMO])) break; if (_sp > XB_SPIN_CAP) { atomicAdd(&(bar)[XB_TMO], 1u); break; } } } } while (0)

struct XcdBarrier { unsigned* bar; unsigned x; volatile LAS unsigned* st; };

__device__ __forceinline__ XcdBarrier xcd_barrier_post(unsigned* bar, volatile LAS unsigned* st) {
    XcdBarrier b; b.bar = bar; b.x = xb_xcc_id(); b.st = st;
    if (threadIdx.x == 0) (void)xb_add(&bar[XB_XCNT(b.x)], 1u);
    return b;
}
__device__ __forceinline__ void xcd_barrier_complete(unsigned* bar, unsigned x, unsigned& nloc, unsigned& nx) {
    const unsigned G = gridDim.x * gridDim.y * gridDim.z;
    unsigned sum, cnt, mine, sp = 0u;
    for (;;) {
        sum = 0u; cnt = 0u; mine = 0u;
#pragma unroll
        for (unsigned j = 0; j < 16; ++j) { const unsigned c = xb_ld(&bar[XB_XCNT(j)]); sum += c; cnt += (c > 0u) ? 1u : 0u; mine = (j == x) ? c : mine; }
        if (sum == G) break;
        __builtin_amdgcn_s_sleep(1);
        if ((++sp & 255u) == 0u) { if (xb_ld(&bar[XB_TMO])) break; if (sp > XB_SPIN_CAP) { atomicAdd(&bar[XB_TMO], 1u); break; } }
    }
    nloc = mine > 0u ? mine : 1u; nx = cnt > 0u ? cnt : 1u;
}
__device__ __forceinline__ void xcd_barrier(const XcdBarrier& b) {
    asm volatile("s_waitcnt vmcnt(0)" ::: "memory");
    __syncthreads();
    if (threadIdx.x == 0) {
        unsigned* bar = b.bar;
        __builtin_amdgcn_s_waitcnt(0);
        unsigned nloc = b.st[0], nx = b.st[1];
        if (nloc == 0u) { xcd_barrier_complete(bar, b.x, nloc, nx); b.st[0] = nloc; b.st[1] = nx; }
        const unsigned old = xb_add(&bar[XB_XSUB(b.x)], 1u);
        const unsigned gen = old / nloc;
        if (old + 1u == (gen + 1u) * nloc) {
            __builtin_amdgcn_fence(__ATOMIC_RELEASE, "agent");
            asm volatile("s_waitcnt vmcnt(0)" ::: "memory");
            const unsigned og = xb_add(&bar[XB_TOP], 1u);
            const unsigned tg = og / nx;
            if (og + 1u == (tg + 1u) * nx) xb_add(&bar[XB_TOPGEN], 1u);
            else XB_SPIN(xb_ld(&bar[XB_TOPGEN]) == tg, bar);
            __builtin_amdgcn_fence(__ATOMIC_ACQUIRE, "agent");
            xb_add(&bar[XB_XGEN(b.x)], 1u);
            asm volatile("s_waitcnt vmcnt(0)" ::: "memory");
        } else {
            XB_SPIN(xb_ld(&bar[XB_XGEN(b.x)]) == gen, bar);
            __builtin_amdgcn_fence(__ATOMIC_ACQUIRE, "agent");
            asm volatile("s_waitcnt vmcnt(0)" ::: "memory");
        }
    }
    __syncthreads();
}

constexpr int SMEM_BYTES = 73728;

DI void mod_item(int item, const float* __restrict__ c, const float* __restrict__ c_ctx, const float* __restrict__ mod_w,
                 const float* __restrict__ mod_b, float* __restrict__ mod, char* smem) {
  float (*sv)[1024] = (float (*)[1024])smem;
  float (*part)[5][64] = (float (*)[5][64])(smem + 5 * 1024 * 4);
  const int tid = threadIdx.x, l = item / 96, bx = item % 96;
  for (int i = tid; i < 5 * 1024; i += 256) {
    const int b = i >> 10, k = i & 1023;
    const float v = b < 4 ? c[b * 1024 + k] : c_ctx[k];
    sv[b][k] = silu(v);
  }
  __syncthreads();
  const int nn = tid & 63, kg = tid >> 6;
  const int n = bx * 64 + nn;
  const float* w = mod_w + (size_t)l * 1024 * 6144 + n;
  float a0 = 0, a1 = 0, a2 = 0, a3 = 0, a4 = 0;
  for (int k = kg * 256; k < kg * 256 + 256; ++k) {
    const float wv = w[(size_t)k * 6144];
    a0 += sv[0][k] * wv; a1 += sv[1][k] * wv; a2 += sv[2][k] * wv; a3 += sv[3][k] * wv; a4 += sv[4][k] * wv;
  }
  part[kg][0][nn] = a0; part[kg][1][nn] = a1; part[kg][2][nn] = a2; part[kg][3][nn] = a3; part[kg][4][nn] = a4;
  __syncthreads();
  for (int i = tid; i < 5 * 64; i += 256) {
    const int b = i >> 6, j = i & 63;
    const float s = part[0][b][j] + part[1][b][j] + part[2][b][j] + part[3][b][j];
    mod[((size_t)l * 5 + b) * 6144 + bx * 64 + j] = s + mod_b[(size_t)l * 6144 + bx * 64 + j];
  }
  __syncthreads();
}

DI void rope_phase(float* __restrict__ cs, float* __restrict__ sn) {
  for (int idx = blockIdx.x * 256 + threadIdx.x; idx < SEQ * 32; idx += gridDim.x * 256) {
    const int t = idx >> 5, i = idx & 31;
    const int row = t >> 6, col = t & 63;
    const int fi = i & 15;
    const float inv = powf(10000.f, -(float)(2 * fi) / 32.f);
    const float ang = (i < 16 ? (float)row : (float)col) * inv;
    cs[idx] = cosf(ang);
    sn[idx] = sinf(ang);
  }
}

DI void transpose_item(int item, const float* __restrict__ W, bf16* __restrict__ Wt, int K, int N, int Npad, char* smem) {
  float (*tile)[33] = (float (*)[33])smem;
  const int tx = threadIdx.x & 31, ty = threadIdx.x >> 5;
  const int ntn = Npad / 32;
  const int n0 = (item % ntn) * 32, k0 = (item / ntn) * 32;
  for (int j = ty; j < 32; j += 8) {
    const int k = k0 + j, n = n0 + tx;
    tile[j][tx] = (n < N) ? W[(size_t)k * N + n] : 0.f;
  }
  __syncthreads();
  for (int j = ty; j < 32; j += 8) {
    const int n = n0 + j, k = k0 + tx;
    Wt[(size_t)n * K + k] = (bf16)tile[tx][j];
  }
  __syncthreads();
}
DI void transpose_phase(const float* __restrict__ W, bf16* __restrict__ Wt, int K, int N, int Npad, char* smem) {
  const int nitems = (Npad / 32) * (K / 32);
  for (int item = blockIdx.x; item < nitems; item += gridDim.x) transpose_item(item, W, Wt, K, N, Npad, smem);
}

DI void convert_phase(const float4* __restrict__ src, bf16x4* __restrict__ dst, size_t n4) {
  for (size_t i = blockIdx.x * (size_t)256 + threadIdx.x; i < n4; i += (size_t)gridDim.x * 256) {
    const float4 v = src[i];
    bf16x4 o; o[0] = (bf16)v.x; o[1] = (bf16)v.y; o[2] = (bf16)v.z; o[3] = (bf16)v.w;
    dst[i] = o;
  }
}


DI void convert_fp8_phase(const float4* __restrict__ src, unsigned* __restrict__ dst, size_t n4, float scale) {
  for (size_t i = blockIdx.x * (size_t)256 + threadIdx.x; i < n4; i += (size_t)gridDim.x * 256) {
    const float4 v = src[i];
    int w = 0;
    w = __builtin_amdgcn_cvt_pk_fp8_f32(v.x * scale, v.y * scale, w, false);
    w = __builtin_amdgcn_cvt_pk_fp8_f32(v.z * scale, v.w * scale, w, true);
    dst[i] = (unsigned)w;
  }
}

DI void norm_mod_item(int row, const float* __restrict__ src_lat, const float* __restrict__ src_ctx, const float* __restrict__ gain,
                      const float* __restrict__ modl, int chunk, bf16* __restrict__ H, char* smem) {
  float* red = (float*)smem;
  const int tid = threadIdx.x;
  const float* src; int b;
  if (row < NLAT) { src = src_lat + (size_t)row * DM; b = row / SEQ; } else { src = src_ctx + (size_t)(row - NLAT) * DM; b = 4; }
  const float4 v = ((const float4*)src)[tid];
  float ss = v.x * v.x + v.y * v.y + v.z * v.z + v.w * v.w;
  for (int o = 32; o > 0; o >>= 1) ss += __shfl_xor(ss, o);
  if ((tid & 63) == 0) red[tid >> 6] = ss;
  __syncthreads();
  ss = red[0] + red[1] + red[2] + red[3];
  const float rs = rsqrtf(ss * (1.f / DM) + EPS);
  const float4 g = ((const float4*)gain)[tid];
  const float4 sh = ((const float4*)(modl + (size_t)b * 6144 + chunk * 1024))[tid];
  const float4 sc = ((const float4*)(modl + (size_t)b * 6144 + (chunk + 1) * 1024))[tid];
  bf16x4 o;
  o[0] = (bf16)(v.x * rs * g.x * (1.f + sc.x) + sh.x);
  o[1] = (bf16)(v.y * rs * g.y * (1.f + sc.y) + sh.y);
  o[2] = (bf16)(v.z * rs * g.z * (1.f + sc.z) + sh.z);
  o[3] = (bf16)(v.w * rs * g.w * (1.f + sc.w) + sh.w);
  ((bf16x4*)(H + (size_t)row * DM))[tid] = o;
  __syncthreads();
}

constexpr int GBM = 128, GBN = 128, GBK = 64, GLD = 72;
enum { EPI_BF16 = 0, EPI_RESID = 1 };
struct GemmEpi {
  bf16* Cb; int ldc; int rowmap;
  float* out_lat; const float* res_lat; float* out_ctx; const float* res_ctx; const float* modl; int gchunk;
};

template <int EPI>
DI void gemm_tile(const bf16* __restrict__ A, int lda, const bf16* __restrict__ Bt, int K, const GemmEpi& e, int m0, int n0, char* smem) {
  bf16* As = (bf16*)smem;
  bf16* Bs = (bf16*)(smem + 2 * GBM * GLD * 2);
  const int tid = threadIdx.x, lane = tid & 63, wave = tid >> 6, wm = wave >> 1, wn = wave & 1;
  const int r = lane & 31, h = lane >> 5;
  const int sc = tid & 7, sr = tid >> 3;
  const bf16* Ag = A + (size_t)(m0 + sr) * lda + sc * 8;
  const bf16* Bg = Bt + (size_t)(n0 + sr) * K + sc * 8;
  u32x4 ra[4], rb[4];
  f32x16 acc[2][2];
#pragma unroll
  for (int i = 0; i < 2; ++i)
#pragma unroll
    for (int j = 0; j < 2; ++j)
#pragma unroll
      for (int q = 0; q < 16; ++q) acc[i][j][q] = 0.f;
  const int nt = K / GBK;
#pragma unroll
  for (int i = 0; i < 4; ++i) { ra[i] = *(const u32x4*)(Ag + (size_t)i * 32 * lda); rb[i] = *(const u32x4*)(Bg + (size_t)i * 32 * K); }
#pragma unroll
  for (int i = 0; i < 4; ++i) { *(u32x4*)(&As[(sr + 32 * i) * GLD + sc * 8]) = ra[i]; *(u32x4*)(&Bs[(sr + 32 * i) * GLD + sc * 8]) = rb[i]; }
  __syncthreads();
  for (int t = 0; t < nt; ++t) {
    if (t + 1 < nt) {
#pragma unroll
      for (int i = 0; i < 4; ++i) {
        ra[i] = *(const u32x4*)(Ag + (size_t)i * 32 * lda + (t + 1) * GBK);
        rb[i] = *(const u32x4*)(Bg + (size_t)i * 32 * K + (t + 1) * GBK);
      }
    }
    const bf16* as = As + (t & 1) * GBM * GLD + (wm * 64 + r) * GLD + 8 * h;
    const bf16* bs = Bs + (t & 1) * GBN * GLD + (wn * 64 + r) * GLD + 8 * h;
#pragma unroll
    for (int ks = 0; ks < 4; ++ks) {
      const bf16x8 a0 = *(const bf16x8*)(as + ks * 16), a1 = *(const bf16x8*)(as + 32 * GLD + ks * 16);
      const bf16x8 b0 = *(const bf16x8*)(bs + ks * 16), b1 = *(const bf16x8*)(bs + 32 * GLD + ks * 16);
      acc[0][0] = mfma32(a0, b0, acc[0][0]);
      acc[0][1] = mfma32(a0, b1, acc[0][1]);
      acc[1][0] = mfma32(a1, b0, acc[1][0]);
      acc[1][1] = mfma32(a1, b1, acc[1][1]);
    }
    if (t + 1 < nt) {
      const int nb = (t + 1) & 1;
#pragma unroll
      for (int i = 0; i < 4; ++i) {
        *(u32x4*)(&As[nb * GBM * GLD + (sr + 32 * i) * GLD + sc * 8]) = ra[i];
        *(u32x4*)(&Bs[nb * GBN * GLD + (sr + 32 * i) * GLD + sc * 8]) = rb[i];
      }
    }
    __syncthreads();
  }
#pragma unroll
  for (int mi = 0; mi < 2; ++mi)
#pragma unroll
    for (int ni = 0; ni < 2; ++ni)
#pragma unroll
      for (int i = 0; i < 16; ++i) {
        const int row = m0 + wm * 64 + mi * 32 + crow(i, h);
        const int col = n0 + wn * 64 + ni * 32 + r;
        const float v = acc[mi][ni][i];
        if constexpr (EPI == EPI_BF16) {
          int orow = row;
          if (e.rowmap) orow = row < NLAT ? (row / SEQ) * NKEY + NCX + (row % SEQ) : ((row - NLAT) / NCX) * NKEY + ((row - NLAT) % NCX);
          e.Cb[(size_t)orow * e.ldc + col] = (bf16)v;
        } else {
          if (row < NLAT) {
            const int b = row / SEQ;
            const float g = e.modl[(size_t)b * 6144 + e.gchunk * 1024 + col];
            e.out_lat[(size_t)row * DM + col] = e.res_lat[(size_t)row * DM + col] + g * v;
          } else {
            const int rc = row - NLAT;
            const float g = e.modl[(size_t)4 * 6144 + e.gchunk * 1024 + col];
            e.out_ctx[(size_t)rc * DM + col] = e.res_ctx[(size_t)rc * DM + col] + g * v;
          }
        }
      }
}
template <int EPI>
DI void gemm_phase(const bf16* __restrict__ A, int lda, const bf16* __restrict__ Bt, int K, const GemmEpi& e, int M, int N, char* smem) {
  const int ntn = N / GBN, nitems = (M / GBM) * ntn;
  for (int item = blockIdx.x; item < nitems; item += gridDim.x) {
    gemm_tile<EPI>(A, lda, Bt, K, e, (item / ntn) * GBM, (item % ntn) * GBN, smem);
  }
}

struct Post0 {
  const bf16* P;
  const float *aqn, *akn, *bqn, *bkn, *cs, *sn;
  bf16 *QA, *QB, *CQA, *CQB, *KA, *VA, *KB, *VB;
};
DI void qkv_post0_item(int row, const Post0& p) {
  const bool lat = row < NLAT;
  int b, t;
  if (lat) { b = row / SEQ; t = row % SEQ; } else { const int rc = row - NLAT; b = rc / NCX; t = rc % NCX; }
  const int key = lat ? NCX + t : t;
#pragma unroll
  for (int it = 0; it < 3; ++it) {
    const int i = threadIdx.x + 256 * it;
    const int slot = i >> 5, pi = i & 31;
    const bf16x2 pv = *(const bf16x2*)(p.P + (size_t)row * 1536 + slot * 64 + 2 * pi);
    float v0 = (float)pv[0], v1 = (float)pv[1];
    const bool isv = (slot == 10 || slot == 11 || slot == 22 || slot == 23);
    float ss = v0 * v0 + v1 * v1;
    for (int o = 16; o > 0; o >>= 1) ss += __shfl_xor(ss, o);
    if (!isv) {
      const float rs = rsqrtf(ss * (1.f / 64.f) + EPS);
      const float* g = slot < 8 ? p.aqn : slot < 10 ? p.akn : slot < 20 ? p.bqn : p.bkn;
      v0 = v0 * rs * g[2 * pi]; v1 = v1 * rs * g[2 * pi + 1];
      if (lat) {
        const float c = p.cs[t * 32 + pi], s = p.sn[t * 32 + pi];
        const float o0 = v0 * c - v1 * s, o1 = v0 * s + v1 * c;
        v0 = o0; v1 = o1;
      }
    }
    bf16x2 ov; ov[0] = (bf16)v0; ov[1] = (bf16)v1;
    bf16* dst;
    if (slot < 8) dst = lat ? p.QA + ((size_t)(b * 8 + slot) * SEQ + t) * 64 : p.CQA + ((size_t)(b * 8 + slot) * NCX + t) * 64;
    else if (slot < 10) dst = p.KA + ((size_t)(b * 2 + slot - 8) * NKEY + key) * 64;
    else if (slot < 12) dst = p.VA + ((size_t)(b * 2 + slot - 10) * NKEY + key) * 64;
    else if (slot < 20) dst = lat ? p.QB + ((size_t)(b * 8 + slot - 12) * SEQ + t) * 64 : p.CQB + ((size_t)(b * 8 + slot - 12) * NCX + t) * 64;
    else if (slot < 22) dst = p.KB + ((size_t)(b * 2 + slot - 20) * NKEY + key) * 64;
    else dst = p.VB + ((size_t)(b * 2 + slot - 22) * NKEY + key) * 64;
    *(bf16x2*)(dst + 2 * pi) = ov;
  }
}

struct AttnParams {
  const bf16* Q; long q_bs, q_hs; int q_ts;
  const bf16* K; long k_bs, k_hs; int k_ts;
  const bf16* K2; long k2_bs; int k2_ts;
  const bf16* V; long v_bs, v_hs; int v_ts;
  bf16* O; int o_row0, o_bs, o_col0;
  const float* sink;
  int nkeys;
  int G;
  int window;
  float scale_log2;
};

template <int DQK, int DV, int DSPLIT, int VBUFS>
DI void attn_item(const AttnParams& p, int qblk, int head, int b, char* smem) {
  constexpr int KCH = DQK / 8, VCH = DV / 8;
  constexpr int KPW = KCH / 4, VPW = VCH / 4;
  constexpr int KBYTES = 64 * DQK * 2, VBYTES = 64 * DV * 2;
  constexpr int NKS = DQK / 16, NDB = DV / 32;
  char* Kbase = smem;
  char* Vbase = smem + 2 * KBYTES;
  const int tid = threadIdx.x, lane = tid & 63, wave = tid >> 6;
  const int wave_u = __builtin_amdgcn_readfirstlane(wave);
  const int r = lane & 31, h = lane >> 5;
  const int q0 = qblk * 128;
  const int hkv = head / p.G;
  const int tq = q0 + wave * 32 + r;

  bf16x8 qf[NKS];
  {
    const bf16* qp = p.Q + (size_t)b * p.q_bs + (size_t)head * p.q_hs + (size_t)tq * p.q_ts + 8 * h;
#pragma unroll
    for (int ks = 0; ks < NKS; ++ks) qf[ks] = *(const bf16x8*)(qp + ks * 16);
  }
  int ntiles, lo = 0;
  if (p.window) {
    lo = q0 - 128 < 0 ? 0 : q0 - 128;
    const int hi = q0 + 256 > SEQ ? SEQ : q0 + 256;
    ntiles = 4 + (hi - lo) / 64;
  } else {
    ntiles = p.nkeys / 64;
  }
  const bf16* Kb = p.K + (size_t)b * p.k_bs + (size_t)hkv * p.k_hs;
  const bf16* K2b = (DSPLIT < DQK) ? p.K2 + (size_t)b * p.k2_bs : nullptr;
  const bf16* Vb = p.V + (size_t)b * p.v_bs + (size_t)hkv * p.v_hs;

  auto key0_of = [&](int j) -> int { return p.window ? (j < 4 ? j * 64 : NCX + lo + (j - 4) * 64) : j * 64; };
  const int krow_l = 8 * wave_u + (lane >> 3);
  const int kcol_l = (lane & 7) ^ ((((wave_u & 1) << 2) | (lane >> 4)) & 7);
  auto issue_k = [&](int j, int buf) {
    const int k0 = key0_of(j);
#pragma unroll
    for (int i = 0; i < KPW; ++i) {
      const int g = i >> 1, row = krow_l + 32 * (i & 1);
      const bf16* src;
      if (DSPLIT == DQK || g * 64 < DSPLIT) src = Kb + (size_t)(k0 + row) * p.k_ts + (8 * g + kcol_l) * 8;
      else src = K2b + (size_t)(k0 + row) * p.k2_ts + ((8 * g + kcol_l) * 8 - DSPLIT);
      __builtin_amdgcn_global_load_lds((const unsigned*)src, (LAS unsigned*)(Kbase + buf * KBYTES + g * 8192 + (wave_u + 4 * (i & 1)) * 1024), 16, 0, 0);
    }
  };
  const int vrow_l = (DV == 128) ? 4 * wave_u + (lane >> 4) : 8 * wave_u + (lane >> 3);
  const int vcol_l = (DV == 128) ? ((lane & 15) ^ (((lane >> 4) << 2) | (wave_u & 3))) : ((lane & 7) ^ (((lane >> 4) & 1) << 2));
  auto issue_v = [&](int j, int buf) {
    const int k0 = key0_of(j);
#pragma unroll
    for (int i = 0; i < VPW; ++i) {
      const int row = vrow_l + ((DV == 128) ? 16 : 32) * i;
      const bf16* src = Vb + (size_t)(k0 + row) * p.v_ts + vcol_l * 8;
      __builtin_amdgcn_global_load_lds((const unsigned*)src, (LAS unsigned*)(Vbase + buf * VBYTES + (wave_u + 4 * i) * 1024), 16, 0, 0);
    }
  };

  f32x16 o[NDB];
#pragma unroll
  for (int d = 0; d < NDB; ++d)
#pragma unroll
    for (int i = 0; i < 16; ++i) o[d][i] = 0.f;
  float m = -1e30f, l = 0.f;
  const int i16 = lane & 15, q4 = i16 >> 2, p4 = i16 & 3, g1 = (lane >> 4) & 1;
  const int kswz = (r >> 1) & 7;

  __syncthreads();
  issue_k(0, 0);
  if (VBUFS == 2) issue_v(0, 0);
  for (int j = 0; j < ntiles; ++j) {
    asm volatile("s_waitcnt vmcnt(0)" ::: "memory");
    __syncthreads();
    if (VBUFS == 1) issue_v(j, 0);
    if (j + 1 < ntiles) { issue_k(j + 1, (j + 1) & 1); if (VBUFS == 2) issue_v(j + 1, (j + 1) & 1); }
    const bf16* Ks = (const bf16*)(Kbase + (j & 1) * KBYTES);
    const bf16* Vs = (const bf16*)(Vbase + (VBUFS == 2 ? (j & 1) * VBYTES : 0));

    f32x16 s[2];
#pragma unroll
    for (int mb = 0; mb < 2; ++mb) {
#pragma unroll
      for (int i = 0; i < 16; ++i) s[mb][i] = 0.f;
#pragma unroll
      for (int ks = 0; ks < NKS; ++ks) {
        const int c = 2 * ks + h;
        const bf16x8 a = *(const bf16x8*)(&Ks[(c >> 3) * 4096 + (mb * 32 + r) * 64 + 8 * ((c ^ kswz) & 7)]);
        s[mb] = mfma32(a, qf[ks], s[mb]);
      }
    }
    const bool band = p.window && j >= 4;
    const int pos0 = lo + (j - 4) * 64;
    float mx = -1e30f;
#pragma unroll
    for (int mb = 0; mb < 2; ++mb)
#pragma unroll
      for (int i = 0; i < 16; ++i) {
        float x = s[mb][i] * p.scale_log2;
        if (band) {
          const int dlt = pos0 + mb * 32 + crow(i, h) - tq;
          if (dlt > 128 || dlt < -128) x = -1e30f;
        }
        s[mb][i] = x;
        mx = fmaxf(mx, x);
      }
    mx = fmaxf(mx, __shfl_xor(mx, 32));
    const float mn = fmaxf(m, mx);
    const float alpha = __builtin_amdgcn_exp2f(m - mn);
    m = mn;
    float ls = 0.f;
#pragma unroll
    for (int mb = 0; mb < 2; ++mb)
#pragma unroll
      for (int i = 0; i < 16; ++i) {
        const float ev = __builtin_amdgcn_exp2f(s[mb][i] - mn);
        s[mb][i] = ev;
        ls += ev;
      }
    l = l * alpha + ls;
#pragma unroll
    for (int d = 0; d < NDB; ++d)
#pragma unroll
      for (int i = 0; i < 16; ++i) o[d][i] *= alpha;
    bf16x8 pf[2][2];
#pragma unroll
    for (int mb = 0; mb < 2; ++mb)
#pragma unroll
      for (int s2 = 0; s2 < 2; ++s2)
#pragma unroll
        for (int jj = 0; jj < 8; ++jj) pf[mb][s2][jj] = (bf16)s[mb][8 * s2 + jj];
    if (VBUFS == 1) {
      asm volatile("s_waitcnt vmcnt(0)" ::: "memory");
      __syncthreads();
    }
#pragma unroll
    for (int d = 0; d < NDB; ++d)
#pragma unroll
      for (int mb = 0; mb < 2; ++mb)
#pragma unroll
        for (int s2 = 0; s2 < 2; ++s2) {
          const int row = mb * 32 + 16 * s2 + 4 * h + q4;
          const int ch = d * 4 + 2 * g1 + (p4 >> 1);
          const int f0 = (DV == 128) ? ((q4 << 2) | ((row >> 2) & 3)) : (((row >> 1) & 1) << 2);
          const int f1 = (DV == 128) ? ((q4 << 2) | (((row + 8) >> 2) & 3)) : ((((row + 8) >> 1) & 1) << 2);
          const bf16* v0p = &Vs[row * DV + 8 * (ch ^ f0) + 4 * (p4 & 1)];
          const bf16* v1p = &Vs[(row + 8) * DV + 8 * (ch ^ f1) + 4 * (p4 & 1)];
          const bf16x4 vlo = __builtin_amdgcn_ds_read_tr16_b64_v4bf16((LAS bf16x4*)(v0p));
          const bf16x4 vhi = __builtin_amdgcn_ds_read_tr16_b64_v4bf16((LAS bf16x4*)(v1p));
          const bf16x8 a = __builtin_shufflevector(vlo, vhi, 0, 1, 2, 3, 4, 5, 6, 7);
          o[d] = mfma32(a, pf[mb][s2], o[d]);
        }
  }
  float lt = l + __shfl_xor(l, 32);
  if (p.sink) lt += __builtin_amdgcn_exp2f(p.sink[head] * LOG2E - m);
  const float inv = 1.f / lt;
  bf16* op = p.O + (size_t)(p.o_row0 + b * p.o_bs + tq) * DM + p.o_col0 + head * DV;
#pragma unroll
  for (int d = 0; d < NDB; ++d)
#pragma unroll
    for (int g = 0; g < 4; ++g) {
      bf16x4 ov;
#pragma unroll
      for (int jj = 0; jj < 4; ++jj) ov[jj] = (bf16)(o[d][4 * g + jj] * inv);
      *(bf16x4*)(op + d * 32 + 8 * g + 4 * h) = ov;
    }
}

struct PairTab { int i[50]; int j[50]; };
constexpr PairTab make_pairs() {
  PairTab t{}; int c = 0;
  for (int i = 0; i < 16; ++i) for (int j = 0; j < 16; ++j) if ((i + 1) * (j + 1) <= 16) { t.i[c] = i; t.j[c] = j; ++c; }
  return t;
}
constexpr PairTab PAIRS = make_pairs();
DI float as_f(unsigned u) { return __builtin_bit_cast(float, u); }
DI unsigned as_u(float f) { return __builtin_bit_cast(unsigned, f); }

DI void peer_select_item(int tile, int hhalf, const bf16* __restrict__ QP, const bf16* __restrict__ SK,
                         int* __restrict__ IDX, float* __restrict__ GW, char* smem) {
  unsigned (*lidx)[64][9] = (unsigned (*)[64][9])smem;
  const int tid = threadIdx.x, lane = tid & 63, wave = tid >> 6;
  const int r = lane & 31, h = lane >> 5;
  const int tok = tile * 32 + r;
  const int head = hhalf * 4 + wave;
  const float INF = __builtin_inff();
  float top[2][16];
#pragma unroll
  for (int p = 0; p < 2; ++p) {
    const bf16* qp = QP + (size_t)tok * 2048 + (head * 2 + p) * 128 + 8 * h;
    const bf16* kp = SK + ((size_t)(head * 2 + p) * 128 + r) * 128 + 8 * h;
    f32x16 acc[4];
#pragma unroll
    for (int nb = 0; nb < 4; ++nb)
#pragma unroll
      for (int i = 0; i < 16; ++i) acc[nb][i] = 0.f;
#pragma unroll 2
    for (int ks = 0; ks < 8; ++ks) {
      const bf16x8 bq = *(const bf16x8*)(qp + ks * 16);
#pragma unroll
      for (int nb = 0; nb < 4; ++nb) {
        const bf16x8 a = *(const bf16x8*)(kp + (size_t)nb * 32 * 128 + ks * 16);
        acc[nb] = mfma32(a, bq, acc[nb]);
      }
    }
#pragma unroll
    for (int nb = 0; nb < 4; ++nb)
#pragma unroll
      for (int i = 0; i < 16; ++i) acc[nb][i] = as_f((as_u(acc[nb][i]) & 0xFFFFFF80u) | (unsigned)(nb * 32 + crow(i, h)));
    float prev = INF;
#pragma unroll
    for (int k = 0; k < 16; ++k) {
      float best = -INF;
#pragma unroll
      for (int nb = 0; nb < 4; ++nb)
#pragma unroll
        for (int i = 0; i < 16; ++i) { const float v = acc[nb][i]; best = fmaxf(best, v < prev ? v : -INF); }
      best = fmaxf(best, __shfl_xor(best, 32));
      top[p][k] = best; prev = best;
    }
  }
  float cand[50];
#pragma unroll
  for (int c = 0; c < 50; ++c) {
    const float sum = top[0][PAIRS.i[c]] + top[1][PAIRS.j[c]];
    cand[c] = as_f((as_u(sum) & 0xFFFFFF00u) | (unsigned)(PAIRS.i[c] * 16 + PAIRS.j[c]));
  }
  float best2[16];
  {
    float prev = INF;
#pragma unroll
    for (int k = 0; k < 16; ++k) {
      float best = -INF;
#pragma unroll
      for (int c = 0; c < 50; ++c) { const float v = cand[c]; best = fmaxf(best, v < prev ? v : -INF); }
      best2[k] = best; prev = best;
    }
  }
  float ex[16], sum = 0.f;
#pragma unroll
  for (int k = 0; k < 16; ++k) { ex[k] = __expf(best2[k] - best2[0]); sum += ex[k]; }
  const float inv = 1.f / sum;
  unsigned* my = lidx[wave][lane];
#pragma unroll
  for (int q = 0; q < 4; ++q) {
    my[q] = (as_u(top[0][4 * q]) & 0x7Fu) | ((as_u(top[0][4 * q + 1]) & 0x7Fu) << 8) | ((as_u(top[0][4 * q + 2]) & 0x7Fu) << 16) | ((as_u(top[0][4 * q + 3]) & 0x7Fu) << 24);
    my[4 + q] = (as_u(top[1][4 * q]) & 0x7Fu) | ((as_u(top[1][4 * q + 1]) & 0x7Fu) << 8) | ((as_u(top[1][4 * q + 2]) & 0x7Fu) << 16) | ((as_u(top[1][4 * q + 3]) & 0x7Fu) << 24);
  }
#pragma unroll
  for (int k = 0; k < 16; ++k) {
    const unsigned code = as_u(best2[k]) & 0xFFu;
    const unsigned i = code >> 4, j = code & 15u;
    const unsigned e0 = (my[i >> 2] >> ((i & 3u) * 8u)) & 0x7Fu;
    const unsigned e1 = (my[4 + (j >> 2)] >> ((j & 3u) * 8u)) & 0x7Fu;
    if (h == 0) {
      IDX[(size_t)tok * 128 + head * 16 + k] = (int)(e0 * 128u + e1);
      GW[(size_t)tok * 128 + head * 16 + k] = ex[k] * inv;
    }
  }
}

typedef float f32x4v __attribute__((ext_vector_type(4)));
typedef float f32x2v __attribute__((ext_vector_type(2)));
constexpr float U_SCALE = 64.f, V_SCALE = 8.f;
DI float gelu_exact(float x) { return 0.5f * x * (1.f + erff(x * 0.70710678118654752f)); }
DI bf16x8 fp8x8_to_bf16(unsigned w0, unsigned w1) {
  const f32x2v a = __builtin_amdgcn_cvt_pk_f32_fp8((int)w0, false), b = __builtin_amdgcn_cvt_pk_f32_fp8((int)w0, true);
  const f32x2v c = __builtin_amdgcn_cvt_pk_f32_fp8((int)w1, false), d = __builtin_amdgcn_cvt_pk_f32_fp8((int)w1, true);
  bf16x8 r;
  r[0] = (bf16)a[0]; r[1] = (bf16)a[1]; r[2] = (bf16)b[0]; r[3] = (bf16)b[1];
  r[4] = (bf16)c[0]; r[5] = (bf16)c[1]; r[6] = (bf16)d[0]; r[7] = (bf16)d[1];
  return r;
}

DI void peer_apply_item(int item, const bf16* __restrict__ H2, const int* __restrict__ IDX, const float* __restrict__ GW,
                        const unsigned char* __restrict__ U8, const unsigned char* __restrict__ V8,
                        float* __restrict__ x_lat, float* __restrict__ x_ctx, const float* __restrict__ modl, char* smem) {
  bf16 (*hs)[DM] = (bf16 (*)[DM])smem;
  int tid = threadIdx.x;
  asm volatile("" : "+v"(tid));
  const int lane = tid & 63, wave = tid >> 6;
  const int token = item * 4 + wave;
  const int col16 = lane & 15, kq = lane >> 4;
  __syncthreads();
  {
    const bf16* hp = H2 + (size_t)token * DM;
    *(u32x4*)(&hs[wave][8 * lane]) = *(const u32x4*)(hp + 8 * lane);
    *(u32x4*)(&hs[wave][512 + 8 * lane]) = *(const u32x4*)(hp + 512 + 8 * lane);
  }
  __syncthreads();
  const bf16* hbp = &hs[wave][16 * kq];
  const int id0 = IDX[(size_t)token * 128 + lane], id1 = IDX[(size_t)token * 128 + 64 + lane];
  float y[16];
#pragma unroll
  for (int i = 0; i < 16; ++i) y[i] = 0.f;
  u32x4 wbuf[16], vbuf[8];
  const unsigned voff = 16u * (unsigned)lane;
  {
    const unsigned e = (unsigned)__shfl(id0, col16);
    const unsigned char* up = U8 + (e * 1024u + 16u * (unsigned)kq);
#pragma unroll
    for (int S = 0; S < 8; ++S) wbuf[S] = *(const u32x4*)(up + 64 * S);
  }
  for (int g = 0; g < 8; ++g) {
    asm volatile("" ::: "memory");
    const int idsel = g < 4 ? id0 : id1;
    const int lbase = (g * 16) & 63;
#pragma unroll
    for (int k = 0; k < 8; ++k) {
      const unsigned es = (unsigned)__builtin_amdgcn_readlane(idsel, lbase + k);
      vbuf[k] = *(const u32x4*)(V8 + (es * 1024u + voff));
    }
    {
      const unsigned e = (unsigned)__shfl(idsel, lbase + col16);
      const unsigned char* up = U8 + (e * 1024u + 16u * (unsigned)kq);
#pragma unroll
      for (int S = 8; S < 16; ++S) wbuf[S] = *(const u32x4*)(up + 64 * S);
    }
    f32x4v c = {0.f, 0.f, 0.f, 0.f};
#pragma unroll
    for (int S = 0; S < 16; ++S) {
      const bf16x8 a0 = fp8x8_to_bf16(wbuf[S][0], wbuf[S][1]), a1 = fp8x8_to_bf16(wbuf[S][2], wbuf[S][3]);
      c = __builtin_amdgcn_mfma_f32_16x16x32_bf16(a0, *(const bf16x8*)(hbp + 64 * S), c, 0, 0, 0);
      c = __builtin_amdgcn_mfma_f32_16x16x32_bf16(a1, *(const bf16x8*)(hbp + 64 * S + 8), c, 0, 0, 0);
      if ((S & 1) == 1) __builtin_amdgcn_sched_barrier(0);
    }
    const float4 gw = *(const float4*)(GW + (size_t)token * 128 + g * 16 + kq * 4);
    float w[4];
    w[0] = gelu_exact(c[0] * (1.f / U_SCALE)) * gw.x; w[1] = gelu_exact(c[1] * (1.f / U_SCALE)) * gw.y;
    w[2] = gelu_exact(c[2] * (1.f / U_SCALE)) * gw.z; w[3] = gelu_exact(c[3] * (1.f / U_SCALE)) * gw.w;
    __builtin_amdgcn_sched_barrier(0);
    if (g < 7) {
      const int idn = (g + 1) < 4 ? id0 : id1;
      const unsigned e = (unsigned)__shfl(idn, (((g + 1) * 16) & 63) + col16);
      const unsigned char* up = U8 + (e * 1024u + 16u * (unsigned)kq);
#pragma unroll
      for (int S = 0; S < 8; ++S) wbuf[S] = *(const u32x4*)(up + 64 * S);
    }
    __builtin_amdgcn_sched_barrier(0);
#pragma unroll
    for (int k = 0; k < 16; ++k) {
      const float ws = as_f((unsigned)__builtin_amdgcn_readlane((int)as_u(w[k & 3]), (k >> 2) * 16));
#pragma unroll
      for (int j = 0; j < 4; ++j) {
        const f32x2v lo = __builtin_amdgcn_cvt_pk_f32_fp8((int)vbuf[k & 7][j], false), hi = __builtin_amdgcn_cvt_pk_f32_fp8((int)vbuf[k & 7][j], true);
        y[4 * j + 0] += ws * lo[0]; y[4 * j + 1] += ws * lo[1]; y[4 * j + 2] += ws * hi[0]; y[4 * j + 3] += ws * hi[1];
      }
      if (k < 8) {
        const unsigned es = (unsigned)__builtin_amdgcn_readlane(idsel, lbase + k + 8);
        vbuf[k] = *(const u32x4*)(V8 + (es * 1024u + voff));
      }
      __builtin_amdgcn_sched_barrier(0);
    }
  }
  float* xr; int b;
  if (token < NLAT) { xr = x_lat + (size_t)token * DM; b = token / SEQ; } else { xr = x_ctx + (size_t)(token - NLAT) * DM; b = 4; }
  const float* gate = modl + (size_t)b * 6144 + 5 * 1024;
#pragma unroll
  for (int q = 0; q < 4; ++q) {
    const int col = 16 * lane + 4 * q;
    float4 xv = *(float4*)(xr + col);
    const float4 gv = *(const float4*)(gate + col);
    xv.x += gv.x * y[4 * q + 0] * (1.f / V_SCALE); xv.y += gv.y * y[4 * q + 1] * (1.f / V_SCALE);
    xv.z += gv.z * y[4 * q + 2] * (1.f / V_SCALE); xv.w += gv.w * y[4 * q + 3] * (1.f / V_SCALE);
    *(float4*)(xr + col) = xv;
  }
}

DI void mla_post1_item(int row, bf16* __restrict__ P1, const float* __restrict__ qan, const float* __restrict__ kvan,
                       const float* __restrict__ krn, const float* __restrict__ cs, const float* __restrict__ sn,
                       bf16* __restrict__ KPE, char* smem) {
  float* red = (float*)smem;
  const int tid = threadIdx.x, lane = tid & 63, wave = tid >> 6;
  bf16* pr = P1 + (size_t)row * 768;
  const int pa = tid, pb = tid + 256;
  const bool actb = pb < 352;
  const bf16x2 va = *(const bf16x2*)(pr + 2 * pa);
  float a0 = (float)va[0], a1 = (float)va[1];
  float b0 = 0.f, b1 = 0.f;
  if (actb) { const bf16x2 vb = *(const bf16x2*)(pr + 2 * pb); b0 = (float)vb[0]; b1 = (float)vb[1]; }
  float sa = a0 * a0 + a1 * a1, sb = b0 * b0 + b1 * b1;
  for (int o = 32; o > 0; o >>= 1) { sa += __shfl_xor(sa, o); sb += __shfl_xor(sb, o); }
  if (lane == 0) { red[wave] = sa; red[4 + wave] = sb; }
  __syncthreads();
  const float ss_q = red[0] + red[1] + red[2], ss_kv = red[3] + red[4], ss_kr = red[5];
  {
    const int e0 = 2 * pa;
    bf16x2 ov;
    if (wave < 3) { const float rs = rsqrtf(ss_q * (1.f / 384.f) + EPS); ov[0] = (bf16)(a0 * rs * qan[e0]); ov[1] = (bf16)(a1 * rs * qan[e0 + 1]); }
    else { const float rs = rsqrtf(ss_kv * (1.f / 256.f) + EPS); ov[0] = (bf16)(a0 * rs * kvan[e0 - 384]); ov[1] = (bf16)(a1 * rs * kvan[e0 - 383]); }
    *(bf16x2*)(pr + e0) = ov;
  }
  if (actb) {
    const int e0 = 2 * pb;
    if (wave == 0) {
      const float rs = rsqrtf(ss_kv * (1.f / 256.f) + EPS);
      bf16x2 ov; ov[0] = (bf16)(b0 * rs * kvan[e0 - 384]); ov[1] = (bf16)(b1 * rs * kvan[e0 - 383]);
      *(bf16x2*)(pr + e0) = ov;
    } else {
      const int pi = pb - 320;
      const float rs = rsqrtf(ss_kr * (1.f / 64.f) + EPS);
      float y0 = b0 * rs * krn[2 * pi], y1 = b1 * rs * krn[2 * pi + 1];
      int orow;
      if (row < NLAT) {
        const int b = row / SEQ, t = row % SEQ;
        const float c = cs[t * 32 + pi], s = sn[t * 32 + pi];
        const float o0 = y0 * c - y1 * s, o1 = y0 * s + y1 * c;
        y0 = o0; y1 = o1;
        orow = b * NKEY + NCX + t;
      } else {
        const int rc = row - NLAT;
        orow = (rc / NCX) * NKEY + (rc % NCX);
      }
      bf16x2 ov; ov[0] = (bf16)y0; ov[1] = (bf16)y1;
      *(bf16x2*)(KPE + (size_t)orow * 64 + 2 * pi) = ov;
    }
  }
  __syncthreads();
}

DI void mla_qpost_item(int row, bf16* __restrict__ Q, const float* __restrict__ qnn, const float* __restrict__ qnr,
                       const float* __restrict__ cs, const float* __restrict__ sn) {
  const int lane = threadIdx.x & 63, wave = threadIdx.x >> 6;
  const int t = row % SEQ;
#pragma unroll
  for (int hh = 0; hh < 2; ++hh) {
    const int head = wave + 4 * hh;
    bf16* qp = Q + (size_t)row * 1536 + head * 192;
    const bf16x2 nv = *(const bf16x2*)(qp + 2 * lane);
    float v0 = (float)nv[0], v1 = (float)nv[1];
    float ss = v0 * v0 + v1 * v1;
    for (int o = 32; o > 0; o >>= 1) ss += __shfl_xor(ss, o);
    const float rs = rsqrtf(ss * (1.f / 128.f) + EPS);
    bf16x2 ov; ov[0] = (bf16)(v0 * rs * qnn[2 * lane]); ov[1] = (bf16)(v1 * rs * qnn[2 * lane + 1]);
    float p0 = 0.f, p1 = 0.f;
    if (lane < 32) { const bf16x2 pv = *(const bf16x2*)(qp + 128 + 2 * lane); p0 = (float)pv[0]; p1 = (float)pv[1]; }
    float s2 = p0 * p0 + p1 * p1;
    for (int o = 32; o > 0; o >>= 1) s2 += __shfl_xor(s2, o);
    const float rs2 = rsqrtf(s2 * (1.f / 64.f) + EPS);
    *(bf16x2*)(qp + 2 * lane) = ov;
    if (lane < 32) {
      const float y0 = p0 * rs2 * qnr[2 * lane], y1 = p1 * rs2 * qnr[2 * lane + 1];
      const float c = cs[t * 32 + lane], s = sn[t * 32 + lane];
      bf16x2 pv; pv[0] = (bf16)(y0 * c - y1 * s); pv[1] = (bf16)(y0 * s + y1 * c);
      *(bf16x2*)(qp + 128 + 2 * lane) = pv;
    }
  }
}

DI void mla_kpost_item(int row, bf16* __restrict__ KV, const float* __restrict__ knn) {
  const int lane = threadIdx.x & 63, wave = threadIdx.x >> 6;
#pragma unroll
  for (int hh = 0; hh < 2; ++hh) {
    const int head = wave + 4 * hh;
    bf16* kp = KV + (size_t)row * 2048 + head * 256;
    const bf16x2 nv = *(const bf16x2*)(kp + 2 * lane);
    const float v0 = (float)nv[0], v1 = (float)nv[1];
    float ss = v0 * v0 + v1 * v1;
    for (int o = 32; o > 0; o >>= 1) ss += __shfl_xor(ss, o);
    const float rs = rsqrtf(ss * (1.f / 128.f) + EPS);
    bf16x2 ov; ov[0] = (bf16)(v0 * rs * knn[2 * lane]); ov[1] = (bf16)(v1 * rs * knn[2 * lane + 1]);
    *(bf16x2*)(kp + 2 * lane) = ov;
  }
}

struct MegaParams {
  const float *x, *c, *ctx, *c_ctx, *mod_w, *mod_b, *mix_norm, *ffn_norm, *even_w_in, *even_w_out, *a_q_norm, *a_k_norm, *b_q_norm,
      *b_k_norm, *b_sink, *mla_w_in, *mla_q_a_norm, *mla_kv_a_norm, *mla_w_uq, *mla_w_ukv, *mla_q_nope_norm, *mla_q_rope_norm,
      *mla_k_nope_norm, *mla_k_rope_norm, *mla_w_out, *peer_w_query, *peer_sub_keys, *peer_u, *peer_v;
  float* out;
  unsigned* bar;
  float *MOD, *RCS, *RSN, *CTXS;
  bf16 *W_EIN, *W_EOUT, *W_PQ, *W_MIN, *W_UQ, *W_UKV, *W_MOUT, *SKB, *HA, *HB;
  unsigned char *U8, *V8;
  int* IDX;
  float* GW;
  char* R;
};

DI unsigned long long uptr64(const LAS unsigned long long* slot) {
  const unsigned long long v = *slot;
  const unsigned lo = __builtin_amdgcn_readfirstlane((unsigned)v), hi = __builtin_amdgcn_readfirstlane((unsigned)(v >> 32));
  return ((unsigned long long)hi << 32) | lo;
}
template <class T> DI T* as_global(T*, unsigned long long v) { return (T*)(__attribute__((address_space(1))) T*)v; }
#define LP(f) as_global((decltype(sp.f))nullptr, uptr64((const LAS unsigned long long*)&sp.f))

#define rP0 ((bf16*)Rb)
#define rQA ((bf16*)(Rb + (size_t)NTOK * 1536 * 2))
#define rQB (rQA + (size_t)NB * 8 * SEQ * 64)
#define rCQA (rQB + (size_t)NB * 8 * SEQ * 64)
#define rCQB (rCQA + (size_t)NB * 8 * NCX * 64)
#define rKA (rCQB + (size_t)NB * 8 * NCX * 64)
#define rVA (rKA + (size_t)NB * 2 * NKEY * 64)
#define rKB (rVA + (size_t)NB * 2 * NKEY * 64)
#define rVB (rKB + (size_t)NB * 2 * NKEY * 64)
#define rQP ((bf16*)Rb)
#define rKPE ((bf16*)Rb)
#define rQRAW (rKPE + (size_t)NB * NKEY * 64)
#define rKVRAW (rQRAW + (size_t)NLAT * 1536)

__global__ __launch_bounds__(256, 2) void mega_kernel(MegaParams kp) {
  __shared__ __attribute__((aligned(16))) char smem[SMEM_BYTES];
  __shared__ uint4 xb_words;
  __shared__ MegaParams sp;
  if (threadIdx.x == 0) { xb_words = make_uint4(0u, 0u, 0u, 0u); sp = kp; }
  __syncthreads();
  XcdBarrier bar = xcd_barrier_post(LP(bar), (volatile LAS unsigned*)&xb_words);
  const int G = gridDim.x, bid = blockIdx.x;

  {
    const float *c = LP(c), *c_ctx = LP(c_ctx), *mod_w = LP(mod_w), *mod_b = LP(mod_b); float* MOD = LP(MOD);
    for (int item = bid; item < 192; item += G) mod_item(item, c, c_ctx, mod_w, mod_b, MOD, smem);
  }
  rope_phase(LP(RCS), LP(RSN));
  transpose_phase(LP(even_w_in), LP(W_EIN), 1024, 1536, 1536, smem);
  transpose_phase(LP(even_w_out), LP(W_EOUT), 1024, 1024, 1024, smem);
  transpose_phase(LP(peer_w_query), LP(W_PQ), 1024, 2048, 2048, smem);
  transpose_phase(LP(peer_w_query) + (size_t)1024 * 2048, LP(W_PQ) + (size_t)2048 * 1024, 1024, 2048, 2048, smem);
  transpose_phase(LP(mla_w_in), LP(W_MIN), 1024, 704, 768, smem);
  transpose_phase(LP(mla_w_uq), LP(W_UQ), 384, 1536, 1536, smem);
  transpose_phase(LP(mla_w_ukv), LP(W_UKV), 256, 2048, 2048, smem);
  transpose_phase(LP(mla_w_out), LP(W_MOUT), 1024, 1024, 1024, smem);
  convert_phase((const float4*)LP(peer_sub_keys), (bf16x4*)LP(SKB), (size_t)2 * 16 * 128 * 128 / 4);
  convert_fp8_phase((const float4*)LP(peer_u), (unsigned*)LP(U8), (size_t)2 * 16384 * 1024 / 4, U_SCALE);
  convert_fp8_phase((const float4*)LP(peer_v), (unsigned*)LP(V8), (size_t)2 * 16384 * 1024 / 4, V_SCALE);
  xcd_barrier(bar);

  {
    const float *x = LP(x), *ctx = LP(ctx), *g = LP(mix_norm), *M = LP(MOD); bf16* H = LP(HA);
    for (int row = bid; row < NTOK; row += G) norm_mod_item(row, x, ctx, g, M, 0, H, smem);
  }
  xcd_barrier(bar);
  {
    char* const Rb = LP(R);
    GemmEpi e{}; e.Cb = rP0; e.ldc = 1536;
    gemm_phase<EPI_BF16>(LP(HA), 1024, LP(W_EIN), 1024, e, NTOK, 1536, smem);
  }
  xcd_barrier(bar);
  {
    char* const Rb = LP(R);
    Post0 q{}; q.P = rP0; q.aqn = LP(a_q_norm); q.akn = LP(a_k_norm); q.bqn = LP(b_q_norm); q.bkn = LP(b_k_norm); q.cs = LP(RCS); q.sn = LP(RSN);
    q.QA = rQA; q.QB = rQB; q.CQA = rCQA; q.CQB = rCQB; q.KA = rKA; q.VA = rVA; q.KB = rKB; q.VB = rVB;
    for (int row = bid; row < NTOK; row += G) qkv_post0_item(row, q);
  }
  xcd_barrier(bar);
  {
    char* const Rb = LP(R);
    bf16* const HBp = LP(HB);
    const float* const sinkp = LP(b_sink);
    for (int item = bid; item < 4224; item += G) {
      AttnParams a{};
      const bool isB = (item >= 2048 && item < 4096) || item >= 4160;
      const bool isC = item >= 4096;
      a.q_ts = 64; a.k_ts = 64; a.v_ts = 64; a.G = 4; a.scale_log2 = 0.125f * LOG2E;
      a.K = isB ? rKB : rKA; a.V = isB ? rVB : rVA;
      a.k_bs = (long)2 * NKEY * 64; a.k_hs = (long)NKEY * 64; a.v_bs = a.k_bs; a.v_hs = a.k_hs;
      a.O = HBp; a.o_col0 = isB ? 512 : 0; a.sink = isB ? sinkp : nullptr;
      int qblk, head, b;
      if (!isC) {
        const int li = item & 2047;
        qblk = li & 63; head = (li >> 6) & 7; b = li >> 9;
        a.Q = isB ? rQB : rQA; a.q_bs = (long)8 * SEQ * 64; a.q_hs = (long)SEQ * 64;
        a.o_row0 = 0; a.o_bs = SEQ; a.nkeys = NKEY; a.window = isB ? 1 : 0;
      } else {
        const int li = (item - 4096) & 63;
        qblk = li & 1; head = (li >> 1) & 7; b = li >> 4;
        a.Q = isB ? rCQB : rCQA; a.q_bs = (long)8 * NCX * 64; a.q_hs = (long)NCX * 64;
        a.o_row0 = NLAT; a.o_bs = NCX; a.nkeys = NCX; a.window = 0;
      }
      attn_item<64, 64, 64, 2>(a, qblk, head, b, smem);
    }
  }
  xcd_barrier(bar);
  {
    GemmEpi e{}; e.out_lat = LP(out); e.res_lat = LP(x); e.out_ctx = LP(CTXS); e.res_ctx = LP(ctx); e.modl = LP(MOD); e.gchunk = 2;
    gemm_phase<EPI_RESID>(LP(HB), 1024, LP(W_EOUT), 1024, e, NTOK, 1024, smem);
  }
  xcd_barrier(bar);
  {
    const float *x = LP(out), *ctx = LP(CTXS), *g = LP(ffn_norm), *M = LP(MOD); bf16* H = LP(HA);
    for (int row = bid; row < NTOK; row += G) norm_mod_item(row, x, ctx, g, M, 3, H, smem);
  }
  xcd_barrier(bar);
  {
    char* const Rb = LP(R);
    GemmEpi e{}; e.Cb = rQP; e.ldc = 2048;
    gemm_phase<EPI_BF16>(LP(HA), 1024, LP(W_PQ), 1024, e, NTOK, 2048, smem);
  }
  xcd_barrier(bar);
  {
    char* const Rb = LP(R);
    const bf16* QPp = rQP; const bf16* SK = LP(SKB); int* IDX = LP(IDX); float* GW = LP(GW);
    for (int item = bid; item < (NTOK / 32) * 2; item += G) peer_select_item(item >> 1, item & 1, QPp, SK, IDX, GW, smem);
  }
  xcd_barrier(bar);
  {
    const bf16* H = LP(HA); const int* IDX = LP(IDX); const float* GW = LP(GW); const unsigned char *U8 = LP(U8), *V8 = LP(V8);
    float *xo = LP(out), *xc = LP(CTXS); const float* M = LP(MOD);
    for (int item = bid; item < NTOK / 4; item += G) peer_apply_item(item, H, IDX, GW, U8, V8, xo, xc, M, smem);
  }
  xcd_barrier(bar);

  {
    const float *x = LP(out), *ctx = LP(CTXS), *g = LP(mix_norm) + 1024, *M = LP(MOD) + 5 * 6144; bf16* H = LP(HA);
    for (int row = bid; row < NTOK; row += G) norm_mod_item(row, x, ctx, g, M, 0, H, smem);
  }
  xcd_barrier(bar);
  {
    GemmEpi e{}; e.Cb = LP(HB); e.ldc = 768;
    gemm_phase<EPI_BF16>(LP(HA), 1024, LP(W_MIN), 1024, e, NTOK, 768, smem);
  }
  xcd_barrier(bar);
  {
    char* const Rb = LP(R);
    bf16* P1 = LP(HB); const float *qa = LP(mla_q_a_norm), *kva = LP(mla_kv_a_norm), *krn = LP(mla_k_rope_norm), *cs = LP(RCS), *sn = LP(RSN);
    bf16* KPEp = rKPE;
    for (int row = bid; row < NTOK; row += G) mla_post1_item(row, P1, qa, kva, krn, cs, sn, KPEp, smem);
  }
  xcd_barrier(bar);
  {
    char* const Rb = LP(R);
    GemmEpi e{}; e.Cb = rQRAW; e.ldc = 1536;
    gemm_phase<EPI_BF16>(LP(HB), 768, LP(W_UQ), 384, e, NLAT, 1536, smem);
    GemmEpi e2{}; e2.Cb = rKVRAW; e2.ldc = 2048; e2.rowmap = 1;
    gemm_phase<EPI_BF16>(LP(HB) + 384, 768, LP(W_UKV), 256, e2, NTOK, 2048, smem);
  }
  xcd_barrier(bar);
  {
    char* const Rb = LP(R);
    bf16* Qr = rQRAW; bf16* KVr = rKVRAW;
    const float *qnn = LP(mla_q_nope_norm), *qnr = LP(mla_q_rope_norm), *knn = LP(mla_k_nope_norm), *cs = LP(RCS), *sn = LP(RSN);
    for (int row = bid; row < NLAT; row += G) mla_qpost_item(row, Qr, qnn, qnr, cs, sn);
    for (int row = bid; row < NB * NKEY; row += G) mla_kpost_item(row, KVr, knn);
  }
  xcd_barrier(bar);
  {
    char* const Rb = LP(R);
    AttnParams a{}; a.Q = rQRAW; a.q_bs = (long)SEQ * 1536; a.q_hs = 192; a.q_ts = 1536;
    a.K = rKVRAW; a.k_bs = (long)NKEY * 2048; a.k_hs = 256; a.k_ts = 2048;
    a.K2 = rKPE; a.k2_bs = (long)NKEY * 64; a.k2_ts = 64;
    a.V = rKVRAW + 128; a.v_bs = (long)NKEY * 2048; a.v_hs = 256; a.v_ts = 2048;
    a.O = LP(HA); a.o_row0 = 0; a.o_bs = SEQ; a.o_col0 = 0; a.sink = nullptr; a.nkeys = NKEY; a.G = 1; a.window = 0;
    a.scale_log2 = 0.07216878364870322f * LOG2E;
    for (int item = bid; item < 2048; item += G) attn_item<192, 128, 128, 1>(a, item & 63, (item >> 6) & 7, item >> 9, smem);
  }
  xcd_barrier(bar);
  {
    GemmEpi e{}; e.out_lat = LP(out); e.res_lat = LP(out); e.out_ctx = LP(CTXS); e.res_ctx = LP(CTXS); e.modl = LP(MOD) + 5 * 6144; e.gchunk = 2;
    gemm_phase<EPI_RESID>(LP(HA), 1024, LP(W_MOUT), 1024, e, NLAT, 1024, smem);
  }
  xcd_barrier(bar);
  {
    const float *x = LP(out), *ctx = LP(CTXS), *g = LP(ffn_norm) + 1024, *M = LP(MOD) + 5 * 6144; bf16* H = LP(HB);
    for (int row = bid; row < NLAT; row += G) norm_mod_item(row, x, ctx, g, M, 3, H, smem);
  }
  xcd_barrier(bar);
  {
    char* const Rb = LP(R);
    GemmEpi e{}; e.Cb = rQP; e.ldc = 2048;
    gemm_phase<EPI_BF16>(LP(HB), 1024, LP(W_PQ) + (size_t)2048 * 1024, 1024, e, NLAT, 2048, smem);
  }
  xcd_barrier(bar);
  {
    char* const Rb = LP(R);
    const bf16* QPp = rQP; const bf16* SK = LP(SKB) + (size_t)16 * 128 * 128; int* IDX = LP(IDX); float* GW = LP(GW);
    for (int item = bid; item < (NLAT / 32) * 2; item += G) peer_select_item(item >> 1, item & 1, QPp, SK, IDX, GW, smem);
  }
  xcd_barrier(bar);
  {
    const bf16* H = LP(HB); const int* IDX = LP(IDX); const float* GW = LP(GW);
    const unsigned char *U8 = LP(U8) + (size_t)16384 * 1024, *V8 = LP(V8) + (size_t)16384 * 1024;
    float *xo = LP(out), *xc = LP(CTXS); const float* M = LP(MOD) + 5 * 6144;
    for (int item = bid; item < NLAT / 4; item += G) peer_apply_item(item, H, IDX, GW, U8, V8, xo, xc, M, smem);
  }
}

static inline size_t align_up(size_t v, size_t a) { return (v + a - 1) / a * a; }

extern "C" void kernel_launch(void* const* d_in, const int* in_sizes, int n_in,
                              void* d_out, int out_size, void* d_ws, size_t ws_size,
                              hipStream_t stream) {
  MegaParams p{};
  const float** fp = (const float**)&p;
  for (int i = 0; i < 29; ++i) fp[i] = (const float*)d_in[i];
  p.out = (float*)d_out;
  char* w = (char*)d_ws;
  size_t off = 0;
  auto take = [&](size_t bytes) { char* q = w + off; off = align_up(off + bytes, 256); return q; };
  p.bar = (unsigned*)take(XCD_BAR_WORDS * 4);
  p.MOD = (float*)take(2 * 5 * 6144 * 4);
  p.RCS = (float*)take((size_t)SEQ * 32 * 4);
  p.RSN = (float*)take((size_t)SEQ * 32 * 4);
  p.CTXS = (float*)take((size_t)NCTXT * DM * 4);
  p.W_EIN = (bf16*)take((size_t)1536 * 1024 * 2);
  p.W_EOUT = (bf16*)take((size_t)1024 * 1024 * 2);
  p.W_PQ = (bf16*)take((size_t)2 * 2048 * 1024 * 2);
  p.W_MIN = (bf16*)take((size_t)768 * 1024 * 2);
  p.W_UQ = (bf16*)take((size_t)1536 * 384 * 2);
  p.W_UKV = (bf16*)take((size_t)2048 * 256 * 2);
  p.W_MOUT = (bf16*)take((size_t)1024 * 1024 * 2);
  p.SKB = (bf16*)take((size_t)2 * 16 * 128 * 128 * 2);
  p.HA = (bf16*)take((size_t)NTOK * DM * 2);
  p.HB = (bf16*)take((size_t)NTOK * DM * 2);
  p.U8 = (unsigned char*)take((size_t)2 * 16384 * 1024);
  p.V8 = (unsigned char*)take((size_t)2 * 16384 * 1024);
  p.IDX = (int*)take((size_t)NTOK * 128 * 4);
  p.GW = (float*)take((size_t)NTOK * 128 * 4);
  p.R = take((size_t)250 * 1024 * 1024);

  static int grid = 0;
  if (!grid) {
    int dev = 0, cus = 0, per_cu = 0;
    hipGetDevice(&dev);
    hipDeviceGetAttribute(&cus, hipDeviceAttributeMultiprocessorCount, dev);
    hipOccupancyMaxActiveBlocksPerMultiprocessor(&per_cu, mega_kernel, 256, 0);
    if (per_cu > 2) per_cu = 2;
    if (per_cu < 1) per_cu = 1;
    grid = cus * per_cu;
  }
  hipMemsetAsync(p.bar, 0, XCD_BAR_WORDS * 4, stream);
  mega_kernel<<<grid, 256, 0, stream>>>(p);
}
```

```cpp
#include <hip/hip_runtime.h>
#include <stdint.h>

typedef __bf16 bf16;
typedef __bf16 bf16x8 __attribute__((ext_vector_type(8)));
typedef __bf16 bf16x4 __attribute__((ext_vector_type(4)));
typedef __bf16 bf16x2 __attribute__((ext_vector_type(2)));
typedef float f32x16 __attribute__((ext_vector_type(16)));
typedef unsigned u32x4 __attribute__((ext_vector_type(4)));
#define LAS __attribute__((address_space(3)))
#define DI __device__ __forceinline__

constexpr int DM = 1024, NB = 4, SEQ = 8192, NCX = 256;
constexpr int NLAT = NB * SEQ, NCTXT = NB * NCX, NTOK = NLAT + NCTXT, NKEY = SEQ + NCX;
constexpr float EPS = 1e-6f;
constexpr float LOG2E = 1.4426950408889634f;

DI int crow(int i, int h) { return (i & 3) + 8 * (i >> 2) + 4 * h; }
DI f32x16 mfma32(bf16x8 a, bf16x8 b, f32x16 c) { return __builtin_amdgcn_mfma_f32_32x32x16_bf16(a, b, c, 0, 0, 0); }
DI float silu(float v) { return v / (1.f + __expf(-v)); }


#define XB_TMO      128
#define XB_XCNT(j)  (256  + 64 * (j))
#define XB_XSUB(j)  (1280 + 64 * (j))
#define XB_XGEN(j)  (2304 + 64 * (j))
#define XB_TOP      3328
#define XB_TOPGEN   3392
#define XCD_BAR_WORDS 3456
#define XB_SPIN_CAP (1u << 18)

__device__ __forceinline__ unsigned xb_ld(unsigned* p)              { return __hip_atomic_load(p, __ATOMIC_RELAXED, __HIP_MEMORY_SCOPE_AGENT); }
__device__ __forceinline__ unsigned xb_add(unsigned* p, unsigned v) { return __hip_atomic_fetch_add(p, v, __ATOMIC_RELAXED, __HIP_MEMORY_SCOPE_AGENT); }
__device__ __forceinline__ unsigned xb_xcc_id() { return (unsigned)__builtin_amdgcn_s_getreg((3 << 11) | 20) & 0xFu; }
#define XB_SPIN(cond, bar) do { unsigned _sp = 0; while (cond) { __builtin_amdgcn_s_sleep(1); \
    if ((++_sp & 255u) == 0u) { if (xb_ld(&(bar)[XB_TMO])) break; if (_sp > XB_SPIN_CAP) { atomicAdd(&(bar)[XB_TMO], 1u); break; } } } } while (0)

struct XcdBarrier { unsigned* bar; unsigned x; volatile LAS unsigned* st; };

__device__ __forceinline__ XcdBarrier xcd_barrier_post(unsigned* bar, volatile LAS unsigned* st) {
    XcdBarrier b; b.bar = bar; b.x = xb_xcc_id(); b.st = st;
    if (threadIdx.x == 0) (void)xb_add(&bar[XB_XCNT(b.x)], 1u);
    return b;
}
__device__ __forceinline__ void xcd_barrier_complete(unsigned* bar, unsigned x, unsigned& nloc, unsigned& nx) {
    const unsigned G = gridDim.x * gridDim.y * gridDim.z;
    unsigned sum, cnt, mine, sp = 0u;
    for (;;) {
        sum = 0u; cnt = 0u; mine = 0u;
#pragma unroll
        for (unsigned j = 0; j < 16; ++j) { const unsigned c = xb_ld(&bar[XB_XCNT(j)]); sum += c; cnt += (c > 0u) ? 1u : 0u; mine = (j == x) ? c : mine; }
        if (sum == G) break;
        __builtin_amdgcn_s_sleep(1);
        if ((++sp & 255u) == 0u) { if (xb_ld(&bar[XB_TMO])) break; if (sp > XB_SPIN_CAP) { atomicAdd(&bar[XB_TMO], 1u); break; } }
    }
    nloc = mine > 0u ? mine : 1u; nx = cnt > 0u ? cnt : 1u;
}
__device__ __forceinline__ void xcd_barrier(const XcdBarrier& b) {
    asm volatile("s_waitcnt vmcnt(0)" ::: "memory");
    __syncthreads();
    if (threadIdx.x == 0) {
        unsigned* bar = b.bar;
        __builtin_amdgcn_s_waitcnt(0);
        unsigned nloc = b.st[0], nx = b.st[1];
        if (nloc == 0u) { xcd_barrier_complete(bar, b.x, nloc, nx); b.st[0] = nloc; b.st[1] = nx; }
        const unsigned old = xb_add(&bar[XB_XSUB(b.x)], 1u);
        const unsigned gen = old / nloc;
        if (old + 1u == (gen + 1u) * nloc) {
            __builtin_amdgcn_fence(__ATOMIC_RELEASE, "agent");
            asm volatile("s_waitcnt vmcnt(0)" ::: "memory");
            const unsigned og = xb_add(&bar[XB_TOP], 1u);
            const unsigned tg = og / nx;
            if (og + 1u == (tg + 1u) * nx) xb_add(&bar[XB_TOPGEN], 1u);
            else XB_SPIN(xb_ld(&bar[XB_TOPGEN]) == tg, bar);
            __builtin_amdgcn_fence(__ATOMIC_ACQUIRE, "agent");
            xb_add(&bar[XB_XGEN(b.x)], 1u);
            asm volatile("s_waitcnt vmcnt(0)" ::: "memory");
        } else {
            XB_SPIN(xb_ld(&bar[XB_XGEN(b.x)]) == gen, bar);
            __builtin_amdgcn_fence(__ATOMIC_ACQUIRE, "agent");
            asm volatile("s_waitcnt vmcnt(0)" ::: "memory");
        }
    }
    __syncthreads();
}

constexpr int SMEM_BYTES = 73728;

DI void mod_item(int item, const float* __restrict__ c, const float* __restrict__ c_ctx, const float* __restrict__ mod_w,
                 const float* __restrict__ mod_b, float* __restrict__ mod, char* smem) {
  float (*sv)[1024] = (float (*)[1024])smem;
  float (*part)[5][64] = (float (*)[5][64])(smem + 5 * 1024 * 4);
  const int tid = threadIdx.x, l = item / 96, bx = item % 96;
  for (int i = tid; i < 5 * 1024; i += 256) {
    const int b = i >> 10, k = i & 1023;
    const float v = b < 4 ? c[b * 1024 + k] : c_ctx[k];
    sv[b][k] = silu(v);
  }
  __syncthreads();
  const int nn = tid & 63, kg = tid >> 6;
  const int n = bx * 64 + nn;
  const float* w = mod_w + (size_t)l * 1024 * 6144 + n;
  float a0 = 0, a1 = 0, a2 = 0, a3 = 0, a4 = 0;
  for (int k = kg * 256; k < kg * 256 + 256; ++k) {
    const float wv = w[(size_t)k * 6144];
    a0 += sv[0][k] * wv; a1 += sv[1][k] * wv; a2 += sv[2][k] * wv; a3 += sv[3][k] * wv; a4 += sv[4][k] * wv;
  }
  part[kg][0][nn] = a0; part[kg][1][nn] = a1; part[kg][2][nn] = a2; part[kg][3][nn] = a3; part[kg][4][nn] = a4;
  __syncthreads();
  for (int i = tid; i < 5 * 64; i += 256) {
    const int b = i >> 6, j = i & 63;
    const float s = part[0][b][j] + part[1][b][j] + part[2][b][j] + part[3][b][j];
    mod[((size_t)l * 5 + b) * 6144 + bx * 64 + j] = s + mod_b[(size_t)l * 6144 + bx * 64 + j];
  }
  __syncthreads();
}

DI void rope_phase(float* __restrict__ cs, float* __restrict__ sn) {
  for (int idx = blockIdx.x * 256 + threadIdx.x; idx < SEQ * 32; idx += gridDim.x * 256) {
    const int t = idx >> 5, i = idx & 31;
    const int row = t >> 6, col = t & 63;
    const int fi = i & 15;
    const float inv = powf(10000.f, -(float)(2 * fi) / 32.f);
    const float ang = (i < 16 ? (float)row : (float)col) * inv;
    cs[idx] = cosf(ang);
    sn[idx] = sinf(ang);
  }
}

DI void transpose_item(int item, const float* __restrict__ W, bf16* __restrict__ Wt, int K, int N, int Npad, char* smem) {
  float (*tile)[33] = (float (*)[33])smem;
  const int tx = threadIdx.x & 31, ty = threadIdx.x >> 5;
  const int ntn = Npad / 32;
  const int n0 = (item % ntn) * 32, k0 = (item / ntn) * 32;
  for (int j = ty; j < 32; j += 8) {
    const int k = k0 + j, n = n0 + tx;
    tile[j][tx] = (n < N) ? W[(size_t)k * N + n] : 0.f;
  }
  __syncthreads();
  for (int j = ty; j < 32; j += 8) {
    const int n = n0 + j, k = k0 + tx;
    Wt[(size_t)n * K + k] = (bf16)tile[tx][j];
  }
  __syncthreads();
}
DI void transpose_phase(const float* __restrict__ W, bf16* __restrict__ Wt, int K, int N, int Npad, char* smem) {
  const int nitems = (Npad / 32) * (K / 32);
  for (int item = blockIdx.x; item < nitems; item += gridDim.x) transpose_item(item, W, Wt, K, N, Npad, smem);
}

DI void convert_phase(const float4* __restrict__ src, bf16x4* __restrict__ dst, size_t n4) {
  for (size_t i = blockIdx.x * (size_t)256 + threadIdx.x; i < n4; i += (size_t)gridDim.x * 256) {
    const float4 v = src[i];
    bf16x4 o; o[0] = (bf16)v.x; o[1] = (bf16)v.y; o[2] = (bf16)v.z; o[3] = (bf16)v.w;
    dst[i] = o;
  }
}


DI void convert_fp8_phase(const float4* __restrict__ src, unsigned* __restrict__ dst, size_t n4, float scale) {
  for (size_t i = blockIdx.x * (size_t)256 + threadIdx.x; i < n4; i += (size_t)gridDim.x * 256) {
    const float4 v = src[i];
    int w = 0;
    w = __builtin_amdgcn_cvt_pk_fp8_f32(v.x * scale, v.y * scale, w, false);
    w = __builtin_amdgcn_cvt_pk_fp8_f32(v.z * scale, v.w * scale, w, true);
    dst[i] = (unsigned)w;
  }
}

DI void norm_mod_item(int row, const float* __restrict__ src_lat, const float* __restrict__ src_ctx, const float* __restrict__ gain,
                      const float* __restrict__ modl, int chunk, bf16* __restrict__ H, char* smem) {
  float* red = (float*)smem;
  const int tid = threadIdx.x;
  const float* src; int b;
  if (row < NLAT) { src = src_lat + (size_t)row * DM; b = row / SEQ; } else { src = src_ctx + (size_t)(row - NLAT) * DM; b = 4; }
  const float4 v = ((const float4*)src)[tid];
  float ss = v.x * v.x + v.y * v.y + v.z * v.z + v.w * v.w;
  for (int o = 32; o > 0; o >>= 1) ss += __shfl_xor(ss, o);
  if ((tid & 63) == 0) red[tid >> 6] = ss;
  __syncthreads();
  ss = red[0] + red[1] + red[2] + red[3];
  const float rs = rsqrtf(ss * (1.f / DM) + EPS);
  const float4 g = ((const float4*)gain)[tid];
  const float4 sh = ((const float4*)(modl + (size_t)b * 6144 + chunk * 1024))[tid];
  const float4 sc = ((const float4*)(modl + (size_t)b * 6144 + (chunk + 1) * 1024))[tid];
  bf16x4 o;
  o[0] = (bf16)(v.x * rs * g.x * (1.f + sc.x) + sh.x);
  o[1] = (bf16)(v.y * rs * g.y * (1.f + sc.y) + sh.y);
  o[2] = (bf16)(v.z * rs * g.z * (1.f + sc.z) + sh.z);
  o[3] = (bf16)(v.w * rs * g.w * (1.f + sc.w) + sh.w);
  ((bf16x4*)(H + (size_t)row * DM))[tid] = o;
  __syncthreads();
}

constexpr int GBM = 128, GBN = 128, GBK = 64, GLD = 72;
enum { EPI_BF16 = 0, EPI_RESID = 1 };
struct GemmEpi {
  bf16* Cb; int ldc; int rowmap;
  float* out_lat; const float* res_lat; float* out_ctx; const float* res_ctx; const float* modl; int gchunk;
};

template <int EPI>
DI void gemm_tile(const bf16* __restrict__ A, int lda, const bf16* __restrict__ Bt, int K, const GemmEpi& e, int m0, int n0, char* smem) {
  bf16* As = (bf16*)smem;
  bf16* Bs = (bf16*)(smem + 2 * GBM * GLD * 2);
  const int tid = threadIdx.x, lane = tid & 63, wave = tid >> 6, wm = wave >> 1, wn = wave & 1;
  const int r = lane & 31, h = lane >> 5;
  const int sc = tid & 7, sr = tid >> 3;
  const bf16* Ag = A + (size_t)(m0 + sr) * lda + sc * 8;
  const bf16* Bg = Bt + (size_t)(n0 + sr) * K + sc * 8;
  u32x4 ra[4], rb[4];
  f32x16 acc[2][2];
#pragma unroll
  for (int i = 0; i < 2; ++i)
#pragma unroll
    for (int j = 0; j < 2; ++j)
#pragma unroll
      for (int q = 0; q < 16; ++q) acc[i][j][q] = 0.f;
  const int nt = K / GBK;
#pragma unroll
  for (int i = 0; i < 4; ++i) { ra[i] = *(const u32x4*)(Ag + (size_t)i * 32 * lda); rb[i] = *(const u32x4*)(Bg + (size_t)i * 32 * K); }
#pragma unroll
  for (int i = 0; i < 4; ++i) { *(u32x4*)(&As[(sr + 32 * i) * GLD + sc * 8]) = ra[i]; *(u32x4*)(&Bs[(sr + 32 * i) * GLD + sc * 8]) = rb[i]; }
  __syncthreads();
  for (int t = 0; t < nt; ++t) {
    if (t + 1 < nt) {
#pragma unroll
      for (int i = 0; i < 4; ++i) {
        ra[i] = *(const u32x4*)(Ag + (size_t)i * 32 * lda + (t + 1) * GBK);
        rb[i] = *(const u32x4*)(Bg + (size_t)i * 32 * K + (t + 1) * GBK);
      }
    }
    const bf16* as = As + (t & 1) * GBM * GLD + (wm * 64 + r) * GLD + 8 * h;
    const bf16* bs = Bs + (t & 1) * GBN * GLD + (wn * 64 + r) * GLD + 8 * h;
#pragma unroll
    for (int ks = 0; ks < 4; ++ks) {
      const bf16x8 a0 = *(const bf16x8*)(as + ks * 16), a1 = *(const bf16x8*)(as + 32 * GLD + ks * 16);
      const bf16x8 b0 = *(const bf16x8*)(bs + ks * 16), b1 = *(const bf16x8*)(bs + 32 * GLD + ks * 16);
      acc[0][0] = mfma32(a0, b0, acc[0][0]);
      acc[0][1] = mfma32(a0, b1, acc[0][1]);
      acc[1][0] = mfma32(a1, b0, acc[1][0]);
      acc[1][1] = mfma32(a1, b1, acc[1][1]);
    }
    if (t + 1 < nt) {
      const int nb = (t + 1) & 1;
#pragma unroll
      for (int i = 0; i < 4; ++i) {
        *(u32x4*)(&As[nb * GBM * GLD + (sr + 32 * i) * GLD + sc * 8]) = ra[i];
        *(u32x4*)(&Bs[nb * GBN * GLD + (sr + 32 * i) * GLD + sc * 8]) = rb[i];
      }
    }
    __syncthreads();
  }
#pragma unroll
  for (int mi = 0; mi < 2; ++mi)
#pragma unroll
    for (int ni = 0; ni < 2; ++ni)
#pragma unroll
      for (int i = 0; i < 16; ++i) {
        const int row = m0 + wm * 64 + mi * 32 + crow(i, h);
        const int col = n0 + wn * 64 + ni * 32 + r;
        const float v = acc[mi][ni][i];
        if constexpr (EPI == EPI_BF16) {
          int orow = row;
          if (e.rowmap) orow = row < NLAT ? (row / SEQ) * NKEY + NCX + (row % SEQ) : ((row - NLAT) / NCX) * NKEY + ((row - NLAT) % NCX);
          e.Cb[(size_t)orow * e.ldc + col] = (bf16)v;
        } else {
          if (row < NLAT) {
            const int b = row / SEQ;
            const float g = e.modl[(size_t)b * 6144 + e.gchunk * 1024 + col];
            e.out_lat[(size_t)row * DM + col] = e.res_lat[(size_t)row * DM + col] + g * v;
          } else {
            const int rc = row - NLAT;
            const float g = e.modl[(size_t)4 * 6144 + e.gchunk * 1024 + col];
            e.out_ctx[(size_t)rc * DM + col] = e.res_ctx[(size_t)rc * DM + col] + g * v;
          }
        }
      }
}
template <int EPI>
DI void gemm_phase(const bf16* __restrict__ A, int lda, const bf16* __restrict__ Bt, int K, const GemmEpi& e, int M, int N, char* smem) {
  const int ntn = N / GBN, nitems = (M / GBM) * ntn;
  for (int item = blockIdx.x; item < nitems; item += gridDim.x) {
    gemm_tile<EPI>(A, lda, Bt, K, e, (item / ntn) * GBM, (item % ntn) * GBN, smem);
  }
}

struct Post0 {
  const bf16* P;
  const float *aqn, *akn, *bqn, *bkn, *cs, *sn;
  bf16 *QA, *QB, *CQA, *CQB, *KA, *VA, *KB, *VB;
};
DI void qkv_post0_item(int row, const Post0& p) {
  const bool lat = row < NLAT;
  int b, t;
  if (lat) { b = row / SEQ; t = row % SEQ; } else { const int rc = row - NLAT; b = rc / NCX; t = rc % NCX; }
  const int key = lat ? NCX + t : t;
#pragma unroll
  for (int it = 0; it < 3; ++it) {
    const int i = threadIdx.x + 256 * it;
    const int slot = i >> 5, pi = i & 31;
    const bf16x2 pv = *(const bf16x2*)(p.P + (size_t)row * 1536 + slot * 64 + 2 * pi);
    float v0 = (float)pv[0], v1 = (float)pv[1];
    const bool isv = (slot == 10 || slot == 11 || slot == 22 || slot == 23);
    float ss = v0 * v0 + v1 * v1;
    for (int o = 16; o > 0; o >>= 1) ss += __shfl_xor(ss, o);
    if (!isv) {
      const float rs = rsqrtf(ss * (1.f / 64.f) + EPS);
      const float* g = slot < 8 ? p.aqn : slot < 10 ? p.akn : slot < 20 ? p.bqn : p.bkn;
      v0 = v0 * rs * g[2 * pi]; v1 = v1 * rs * g[2 * pi + 1];
      if (lat) {
        const float c = p.cs[t * 32 + pi], s = p.sn[t * 32 + pi];
        const float o0 = v0 * c - v1 * s, o1 = v0 * s + v1 * c;
        v0 = o0; v1 = o1;
      }
    }
    bf16x2 ov; ov[0] = (bf16)v0; ov[1] = (bf16)v1;
    bf16* dst;
    if (slot < 8) dst = lat ? p.QA + ((size_t)(b * 8 + slot) * SEQ + t) * 64 : p.CQA + ((size_t)(b * 8 + slot) * NCX + t) * 64;
    else if (slot < 10) dst = p.KA + ((size_t)(b * 2 + slot - 8) * NKEY + key) * 64;
    else if (slot < 12) dst = p.VA + ((size_t)(b * 2 + slot - 10) * NKEY + key) * 64;
    else if (slot < 20) dst = lat ? p.QB + ((size_t)(b * 8 + slot - 12) * SEQ + t) * 64 : p.CQB + ((size_t)(b * 8 + slot - 12) * NCX + t) * 64;
    else if (slot < 22) dst = p.KB + ((size_t)(b * 2 + slot - 20) * NKEY + key) * 64;
    else dst = p.VB + ((size_t)(b * 2 + slot - 22) * NKEY + key) * 64;
    *(bf16x2*)(dst + 2 * pi) = ov;
  }
}

struct AttnParams {
  const bf16* Q; long q_bs, q_hs; int q_ts;
  const bf16* K; long k_bs, k_hs; int k_ts;
  const bf16* K2; long k2_bs; int k2_ts;
  const bf16* V; long v_bs, v_hs; int v_ts;
  bf16* O; int o_row0, o_bs, o_col0;
  const float* sink;
  int nkeys;
  int G;
  int window;
  float scale_log2;
};

template <int DQK, int DV, int DSPLIT, int VBUFS, bool WINDOW>
DI void attn_item(const AttnParams& p, int qblk, int head, int b, char* smem) {
  constexpr int KCH = DQK / 8, VCH = DV / 8;
  constexpr int KPW = KCH / 4, VPW = VCH / 4;
  constexpr int KBYTES = 64 * DQK * 2, VBYTES = 64 * DV * 2;
  constexpr int NKS = DQK / 16, NDB = DV / 32;
  char* Kbase = smem;
  char* Vbase = smem + 2 * KBYTES;
  const int tid = threadIdx.x, lane = tid & 63, wave = tid >> 6;
  const int wave_u = __builtin_amdgcn_readfirstlane(wave);
  const int r = lane & 31, h = lane >> 5;
  const int q0 = qblk * 128;
  const int hkv = head / p.G;
  const int tq = q0 + wave * 32 + r;

  bf16x8 qf[NKS];
  {
    const bf16* qp = p.Q + (size_t)b * p.q_bs + (size_t)head * p.q_hs + (size_t)tq * p.q_ts + 8 * h;
#pragma unroll
    for (int ks = 0; ks < NKS; ++ks) qf[ks] = *(const bf16x8*)(qp + ks * 16);
  }
  int ntiles, lo = 0;
  if (WINDOW) {
    lo = q0 - 128 < 0 ? 0 : q0 - 128;
    const int hi = q0 + 256 > SEQ ? SEQ : q0 + 256;
    ntiles = 4 + (hi - lo) / 64;
  } else {
    ntiles = p.nkeys / 64;
  }
  const bf16* Kb = p.K + (size_t)b * p.k_bs + (size_t)hkv * p.k_hs;
  const bf16* K2b = (DSPLIT < DQK) ? p.K2 + (size_t)b * p.k2_bs : nullptr;
  const bf16* Vb = p.V + (size_t)b * p.v_bs + (size_t)hkv * p.v_hs;

  auto key0_of = [&](int j) -> int { return WINDOW ? (j < 4 ? j * 64 : NCX + lo + (j - 4) * 64) : j * 64; };
  const int krow_l = 8 * wave_u + (lane >> 3);
  const int kcol_l = (lane & 7) ^ ((((wave_u & 1) << 2) | (lane >> 4)) & 7);
  auto issue_k = [&](int j, int buf) {
    const int k0 = key0_of(j);
#pragma unroll
    for (int i = 0; i < KPW; ++i) {
      const int g = i >> 1, row = krow_l + 32 * (i & 1);
      const bf16* src;
      if (DSPLIT == DQK || g * 64 < DSPLIT) src = Kb + (size_t)(k0 + row) * p.k_ts + (8 * g + kcol_l) * 8;
      else src = K2b + (size_t)(k0 + row) * p.k2_ts + ((8 * g + kcol_l) * 8 - DSPLIT);
      __builtin_amdgcn_global_load_lds((const unsigned*)src, (LAS unsigned*)(Kbase + buf * KBYTES + g * 8192 + (wave_u + 4 * (i & 1)) * 1024), 16, 0, 0);
    }
  };
  const int vrow_l = (DV == 128) ? 4 * wave_u + (lane >> 4) : 8 * wave_u + (lane >> 3);
  const int vcol_l = (DV == 128) ? ((lane & 15) ^ (((lane >> 4) << 2) | (wave_u & 3))) : ((lane & 7) ^ (((lane >> 4) & 1) << 2));
  auto issue_v = [&](int j, int buf) {
    const int k0 = key0_of(j);
#pragma unroll
    for (int i = 0; i < VPW; ++i) {
      const int row = vrow_l + ((DV == 128) ? 16 : 32) * i;
      const bf16* src = Vb + (size_t)(k0 + row) * p.v_ts + vcol_l * 8;
      __builtin_amdgcn_global_load_lds((const unsigned*)src, (LAS unsigned*)(Vbase + buf * VBYTES + (wave_u + 4 * i) * 1024), 16, 0, 0);
    }
  };

  f32x16 o[NDB];
#pragma unroll
  for (int d = 0; d < NDB; ++d)
#pragma unroll
    for (int i = 0; i < 16; ++i) o[d][i] = 0.f;
  float m = -1e30f, l = 0.f;
  const int i16 = lane & 15, q4 = i16 >> 2, p4 = i16 & 3, g1 = (lane >> 4) & 1;
  const int kswz = (r >> 1) & 7;

  __syncthreads();
  issue_k(0, 0);
  if (VBUFS == 2) issue_v(0, 0);
  for (int j = 0; j < ntiles; ++j) {
    asm volatile("s_waitcnt vmcnt(0)" ::: "memory");
    __syncthreads();
    if (VBUFS == 1) issue_v(j, 0);
    if (j + 1 < ntiles) { issue_k(j + 1, (j + 1) & 1); if (VBUFS == 2) issue_v(j + 1, (j + 1) & 1); }
    const bf16* Ks = (const bf16*)(Kbase + (j & 1) * KBYTES);
    const bf16* Vs = (const bf16*)(Vbase + (VBUFS == 2 ? (j & 1) * VBYTES : 0));

    f32x16 s[2];
#pragma unroll
    for (int mb = 0; mb < 2; ++mb)
#pragma unroll
      for (int i = 0; i < 16; ++i) s[mb][i] = 0.f;
    {
      constexpr int GPM = NKS / 4, NG = 2 * GPM;
      bf16x8 fa[4], fb[4];
#define ATTN_KRD(F, g)                                                                                                   \
  _Pragma("unroll") for (int i = 0; i < 4; ++i) {                                                                      \
    const int c = 2 * ((((g) % GPM) * 4) + i) + h;                                                                      \
    F[i] = *(const bf16x8*)(&Ks[(c >> 3) * 4096 + (((g) / GPM) * 32 + r) * 64 + 8 * ((c ^ kswz) & 7)]);                \
  }
      ATTN_KRD(fa, 0)
#pragma unroll
      for (int g = 0; g < NG; ++g) {
        if (g + 1 < NG) { if (g & 1) { ATTN_KRD(fa, g + 1) } else { ATTN_KRD(fb, g + 1) } }
        __builtin_amdgcn_sched_barrier(0);
#pragma unroll
        for (int i = 0; i < 4; ++i) s[g / GPM] = mfma32((g & 1) ? fb[i] : fa[i], qf[(g % GPM) * 4 + i], s[g / GPM]);
        __builtin_amdgcn_sched_barrier(0);
      }
#undef ATTN_KRD
    }
    const bool band = WINDOW && j >= 4;
    const int pos0 = lo + (j - 4) * 64;
    float mx = -1e30f;
#pragma unroll
    for (int mb = 0; mb < 2; ++mb)
#pragma unroll
      for (int i = 0; i < 16; ++i) {
        if (WINDOW) {
          if (band) {
            const int dlt = pos0 + mb * 32 + crow(i, h) - tq;
            if (dlt > 128 || dlt < -128) s[mb][i] = -1e30f;
          }
        }
        mx = fmaxf(mx, s[mb][i]);
      }
    mx = fmaxf(mx, __shfl_xor(mx, 32)) * p.scale_log2;
    if (__any(mx > m + 8.f)) {
      const float mn = fmaxf(m, mx);
      const float alpha = __builtin_amdgcn_exp2f(m - mn);
      m = mn;
      l *= alpha;
#pragma unroll
      for (int d = 0; d < NDB; ++d)
#pragma unroll
        for (int i = 0; i < 16; ++i) o[d][i] *= alpha;
    }
    float ls = 0.f;
#pragma unroll
    for (int mb = 0; mb < 2; ++mb)
#pragma unroll
      for (int i = 0; i < 16; ++i) {
        const float ev = __builtin_amdgcn_exp2f(__builtin_fmaf(s[mb][i], p.scale_log2, -m));
        s[mb][i] = ev;
        ls += ev;
      }
    l += ls;
    bf16x8 pf[2][2];
#pragma unroll
    for (int mb = 0; mb < 2; ++mb)
#pragma unroll
      for (int s2 = 0; s2 < 2; ++s2)
#pragma unroll
        for (int jj = 0; jj < 8; ++jj) pf[mb][s2][jj] = (bf16)s[mb][8 * s2 + jj];
    if (VBUFS == 1) {
      asm volatile("s_waitcnt vmcnt(0)" ::: "memory");
      __syncthreads();
    }
    {
      const unsigned vbase = (unsigned)(size_t)Vs;
      bf16x4 ta[8], tb[8];
#define ATTN_VADDR(d)                                                                                                   \
      const int row0_ = 4 * h + q4;                                                                                     \
      const int ch_ = (d) * 4 + 2 * g1 + (p4 >> 1);                                                                     \
      const int f0_ = (DV == 128) ? ((q4 << 2) | ((row0_ >> 2) & 3)) : (((row0_ >> 1) & 1) << 2);                       \
      const int f1_ = (DV == 128) ? ((q4 << 2) | (((row0_ + 8) >> 2) & 3)) : ((((row0_ + 8) >> 1) & 1) << 2);           \
      const unsigned a_lo_ = vbase + (unsigned)((row0_ * DV + 8 * (ch_ ^ f0_) + 4 * (p4 & 1)) * 2);                     \
      const unsigned a_hi_ = vbase + (unsigned)(((row0_ + 8) * DV + 8 * (ch_ ^ f1_) + 4 * (p4 & 1)) * 2);
#define ATTN_VRD(T, d)                                                                                                  \
      {                                                                                                                 \
        ATTN_VADDR(d)                                                                                                   \
        asm volatile(                                                                                                   \
            "ds_read_b64_tr_b16 %0, %8\n\t"                                                                             \
            "ds_read_b64_tr_b16 %1, %9\n\t"                                                                             \
            "ds_read_b64_tr_b16 %2, %8 offset:%10\n\t"                                                                  \
            "ds_read_b64_tr_b16 %3, %9 offset:%10\n\t"                                                                  \
            "ds_read_b64_tr_b16 %4, %8 offset:%11\n\t"                                                                  \
            "ds_read_b64_tr_b16 %5, %9 offset:%11\n\t"                                                                  \
            "ds_read_b64_tr_b16 %6, %8 offset:%12\n\t"                                                                  \
            "ds_read_b64_tr_b16 %7, %9 offset:%12"                                                                      \
            : "=&v"(T[0]), "=&v"(T[1]), "=&v"(T[2]), "=&v"(T[3]), "=&v"(T[4]), "=&v"(T[5]), "=&v"(T[6]), "=&v"(T[7])    \
            : "v"(a_lo_), "v"(a_hi_), "i"(16 * DV * 2), "i"(32 * DV * 2), "i"(48 * DV * 2)                              \
            : "memory");                                                                                                \
      }
#define ATTN_VWAIT(T, N)                                                                                                \
      asm volatile("s_waitcnt lgkmcnt(" #N ")"                                                                          \
                   : "+v"(T[0]), "+v"(T[1]), "+v"(T[2]), "+v"(T[3]), "+v"(T[4]), "+v"(T[5]), "+v"(T[6]), "+v"(T[7]) : : "memory");
#define ATTN_VMMA(T, d)                                                                                                 \
      o[d] = mfma32(__builtin_shufflevector(T[0], T[1], 0, 1, 2, 3, 4, 5, 6, 7), pf[0][0], o[d]);                       \
      o[d] = mfma32(__builtin_shufflevector(T[2], T[3], 0, 1, 2, 3, 4, 5, 6, 7), pf[0][1], o[d]);                       \
      o[d] = mfma32(__builtin_shufflevector(T[4], T[5], 0, 1, 2, 3, 4, 5, 6, 7), pf[1][0], o[d]);                       \
      o[d] = mfma32(__builtin_shufflevector(T[6], T[7], 0, 1, 2, 3, 4, 5, 6, 7), pf[1][1], o[d]);
      ATTN_VRD(ta, 0)
#pragma unroll
      for (int d = 0; d < NDB; ++d) {
        if (d + 1 < NDB) {
          if (d & 1) { ATTN_VRD(ta, d + 1) ATTN_VWAIT(tb, 8) ATTN_VMMA(tb, d) }
          else       { ATTN_VRD(tb, d + 1) ATTN_VWAIT(ta, 8) ATTN_VMMA(ta, d) }
        } else {
          if (d & 1) { ATTN_VWAIT(tb, 0) ATTN_VMMA(tb, d) }
          else       { ATTN_VWAIT(ta, 0) ATTN_VMMA(ta, d) }
        }
      }
#undef ATTN_VADDR
#undef ATTN_VRD
#undef ATTN_VWAIT
#undef ATTN_VMMA
    }
  }
  float lt = l + __shfl_xor(l, 32);
  if (p.sink) lt += __builtin_amdgcn_exp2f(p.sink[head] * LOG2E - m);
  const float inv = 1.f / lt;
  bf16* op = p.O + (size_t)(p.o_row0 + b * p.o_bs + tq) * DM + p.o_col0 + head * DV;
#pragma unroll
  for (int d = 0; d < NDB; ++d)
#pragma unroll
    for (int g = 0; g < 4; ++g) {
      bf16x4 ov;
#pragma unroll
      for (int jj = 0; jj < 4; ++jj) ov[jj] = (bf16)(o[d][4 * g + jj] * inv);
      *(bf16x4*)(op + d * 32 + 8 * g + 4 * h) = ov;
    }
}

struct PairTab { int i[50]; int j[50]; };
constexpr PairTab make_pairs() {
  PairTab t{}; int c = 0;
  for (int i = 0; i < 16; ++i) for (int j = 0; j < 16; ++j) if ((i + 1) * (j + 1) <= 16) { t.i[c] = i; t.j[c] = j; ++c; }
  return t;
}
constexpr PairTab PAIRS = make_pairs();
DI float as_f(unsigned u) { return __builtin_bit_cast(float, u); }
DI unsigned as_u(float f) { return __builtin_bit_cast(unsigned, f); }

DI void peer_select_item(int tile, int hhalf, const bf16* __restrict__ QP, const bf16* __restrict__ SK,
                         int* __restrict__ IDX, float* __restrict__ GW, char* smem) {
  unsigned (*lidx)[64][9] = (unsigned (*)[64][9])smem;
  const int tid = threadIdx.x, lane = tid & 63, wave = tid >> 6;
  const int r = lane & 31, h = lane >> 5;
  const int tok = tile * 32 + r;
  const int head = hhalf * 4 + wave;
  const float INF = __builtin_inff();
  float top[2][16];
#pragma unroll
  for (int p = 0; p < 2; ++p) {
    const bf16* qp = QP + (size_t)tok * 2048 + (head * 2 + p) * 128 + 8 * h;
    const bf16* kp = SK + ((size_t)(head * 2 + p) * 128 + r) * 128 + 8 * h;
    f32x16 acc[4];
#pragma unroll
    for (int nb = 0; nb < 4; ++nb)
#pragma unroll
      for (int i = 0; i < 16; ++i) acc[nb][i] = 0.f;
#pragma unroll 2
    for (int ks = 0; ks < 8; ++ks) {
      const bf16x8 bq = *(const bf16x8*)(qp + ks * 16);
#pragma unroll
      for (int nb = 0; nb < 4; ++nb) {
        const bf16x8 a = *(const bf16x8*)(kp + (size_t)nb * 32 * 128 + ks * 16);
        acc[nb] = mfma32(a, bq, acc[nb]);
      }
    }
#pragma unroll
    for (int nb = 0; nb < 4; ++nb)
#pragma unroll
      for (int i = 0; i < 16; ++i) acc[nb][i] = as_f((as_u(acc[nb][i]) & 0xFFFFFF80u) | (unsigned)(nb * 32 + crow(i, h)));
    float prev = INF;
#pragma unroll
    for (int k = 0; k < 16; ++k) {
      float best = -INF;
#pragma unroll
      for (int nb = 0; nb < 4; ++nb)
#pragma unroll
        for (int i = 0; i < 16; ++i) { const float v = acc[nb][i]; best = fmaxf(best, v < prev ? v : -INF); }
      best = fmaxf(best, __shfl_xor(best, 32));
      top[p][k] = best; prev = best;
    }
  }
  float cand[50];
#pragma unroll
  for (int c = 0; c < 50; ++c) {
    const float sum = top[0][PAIRS.i[c]] + top[1][PAIRS.j[c]];
    cand[c] = as_f((as_u(sum) & 0xFFFFFF00u) | (unsigned)(PAIRS.i[c] * 16 + PAIRS.j[c]));
  }
  float best2[16];
  {
    float prev = INF;
#pragma unroll
    for (int k = 0; k < 16; ++k) {
      float best = -INF;
#pragma unroll
      for (int c = 0; c < 50; ++c) { const float v = cand[c]; best = fmaxf(best, v < prev ? v : -INF); }
      best2[k] = best; prev = best;
    }
  }
  float ex[16], sum = 0.f;
#pragma unroll
  for (int k = 0; k < 16; ++k) { ex[k] = __expf(best2[k] - best2[0]); sum += ex[k]; }
  const float inv = 1.f / sum;
  unsigned* my = lidx[wave][lane];
#pragma unroll
  for (int q = 0; q < 4; ++q) {
    my[q] = (as_u(top[0][4 * q]) & 0x7Fu) | ((as_u(top[0][4 * q + 1]) & 0x7Fu) << 8) | ((as_u(top[0][4 * q + 2]) & 0x7Fu) << 16) | ((as_u(top[0][4 * q + 3]) & 0x7Fu) << 24);
    my[4 + q] = (as_u(top[1][4 * q]) & 0x7Fu) | ((as_u(top[1][4 * q + 1]) & 0x7Fu) << 8) | ((as_u(top[1][4 * q + 2]) & 0x7Fu) << 16) | ((as_u(top[1][4 * q + 3]) & 0x7Fu) << 24);
  }
#pragma unroll
  for (int k = 0; k < 16; ++k) {
    const unsigned code = as_u(best2[k]) & 0xFFu;
    const unsigned i = code >> 4, j = code & 15u;
    const unsigned e0 = (my[i >> 2] >> ((i & 3u) * 8u)) & 0x7Fu;
    const unsigned e1 = (my[4 + (j >> 2)] >> ((j & 3u) * 8u)) & 0x7Fu;
    if (h == 0) {
      IDX[(size_t)tok * 128 + head * 16 + k] = (int)(e0 * 128u + e1);
      GW[(size_t)tok * 128 + head * 16 + k] = ex[k] * inv;
    }
  }
}

typedef float f32x4v __attribute__((ext_vector_type(4)));
typedef float f32x2v __attribute__((ext_vector_type(2)));
constexpr float U_SCALE = 64.f, V_SCALE = 8.f;
DI float gelu_exact(float x) { return 0.5f * x * (1.f + erff(x * 0.70710678118654752f)); }
DI bf16x8 fp8x8_to_bf16(unsigned w0, unsigned w1) {
  const f32x2v a = __builtin_amdgcn_cvt_pk_f32_fp8((int)w0, false), b = __builtin_amdgcn_cvt_pk_f32_fp8((int)w0, true);
  const f32x2v c = __builtin_amdgcn_cvt_pk_f32_fp8((int)w1, false), d = __builtin_amdgcn_cvt_pk_f32_fp8((int)w1, true);
  bf16x8 r;
  r[0] = (bf16)a[0]; r[1] = (bf16)a[1]; r[2] = (bf16)b[0]; r[3] = (bf16)b[1];
  r[4] = (bf16)c[0]; r[5] = (bf16)c[1]; r[6] = (bf16)d[0]; r[7] = (bf16)d[1];
  return r;
}

DI void peer_apply_item(int item, const bf16* __restrict__ H2, const int* __restrict__ IDX, const float* __restrict__ GW,
                        const unsigned char* __restrict__ U8, const unsigned char* __restrict__ V8,
                        float* __restrict__ x_lat, float* __restrict__ x_ctx, const float* __restrict__ modl, char* smem) {
  bf16 (*hs)[DM] = (bf16 (*)[DM])smem;
  int tid = threadIdx.x;
  asm volatile("" : "+v"(tid));
  const int lane = tid & 63, wave = tid >> 6;
  const int token = item * 4 + wave;
  const int col16 = lane & 15, kq = lane >> 4;
  __syncthreads();
  {
    const bf16* hp = H2 + (size_t)token * DM;
    *(u32x4*)(&hs[wave][8 * lane]) = *(const u32x4*)(hp + 8 * lane);
    *(u32x4*)(&hs[wave][512 + 8 * lane]) = *(const u32x4*)(hp + 512 + 8 * lane);
  }
  __syncthreads();
  const bf16* hbp = &hs[wave][16 * kq];
  const int id0 = IDX[(size_t)token * 128 + lane], id1 = IDX[(size_t)token * 128 + 64 + lane];
  float y[16];
#pragma unroll
  for (int i = 0; i < 16; ++i) y[i] = 0.f;
  u32x4 wbuf[16], vbuf[8];
  const unsigned voff = 16u * (unsigned)lane;
  {
    const unsigned e = (unsigned)__shfl(id0, col16);
    const unsigned char* up = U8 + (e * 1024u + 16u * (unsigned)kq);
#pragma unroll
    for (int S = 0; S < 8; ++S) wbuf[S] = *(const u32x4*)(up + 64 * S);
  }
  for (int g = 0; g < 8; ++g) {
    asm volatile("" ::: "memory");
    const int idsel = g < 4 ? id0 : id1;
    const int lbase = (g * 16) & 63;
#pragma unroll
    for (int k = 0; k < 8; ++k) {
      const unsigned es = (unsigned)__builtin_amdgcn_readlane(idsel, lbase + k);
      vbuf[k] = *(const u32x4*)(V8 + (es * 1024u + voff));
    }
    {
      const unsigned e = (unsigned)__shfl(idsel, lbase + col16);
      const unsigned char* up = U8 + (e * 1024u + 16u * (unsigned)kq);
#pragma unroll
      for (int S = 8; S < 16; ++S) wbuf[S] = *(const u32x4*)(up + 64 * S);
    }
    f32x4v c = {0.f, 0.f, 0.f, 0.f};
#pragma unroll
    for (int S = 0; S < 16; ++S) {
      const bf16x8 a0 = fp8x8_to_bf16(wbuf[S][0], wbuf[S][1]), a1 = fp8x8_to_bf16(wbuf[S][2], wbuf[S][3]);
      c = __builtin_amdgcn_mfma_f32_16x16x32_bf16(a0, *(const bf16x8*)(hbp + 64 * S), c, 0, 0, 0);
      c = __builtin_amdgcn_mfma_f32_16x16x32_bf16(a1, *(const bf16x8*)(hbp + 64 * S + 8), c, 0, 0, 0);
      if ((S & 1) == 1) __builtin_amdgcn_sched_barrier(0);
    }
    const float4 gw = *(const float4*)(GW + (size_t)token * 128 + g * 16 + kq * 4);
    float w[4];
    w[0] = gelu_exact(c[0] * (1.f / U_SCALE)) * gw.x; w[1] = gelu_exact(c[1] * (1.f / U_SCALE)) * gw.y;
    w[2] = gelu_exact(c[2] * (1.f / U_SCALE)) * gw.z; w[3] = gelu_exact(c[3] * (1.f / U_SCALE)) * gw.w;
    __builtin_amdgcn_sched_barrier(0);
    if (g < 7) {
      const int idn = (g + 1) < 4 ? id0 : id1;
      const unsigned e = (unsigned)__shfl(idn, (((g + 1) * 16) & 63) + col16);
      const unsigned char* up = U8 + (e * 1024u + 16u * (unsigned)kq);
#pragma unroll
      for (int S = 0; S < 8; ++S) wbuf[S] = *(const u32x4*)(up + 64 * S);
    }
    __builtin_amdgcn_sched_barrier(0);
#pragma unroll
    for (int k = 0; k < 16; ++k) {
      const float ws = as_f((unsigned)__builtin_amdgcn_readlane((int)as_u(w[k & 3]), (k >> 2) * 16));
#pragma unroll
      for (int j = 0; j < 4; ++j) {
        const f32x2v lo = __builtin_amdgcn_cvt_pk_f32_fp8((int)vbuf[k & 7][j], false), hi = __builtin_amdgcn_cvt_pk_f32_fp8((int)vbuf[k & 7][j], true);
        y[4 * j + 0] += ws * lo[0]; y[4 * j + 1] += ws * lo[1]; y[4 * j + 2] += ws * hi[0]; y[4 * j + 3] += ws * hi[1];
      }
      if (k < 8) {
        const unsigned es = (unsigned)__builtin_amdgcn_readlane(idsel, lbase + k + 8);
        vbuf[k] = *(const u32x4*)(V8 + (es * 1024u + voff));
      }
      __builtin_amdgcn_sched_barrier(0);
    }
  }
  float* xr; int b;
  if (token < NLAT) { xr = x_lat + (size_t)token * DM; b = token / SEQ; } else { xr = x_ctx + (size_t)(token - NLAT) * DM; b = 4; }
  const float* gate = modl + (size_t)b * 6144 + 5 * 1024;
#pragma unroll
  for (int q = 0; q < 4; ++q) {
    const int col = 16 * lane + 4 * q;
    float4 xv = *(float4*)(xr + col);
    const float4 gv = *(const float4*)(gate + col);
    xv.x += gv.x * y[4 * q + 0] * (1.f / V_SCALE); xv.y += gv.y * y[4 * q + 1] * (1.f / V_SCALE);
    xv.z += gv.z * y[4 * q + 2] * (1.f / V_SCALE); xv.w += gv.w * y[4 * q + 3] * (1.f / V_SCALE);
    *(float4*)(xr + col) = xv;
  }
}

DI void mla_post1_item(int row, bf16* __restrict__ P1, const float* __restrict__ qan, const float* __restrict__ kvan,
                       const float* __restrict__ krn, const float* __restrict__ cs, const float* __restrict__ sn,
                       bf16* __restrict__ KPE, char* smem) {
  float* red = (float*)smem;
  const int tid = threadIdx.x, lane = tid & 63, wave = tid >> 6;
  bf16* pr = P1 + (size_t)row * 768;
  const int pa = tid, pb = tid + 256;
  const bool actb = pb < 352;
  const bf16x2 va = *(const bf16x2*)(pr + 2 * pa);
  float a0 = (float)va[0], a1 = (float)va[1];
  float b0 = 0.f, b1 = 0.f;
  if (actb) { const bf16x2 vb = *(const bf16x2*)(pr + 2 * pb); b0 = (float)vb[0]; b1 = (float)vb[1]; }
  float sa = a0 * a0 + a1 * a1, sb = b0 * b0 + b1 * b1;
  for (int o = 32; o > 0; o >>= 1) { sa += __shfl_xor(sa, o); sb += __shfl_xor(sb, o); }
  if (lane == 0) { red[wave] = sa; red[4 + wave] = sb; }
  __syncthreads();
  const float ss_q = red[0] + red[1] + red[2], ss_kv = red[3] + red[4], ss_kr = red[5];
  {
    const int e0 = 2 * pa;
    bf16x2 ov;
    if (wave < 3) { const float rs = rsqrtf(ss_q * (1.f / 384.f) + EPS); ov[0] = (bf16)(a0 * rs * qan[e0]); ov[1] = (bf16)(a1 * rs * qan[e0 + 1]); }
    else { const float rs = rsqrtf(ss_kv * (1.f / 256.f) + EPS); ov[0] = (bf16)(a0 * rs * kvan[e0 - 384]); ov[1] = (bf16)(a1 * rs * kvan[e0 - 383]); }
    *(bf16x2*)(pr + e0) = ov;
  }
  if (actb) {
    const int e0 = 2 * pb;
    if (wave == 0) {
      const float rs = rsqrtf(ss_kv * (1.f / 256.f) + EPS);
      bf16x2 ov; ov[0] = (bf16)(b0 * rs * kvan[e0 - 384]); ov[1] = (bf16)(b1 * rs * kvan[e0 - 383]);
      *(bf16x2*)(pr + e0) = ov;
    } else {
      const int pi = pb - 320;
      const float rs = rsqrtf(ss_kr * (1.f / 64.f) + EPS);
      float y0 = b0 * rs * krn[2 * pi], y1 = b1 * rs * krn[2 * pi + 1];
      int orow;
      if (row < NLAT) {
        const int b = row / SEQ, t = row % SEQ;
        const float c = cs[t * 32 + pi], s = sn[t * 32 + pi];
        const float o0 = y0 * c - y1 * s, o1 = y0 * s + y1 * c;
        y0 = o0; y1 = o1;
        orow = b * NKEY + NCX + t;
      } else {
        const int rc = row - NLAT;
        orow = (rc / NCX) * NKEY + (rc % NCX);
      }
      bf16x2 ov; ov[0] = (bf16)y0; ov[1] = (bf16)y1;
      *(bf16x2*)(KPE + (size_t)orow * 64 + 2 * pi) = ov;
    }
  }
  __syncthreads();
}

DI void mla_qpost_item(int row, bf16* __restrict__ Q, const float* __restrict__ qnn, const float* __restrict__ qnr,
                       const float* __restrict__ cs, const float* __restrict__ sn) {
  const int lane = threadIdx.x & 63, wave = threadIdx.x >> 6;
  const int t = row % SEQ;
#pragma unroll
  for (int hh = 0; hh < 2; ++hh) {
    const int head = wave + 4 * hh;
    bf16* qp = Q + (size_t)row * 1536 + head * 192;
    const bf16x2 nv = *(const bf16x2*)(qp + 2 * lane);
    float v0 = (float)nv[0], v1 = (float)nv[1];
    float ss = v0 * v0 + v1 * v1;
    for (int o = 32; o > 0; o >>= 1) ss += __shfl_xor(ss, o);
    const float rs = rsqrtf(ss * (1.f / 128.f) + EPS);
    bf16x2 ov; ov[0] = (bf16)(v0 * rs * qnn[2 * lane]); ov[1] = (bf16)(v1 * rs * qnn[2 * lane + 1]);
    float p0 = 0.f, p1 = 0.f;
    if (lane < 32) { const bf16x2 pv = *(const bf16x2*)(qp + 128 + 2 * lane); p0 = (float)pv[0]; p1 = (float)pv[1]; }
    float s2 = p0 * p0 + p1 * p1;
    for (int o = 32; o > 0; o >>= 1) s2 += __shfl_xor(s2, o);
    const float rs2 = rsqrtf(s2 * (1.f / 64.f) + EPS);
    *(bf16x2*)(qp + 2 * lane) = ov;
    if (lane < 32) {
      const float y0 = p0 * rs2 * qnr[2 * lane], y1 = p1 * rs2 * qnr[2 * lane + 1];
      const float c = cs[t * 32 + lane], s = sn[t * 32 + lane];
      bf16x2 pv; pv[0] = (bf16)(y0 * c - y1 * s); pv[1] = (bf16)(y0 * s + y1 * c);
      *(bf16x2*)(qp + 128 + 2 * lane) = pv;
    }
  }
}

DI void mla_kpost_item(int row, bf16* __restrict__ KV, const float* __restrict__ knn) {
  const int lane = threadIdx.x & 63, wave = threadIdx.x >> 6;
#pragma unroll
  for (int hh = 0; hh < 2; ++hh) {
    const int head = wave + 4 * hh;
    bf16* kp = KV + (size_t)row * 2048 + head * 256;
    const bf16x2 nv = *(const bf16x2*)(kp + 2 * lane);
    const float v0 = (float)nv[0], v1 = (float)nv[1];
    float ss = v0 * v0 + v1 * v1;
    for (int o = 32; o > 0; o >>= 1) ss += __shfl_xor(ss, o);
    const float rs = rsqrtf(ss * (1.f / 128.f) + EPS);
    bf16x2 ov; ov[0] = (bf16)(v0 * rs * knn[2 * lane]); ov[1] = (bf16)(v1 * rs * knn[2 * lane + 1]);
    *(bf16x2*)(kp + 2 * lane) = ov;
  }
}

struct MegaParams {
  const float *x, *c, *ctx, *c_ctx, *mod_w, *mod_b, *mix_norm, *ffn_norm, *even_w_in, *even_w_out, *a_q_norm, *a_k_norm, *b_q_norm,
      *b_k_norm, *b_sink, *mla_w_in, *mla_q_a_norm, *mla_kv_a_norm, *mla_w_uq, *mla_w_ukv, *mla_q_nope_norm, *mla_q_rope_norm,
      *mla_k_nope_norm, *mla_k_rope_norm, *mla_w_out, *peer_w_query, *peer_sub_keys, *peer_u, *peer_v;
  float* out;
  unsigned* bar;
  float *MOD, *RCS, *RSN, *CTXS;
  bf16 *W_EIN, *W_EOUT, *W_PQ, *W_MIN, *W_UQ, *W_UKV, *W_MOUT, *SKB, *HA, *HB;
  unsigned char *U8, *V8;
  int* IDX;
  float* GW;
  char* R;
};

DI unsigned long long uptr64(const LAS unsigned long long* slot) {
  const unsigned long long v = *slot;
  const unsigned lo = __builtin_amdgcn_readfirstlane((unsigned)v), hi = __builtin_amdgcn_readfirstlane((unsigned)(v >> 32));
  return ((unsigned long long)hi << 32) | lo;
}
template <class T> DI T* as_global(T*, unsigned long long v) { return (T*)(__attribute__((address_space(1))) T*)v; }
#define LP(f) as_global((decltype(sp.f))nullptr, uptr64((const LAS unsigned long long*)&sp.f))

#define rP0 ((bf16*)Rb)
#define rQA ((bf16*)(Rb + (size_t)NTOK * 1536 * 2))
#define rQB (rQA + (size_t)NB * 8 * SEQ * 64)
#define rCQA (rQB + (size_t)NB * 8 * SEQ * 64)
#define rCQB (rCQA + (size_t)NB * 8 * NCX * 64)
#define rKA (rCQB + (size_t)NB * 8 * NCX * 64)
#define rVA (rKA + (size_t)NB * 2 * NKEY * 64)
#define rKB (rVA + (size_t)NB * 2 * NKEY * 64)
#define rVB (rKB + (size_t)NB * 2 * NKEY * 64)
#define rQP ((bf16*)Rb)
#define rKPE ((bf16*)Rb)
#define rQRAW (rKPE + (size_t)NB * NKEY * 64)
#define rKVRAW (rQRAW + (size_t)NLAT * 1536)

__global__ __launch_bounds__(256, 2) void mega_kernel(MegaParams kp) {
  __shared__ __attribute__((aligned(16))) char lds_all[SMEM_BYTES + 16 + ((sizeof(MegaParams) + 15) / 16) * 16];
  char* const smem = lds_all;
  uint4& xb_words = *(uint4*)(lds_all + SMEM_BYTES);
  MegaParams& sp = *(MegaParams*)(lds_all + SMEM_BYTES + 16);
  if (threadIdx.x == 0) { xb_words = make_uint4(0u, 0u, 0u, 0u); sp = kp; }
  __syncthreads();
  XcdBarrier bar = xcd_barrier_post(LP(bar), (volatile LAS unsigned*)&xb_words);
  const int G = gridDim.x, bid = blockIdx.x;

  {
    const float *c = LP(c), *c_ctx = LP(c_ctx), *mod_w = LP(mod_w), *mod_b = LP(mod_b); float* MOD = LP(MOD);
    for (int item = bid; item < 192; item += G) mod_item(item, c, c_ctx, mod_w, mod_b, MOD, smem);
  }
  rope_phase(LP(RCS), LP(RSN));
  transpose_phase(LP(even_w_in), LP(W_EIN), 1024, 1536, 1536, smem);
  transpose_phase(LP(even_w_out), LP(W_EOUT), 1024, 1024, 1024, smem);
  transpose_phase(LP(peer_w_query), LP(W_PQ), 1024, 2048, 2048, smem);
  transpose_phase(LP(peer_w_query) + (size_t)1024 * 2048, LP(W_PQ) + (size_t)2048 * 1024, 1024, 2048, 2048, smem);
  transpose_phase(LP(mla_w_in), LP(W_MIN), 1024, 704, 768, smem);
  transpose_phase(LP(mla_w_uq), LP(W_UQ), 384, 1536, 1536, smem);
  transpose_phase(LP(mla_w_ukv), LP(W_UKV), 256, 2048, 2048, smem);
  transpose_phase(LP(mla_w_out), LP(W_MOUT), 1024, 1024, 1024, smem);
  convert_phase((const float4*)LP(peer_sub_keys), (bf16x4*)LP(SKB), (size_t)2 * 16 * 128 * 128 / 4);
  convert_fp8_phase((const float4*)LP(peer_u), (unsigned*)LP(U8), (size_t)2 * 16384 * 1024 / 4, U_SCALE);
  convert_fp8_phase((const float4*)LP(peer_v), (unsigned*)LP(V8), (size_t)2 * 16384 * 1024 / 4, V_SCALE);
  xcd_barrier(bar);

  {
    const float *x = LP(x), *ctx = LP(ctx), *g = LP(mix_norm), *M = LP(MOD); bf16* H = LP(HA);
    for (int row = bid; row < NTOK; row += G) norm_mod_item(row, x, ctx, g, M, 0, H, smem);
  }
  xcd_barrier(bar);
  {
    char* const Rb = LP(R);
    GemmEpi e{}; e.Cb = rP0; e.ldc = 1536;
    gemm_phase<EPI_BF16>(LP(HA), 1024, LP(W_EIN), 1024, e, NTOK, 1536, smem);
  }
  xcd_barrier(bar);
  {
    char* const Rb = LP(R);
    Post0 q{}; q.P = rP0; q.aqn = LP(a_q_norm); q.akn = LP(a_k_norm); q.bqn = LP(b_q_norm); q.bkn = LP(b_k_norm); q.cs = LP(RCS); q.sn = LP(RSN);
    q.QA = rQA; q.QB = rQB; q.CQA = rCQA; q.CQB = rCQB; q.KA = rKA; q.VA = rVA; q.KB = rKB; q.VB = rVB;
    for (int row = bid; row < NTOK; row += G) qkv_post0_item(row, q);
  }
  xcd_barrier(bar);
  {
    char* const Rb = LP(R);
    bf16* const HBp = LP(HB);
    const float* const sinkp = LP(b_sink);
    const int xcd = bid & 7, nj = G >> 3;
    const int b = xcd >> 1, hkv = xcd & 1;
    for (int t = bid >> 3; t < 528; t += nj) {
      AttnParams a{};
      const bool isC = t >= 512;
      const bool isB = isC ? (t >= 520) : (t >= 256);
      a.q_ts = 64; a.k_ts = 64; a.v_ts = 64; a.G = 4; a.scale_log2 = 0.125f * LOG2E;
      a.K = isB ? rKB : rKA; a.V = isB ? rVB : rVA;
      a.k_bs = (long)2 * NKEY * 64; a.k_hs = (long)NKEY * 64; a.v_bs = a.k_bs; a.v_hs = a.k_hs;
      a.O = HBp; a.o_col0 = isB ? 512 : 0; a.sink = isB ? sinkp : nullptr;
      int qblk, head;
      if (!isC) {
        const int li = t & 255;
        qblk = li & 63; head = hkv * 4 + (li >> 6);
        a.Q = isB ? rQB : rQA; a.q_bs = (long)8 * SEQ * 64; a.q_hs = (long)SEQ * 64;
        a.o_row0 = 0; a.o_bs = SEQ; a.nkeys = NKEY;
      } else {
        const int li = (t - 512) & 7;
        qblk = li & 1; head = hkv * 4 + (li >> 1);
        a.Q = isB ? rCQB : rCQA; a.q_bs = (long)8 * NCX * 64; a.q_hs = (long)NCX * 64;
        a.o_row0 = NLAT; a.o_bs = NCX; a.nkeys = NCX;
      }
      if (isB && !isC) attn_item<64, 64, 64, 2, true>(a, qblk, head, b, smem);
      else attn_item<64, 64, 64, 2, false>(a, qblk, head, b, smem);
    }
  }
  xcd_barrier(bar);
  {
    GemmEpi e{}; e.out_lat = LP(out); e.res_lat = LP(x); e.out_ctx = LP(CTXS); e.res_ctx = LP(ctx); e.modl = LP(MOD); e.gchunk = 2;
    gemm_phase<EPI_RESID>(LP(HB), 1024, LP(W_EOUT), 1024, e, NTOK, 1024, smem);
  }
  xcd_barrier(bar);
  {
    const float *x = LP(out), *ctx = LP(CTXS), *g = LP(ffn_norm), *M = LP(MOD); bf16* H = LP(HA);
    for (int row = bid; row < NTOK; row += G) norm_mod_item(row, x, ctx, g, M, 3, H, smem);
  }
  xcd_barrier(bar);
  {
    char* const Rb = LP(R);
    GemmEpi e{}; e.Cb = rQP; e.ldc = 2048;
    gemm_phase<EPI_BF16>(LP(HA), 1024, LP(W_PQ), 1024, e, NTOK, 2048, smem);
  }
  xcd_barrier(bar);
  {
    char* const Rb = LP(R);
    const bf16* QPp = rQP; const bf16* SK = LP(SKB); int* IDX = LP(IDX); float* GW = LP(GW);
    for (int item = bid; item < (NTOK / 32) * 2; item += G) peer_select_item(item >> 1, item & 1, QPp, SK, IDX, GW, smem);
  }
  xcd_barrier(bar);
  {
    const bf16* H = LP(HA); const int* IDX = LP(IDX); const float* GW = LP(GW); const unsigned char *U8 = LP(U8), *V8 = LP(V8);
    float *xo = LP(out), *xc = LP(CTXS); const float* M = LP(MOD);
    for (int item = bid; item < NTOK / 4; item += G) peer_apply_item(item, H, IDX, GW, U8, V8, xo, xc, M, smem);
  }
  xcd_barrier(bar);

  {
    const float *x = LP(out), *ctx = LP(CTXS), *g = LP(mix_norm) + 1024, *M = LP(MOD) + 5 * 6144; bf16* H = LP(HA);
    for (int row = bid; row < NTOK; row += G) norm_mod_item(row, x, ctx, g, M, 0, H, smem);
  }
  xcd_barrier(bar);
  {
    GemmEpi e{}; e.Cb = LP(HB); e.ldc = 768;
    gemm_phase<EPI_BF16>(LP(HA), 1024, LP(W_MIN), 1024, e, NTOK, 768, smem);
  }
  xcd_barrier(bar);
  {
    char* const Rb = LP(R);
    bf16* P1 = LP(HB); const float *qa = LP(mla_q_a_norm), *kva = LP(mla_kv_a_norm), *krn = LP(mla_k_rope_norm), *cs = LP(RCS), *sn = LP(RSN);
    bf16* KPEp = rKPE;
    for (int row = bid; row < NTOK; row += G) mla_post1_item(row, P1, qa, kva, krn, cs, sn, KPEp, smem);
  }
  xcd_barrier(bar);
  {
    char* const Rb = LP(R);
    GemmEpi e{}; e.Cb = rQRAW; e.ldc = 1536;
    gemm_phase<EPI_BF16>(LP(HB), 768, LP(W_UQ), 384, e, NLAT, 1536, smem);
    GemmEpi e2{}; e2.Cb = rKVRAW; e2.ldc = 2048; e2.rowmap = 1;
    gemm_phase<EPI_BF16>(LP(HB) + 384, 768, LP(W_UKV), 256, e2, NTOK, 2048, smem);
  }
  xcd_barrier(bar);
  {
    char* const Rb = LP(R);
    bf16* Qr = rQRAW; bf16* KVr = rKVRAW;
    const float *qnn = LP(mla_q_nope_norm), *qnr = LP(mla_q_rope_norm), *knn = LP(mla_k_nope_norm), *cs = LP(RCS), *sn = LP(RSN);
    for (int row = bid; row < NLAT; row += G) mla_qpost_item(row, Qr, qnn, qnr, cs, sn);
    for (int row = bid; row < NB * NKEY; row += G) mla_kpost_item(row, KVr, knn);
  }
  xcd_barrier(bar);
  {
    char* const Rb = LP(R);
    AttnParams a{}; a.Q = rQRAW; a.q_bs = (long)SEQ * 1536; a.q_hs = 192; a.q_ts = 1536;
    a.K = rKVRAW; a.k_bs = (long)NKEY * 2048; a.k_hs = 256; a.k_ts = 2048;
    a.K2 = rKPE; a.k2_bs = (long)NKEY * 64; a.k2_ts = 64;
    a.V = rKVRAW + 128; a.v_bs = (long)NKEY * 2048; a.v_hs = 256; a.v_ts = 2048;
    a.O = LP(HA); a.o_row0 = 0; a.o_bs = SEQ; a.o_col0 = 0; a.sink = nullptr; a.nkeys = NKEY; a.G = 1; a.window = 0;
    a.scale_log2 = 0.07216878364870322f * LOG2E;
    const int xcd = bid & 7, nj = G >> 3;
    for (int t = bid >> 3; t < 256; t += nj) {
      const int bh = (t >> 6) * 8 + xcd;
      attn_item<192, 128, 128, 1, false>(a, t & 63, bh & 7, bh >> 3, smem);
    }
  }
  xcd_barrier(bar);
  {
    GemmEpi e{}; e.out_lat = LP(out); e.res_lat = LP(out); e.out_ctx = LP(CTXS); e.res_ctx = LP(CTXS); e.modl = LP(MOD) + 5 * 6144; e.gchunk = 2;
    gemm_phase<EPI_RESID>(LP(HA), 1024, LP(W_MOUT), 1024, e, NLAT, 1024, smem);
  }
  xcd_barrier(bar);
  {
    const float *x = LP(out), *ctx = LP(CTXS), *g = LP(ffn_norm) + 1024, *M = LP(MOD) + 5 * 6144; bf16* H = LP(HB);
    for (int row = bid; row < NLAT; row += G) norm_mod_item(row, x, ctx, g, M, 3, H, smem);
  }
  xcd_barrier(bar);
  {
    char* const Rb = LP(R);
    GemmEpi e{}; e.Cb = rQP; e.ldc = 2048;
    gemm_phase<EPI_BF16>(LP(HB), 1024, LP(W_PQ) + (size_t)2048 * 1024, 1024, e, NLAT, 2048, smem);
  }
  xcd_barrier(bar);
  {
    char* const Rb = LP(R);
    const bf16* QPp = rQP; const bf16* SK = LP(SKB) + (size_t)16 * 128 * 128; int* IDX = LP(IDX); float* GW = LP(GW);
    for (int item = bid; item < (NLAT / 32) * 2; item += G) peer_select_item(item >> 1, item & 1, QPp, SK, IDX, GW, smem);
  }
  xcd_barrier(bar);
  {
    const bf16* H = LP(HB); const int* IDX = LP(IDX); const float* GW = LP(GW);
    const unsigned char *U8 = LP(U8) + (size_t)16384 * 1024, *V8 = LP(V8) + (size_t)16384 * 1024;
    float *xo = LP(out), *xc = LP(CTXS); const float* M = LP(MOD) + 5 * 6144;
    for (int item = bid; item < NLAT / 4; item += G) peer_apply_item(item, H, IDX, GW, U8, V8, xo, xc, M, smem);
  }
}

static inline size_t align_up(size_t v, size_t a) { return (v + a - 1) / a * a; }

extern "C" void kernel_launch(void* const* d_in, const int* in_sizes, int n_in,
                              void* d_out, int out_size, void* d_ws, size_t ws_size,
                              hipStream_t stream) {
  MegaParams p{};
  const float** fp = (const float**)&p;
  for (int i = 0; i < 29; ++i) fp[i] = (const float*)d_in[i];
  p.out = (float*)d_out;
  char* w = (char*)d_ws;
  size_t off = 0;
  auto take = [&](size_t bytes) { char* q = w + off; off = align_up(off + bytes, 256); return q; };
  p.bar = (unsigned*)take(XCD_BAR_WORDS * 4);
  p.MOD = (float*)take(2 * 5 * 6144 * 4);
  p.RCS = (float*)take((size_t)SEQ * 32 * 4);
  p.RSN = (float*)take((size_t)SEQ * 32 * 4);
  p.CTXS = (float*)take((size_t)NCTXT * DM * 4);
  p.W_EIN = (bf16*)take((size_t)1536 * 1024 * 2);
  p.W_EOUT = (bf16*)take((size_t)1024 * 1024 * 2);
  p.W_PQ = (bf16*)take((size_t)2 * 2048 * 1024 * 2);
  p.W_MIN = (bf16*)take((size_t)768 * 1024 * 2);
  p.W_UQ = (bf16*)take((size_t)1536 * 384 * 2);
  p.W_UKV = (bf16*)take((size_t)2048 * 256 * 2);
  p.W_MOUT = (bf16*)take((size_t)1024 * 1024 * 2);
  p.SKB = (bf16*)take((size_t)2 * 16 * 128 * 128 * 2);
  p.HA = (bf16*)take((size_t)NTOK * DM * 2);
  p.HB = (bf16*)take((size_t)NTOK * DM * 2);
  p.U8 = (unsigned char*)take((size_t)2 * 16384 * 1024);
  p.V8 = (unsigned char*)take((size_t)2 * 16384 * 1024);
  p.IDX = (int*)take((size_t)NTOK * 128 * 4);
  p.GW = (float*)take((size_t)NTOK * 128 * 4);
  p.R = take((size_t)250 * 1024 * 1024);

  static int grid = 0;
  if (!grid) {
    int dev = 0, cus = 0, per_cu = 0;
    hipGetDevice(&dev);
    hipDeviceGetAttribute(&cus, hipDeviceAttributeMultiprocessorCount, dev);
    hipOccupancyMaxActiveBlocksPerMultiprocessor(&per_cu, mega_kernel, 256, 0);
    if (per_cu > 2) per_cu = 2;
    if (per_cu < 1) per_cu = 1;
    grid = cus * per_cu;
  }
  hipMemsetAsync(p.bar, 0, XCD_BAR_WORDS * 4, stream);
  mega_kernel<<<grid, 256, 0, stream>>>(p);
}
```

```cpp
#include <hip/hip_runtime.h>
#include <stdint.h>

typedef __bf16 bf16;
typedef __bf16 bf16x8 __attribute__((ext_vector_type(8)));
typedef __bf16 bf16x4 __attribute__((ext_vector_type(4)));
typedef __bf16 bf16x2 __attribute__((ext_vector_type(2)));
typedef float f32x16 __attribute__((ext_vector_type(16)));
typedef unsigned u32x4 __attribute__((ext_vector_type(4)));
#define LAS __attribute__((address_space(3)))
#define DI __device__ __forceinline__

constexpr int DM = 1024, NB = 4, SEQ = 8192, NCX = 256;
constexpr int NLAT = NB * SEQ, NCTXT = NB * NCX, NTOK = NLAT + NCTXT, NKEY = SEQ + NCX;
constexpr float EPS = 1e-6f;
constexpr float LOG2E = 1.4426950408889634f;

DI int crow(int i, int h) { return (i & 3) + 8 * (i >> 2) + 4 * h; }
DI f32x16 mfma32(bf16x8 a, bf16x8 b, f32x16 c) { return __builtin_amdgcn_mfma_f32_32x32x16_bf16(a, b, c, 0, 0, 0); }
DI float silu(float v) { return v / (1.f + __expf(-v)); }


#define XB_TMO      128
#define XB_XCNT(j)  (256  + 64 * (j))
#define XB_XSUB(j)  (1280 + 64 * (j))
#define XB_XGEN(j)  (2304 + 64 * (j))
#define XB_TOP      3328
#define XB_TOPGEN   3392
#define XCD_BAR_WORDS 3456
#define XB_SPIN_CAP (1u << 18)

__device__ __forceinline__ unsigned xb_ld(unsigned* p)              { return __hip_atomic_load(p, __ATOMIC_RELAXED, __HIP_MEMORY_SCOPE_AGENT); }
__device__ __forceinline__ unsigned xb_add(unsigned* p, unsigned v) { return __hip_atomic_fetch_add(p, v, __ATOMIC_RELAXED, __HIP_MEMORY_SCOPE_AGENT); }
__device__ __forceinline__ unsigned xb_xcc_id() { return (unsigned)__builtin_amdgcn_s_getreg((3 << 11) | 20) & 0xFu; }
#define XB_SPIN(cond, bar) do { unsigned _sp = 0; while (cond) { __builtin_amdgcn_s_sleep(1); \
    if ((++_sp & 255u) == 0u) { if (xb_ld(&(bar)[XB_TMO])) break; if (_sp > XB_SPIN_CAP) { atomicAdd(&(bar)[XB_TMO], 1u); break; } } } } while (0)

struct XcdBarrier { unsigned* bar; unsigned x; volatile LAS unsigned* st; };

__device__ __forceinline__ XcdBarrier xcd_barrier_post(unsigned* bar, volatile LAS unsigned* st) {
    XcdBarrier b; b.bar = bar; b.x = xb_xcc_id(); b.st = st;
    if (threadIdx.x == 0) (void)xb_add(&bar[XB_XCNT(b.x)], 1u);
    return b;
}
__device__ __forceinline__ void xcd_barrier_complete(unsigned* bar, unsigned x, unsigned& nloc, unsigned& nx) {
    const unsigned G = gridDim.x * gridDim.y * gridDim.z;
    unsigned sum, cnt, mine, sp = 0u;
    for (;;) {
        sum = 0u; cnt = 0u; mine = 0u;
#pragma unroll
        for (unsigned j = 0; j < 16; ++j) { const unsigned c = xb_ld(&bar[XB_XCNT(j)]); sum += c; cnt += (c > 0u) ? 1u : 0u; mine = (j == x) ? c : mine; }
        if (sum == G) break;
        __builtin_amdgcn_s_sleep(1);
        if ((++sp & 255u) == 0u) { if (xb_ld(&bar[XB_TMO])) break; if (sp > XB_SPIN_CAP) { atomicAdd(&bar[XB_TMO], 1u); break; } }
    }
    nloc = mine > 0u ? mine : 1u; nx = cnt > 0u ? cnt : 1u;
}
__device__ __forceinline__ void xcd_barrier(const XcdBarrier& b) {
    asm volatile("s_waitcnt vmcnt(0)" ::: "memory");
    __syncthreads();
    if (threadIdx.x == 0) {
        unsigned* bar = b.bar;
        __builtin_amdgcn_s_waitcnt(0);
        unsigned nloc = b.st[0], nx = b.st[1];
        if (nloc == 0u) { xcd_barrier_complete(bar, b.x, nloc, nx); b.st[0] = nloc; b.st[1] = nx; }
        const unsigned old = xb_add(&bar[XB_XSUB(b.x)], 1u);
        const unsigned gen = old / nloc;
        if (old + 1u == (gen + 1u) * nloc) {
            __builtin_amdgcn_fence(__ATOMIC_RELEASE, "agent");
            asm volatile("s_waitcnt vmcnt(0)" ::: "memory");
            const unsigned og = xb_add(&bar[XB_TOP], 1u);
            const unsigned tg = og / nx;
            if (og + 1u == (tg + 1u) * nx) xb_add(&bar[XB_TOPGEN], 1u);
            else XB_SPIN(xb_ld(&bar[XB_TOPGEN]) == tg, bar);
            __builtin_amdgcn_fence(__ATOMIC_ACQUIRE, "agent");
            xb_add(&bar[XB_XGEN(b.x)], 1u);
            asm volatile("s_waitcnt vmcnt(0)" ::: "memory");
        } else {
            XB_SPIN(xb_ld(&bar[XB_XGEN(b.x)]) == gen, bar);
            __builtin_amdgcn_fence(__ATOMIC_ACQUIRE, "agent");
            asm volatile("s_waitcnt vmcnt(0)" ::: "memory");
        }
    }
    __syncthreads();
}

constexpr int SMEM_BYTES = 73728;

DI void mod_item(int item, const float* __restrict__ c, const float* __restrict__ c_ctx, const float* __restrict__ mod_w,
                 const float* __restrict__ mod_b, float* __restrict__ mod, char* smem) {
  float (*sv)[1024] = (float (*)[1024])smem;
  float (*part)[5][64] = (float (*)[5][64])(smem + 5 * 1024 * 4);
  const int tid = threadIdx.x, l = item / 96, bx = item % 96;
  for (int i = tid; i < 5 * 1024; i += 256) {
    const int b = i >> 10, k = i & 1023;
    const float v = b < 4 ? c[b * 1024 + k] : c_ctx[k];
    sv[b][k] = silu(v);
  }
  __syncthreads();
  const int nn = tid & 63, kg = tid >> 6;
  const int n = bx * 64 + nn;
  const float* w = mod_w + (size_t)l * 1024 * 6144 + n;
  float a0 = 0, a1 = 0, a2 = 0, a3 = 0, a4 = 0;
  for (int k = kg * 256; k < kg * 256 + 256; ++k) {
    const float wv = w[(size_t)k * 6144];
    a0 += sv[0][k] * wv; a1 += sv[1][k] * wv; a2 += sv[2][k] * wv; a3 += sv[3][k] * wv; a4 += sv[4][k] * wv;
  }
  part[kg][0][nn] = a0; part[kg][1][nn] = a1; part[kg][2][nn] = a2; part[kg][3][nn] = a3; part[kg][4][nn] = a4;
  __syncthreads();
  for (int i = tid; i < 5 * 64; i += 256) {
    const int b = i >> 6, j = i & 63;
    const float s = part[0][b][j] + part[1][b][j] + part[2][b][j] + part[3][b][j];
    mod[((size_t)l * 5 + b) * 6144 + bx * 64 + j] = s + mod_b[(size_t)l * 6144 + bx * 64 + j];
  }
  __syncthreads();
}

DI void rope_phase(float* __restrict__ cs, float* __restrict__ sn) {
  for (int idx = blockIdx.x * 256 + threadIdx.x; idx < SEQ * 32; idx += gridDim.x * 256) {
    const int t = idx >> 5, i = idx & 31;
    const int row = t >> 6, col = t & 63;
    const int fi = i & 15;
    const float inv = powf(10000.f, -(float)(2 * fi) / 32.f);
    const float ang = (i < 16 ? (float)row : (float)col) * inv;
    cs[idx] = cosf(ang);
    sn[idx] = sinf(ang);
  }
}

DI void transpose_item(int item, const float* __restrict__ W, bf16* __restrict__ Wt, int K, int N, int Npad, char* smem) {
  float (*tile)[33] = (float (*)[33])smem;
  const int tx = threadIdx.x & 31, ty = threadIdx.x >> 5;
  const int ntn = Npad / 32;
  const int n0 = (item % ntn) * 32, k0 = (item / ntn) * 32;
  for (int j = ty; j < 32; j += 8) {
    const int k = k0 + j, n = n0 + tx;
    tile[j][tx] = (n < N) ? W[(size_t)k * N + n] : 0.f;
  }
  __syncthreads();
  for (int j = ty; j < 32; j += 8) {
    const int n = n0 + j, k = k0 + tx;
    Wt[(size_t)n * K + k] = (bf16)tile[tx][j];
  }
  __syncthreads();
}
DI void transpose_phase(const float* __restrict__ W, bf16* __restrict__ Wt, int K, int N, int Npad, char* smem) {
  const int nitems = (Npad / 32) * (K / 32);
  for (int item = blockIdx.x; item < nitems; item += gridDim.x) transpose_item(item, W, Wt, K, N, Npad, smem);
}

DI void convert_phase(const float4* __restrict__ src, bf16x4* __restrict__ dst, size_t n4) {
  for (size_t i = blockIdx.x * (size_t)256 + threadIdx.x; i < n4; i += (size_t)gridDim.x * 256) {
    const float4 v = src[i];
    bf16x4 o; o[0] = (bf16)v.x; o[1] = (bf16)v.y; o[2] = (bf16)v.z; o[3] = (bf16)v.w;
    dst[i] = o;
  }
}


DI void convert_fp8_phase(const float4* __restrict__ src, unsigned* __restrict__ dst, size_t n4, float scale) {
  for (size_t i = blockIdx.x * (size_t)256 + threadIdx.x; i < n4; i += (size_t)gridDim.x * 256) {
    const float4 v = src[i];
    int w = 0;
    w = __builtin_amdgcn_cvt_pk_fp8_f32(v.x * scale, v.y * scale, w, false);
    w = __builtin_amdgcn_cvt_pk_fp8_f32(v.z * scale, v.w * scale, w, true);
    dst[i] = (unsigned)w;
  }
}

DI float wave_sum(float v) {
#pragma unroll
  for (int o = 32; o > 0; o >>= 1) v += __shfl_xor(v, o);
  return v;
}
DI void norm_mod_item(int item, const float* __restrict__ src_lat, const float* __restrict__ src_ctx, const float* __restrict__ gain,
                      const float* __restrict__ modl, int chunk, bf16* __restrict__ H) {
  const int lane = threadIdx.x & 63, wave = threadIdx.x >> 6;
  const int row = item * 4 + wave;
  const float* src; int b;
  if (row < NLAT) { src = src_lat + (size_t)row * DM; b = row / SEQ; } else { src = src_ctx + (size_t)(row - NLAT) * DM; b = 4; }
  float4 v[4];
#pragma unroll
  for (int k = 0; k < 4; ++k) v[k] = ((const float4*)src)[lane + 64 * k];
  float ss = 0.f;
#pragma unroll
  for (int k = 0; k < 4; ++k) ss += v[k].x * v[k].x + v[k].y * v[k].y + v[k].z * v[k].z + v[k].w * v[k].w;
  ss = wave_sum(ss);
  const float rs = rsqrtf(ss * (1.f / DM) + EPS);
  const float4* gp = (const float4*)gain;
  const float4* shp = (const float4*)(modl + (size_t)b * 6144 + chunk * 1024);
  const float4* scp = (const float4*)(modl + (size_t)b * 6144 + (chunk + 1) * 1024);
#pragma unroll
  for (int k = 0; k < 4; ++k) {
    const float4 g = gp[lane + 64 * k], sh = shp[lane + 64 * k], sc = scp[lane + 64 * k];
    bf16x4 o;
    o[0] = (bf16)(v[k].x * rs * g.x * (1.f + sc.x) + sh.x);
    o[1] = (bf16)(v[k].y * rs * g.y * (1.f + sc.y) + sh.y);
    o[2] = (bf16)(v[k].z * rs * g.z * (1.f + sc.z) + sh.z);
    o[3] = (bf16)(v[k].w * rs * g.w * (1.f + sc.w) + sh.w);
    ((bf16x4*)(H + (size_t)row * DM))[lane + 64 * k] = o;
  }
}

constexpr int GBM = 128, GBN = 128, GBK = 64, GLD = 72;
enum { EPI_BF16 = 0, EPI_RESID = 1 };
struct GemmEpi {
  bf16* Cb; int ldc; int rowmap;
  float* out_lat; const float* res_lat; float* out_ctx; const float* res_ctx; const float* modl; int gchunk;
};

template <int EPI>
DI void gemm_tile(const bf16* __restrict__ A, int lda, const bf16* __restrict__ Bt, int K, const GemmEpi& e, int m0, int n0, char* smem) {
  const int tid = threadIdx.x, lane = tid & 63, wave = tid >> 6, wm = wave >> 1, wn = wave & 1;
  const int wave_u = __builtin_amdgcn_readfirstlane(wave);
  const int r = lane & 31, h = lane >> 5;
  const int drow = 8 * wave_u + (lane >> 3);
  const int dcol = ((lane & 7) ^ ((((wave_u & 1) << 2) | (lane >> 4)) & 7)) * 8;
  const bf16* Ag = A + (size_t)(m0 + drow) * lda + dcol;
  const bf16* Bg = Bt + (size_t)(n0 + drow) * K + dcol;
  f32x16 acc[2][2];
#pragma unroll
  for (int i = 0; i < 2; ++i)
#pragma unroll
    for (int j = 0; j < 2; ++j)
#pragma unroll
      for (int q = 0; q < 16; ++q) acc[i][j][q] = 0.f;
  const int nt = K / GBK;
  auto issue = [&](int t, int buf) {
#pragma unroll
    for (int i = 0; i < 4; ++i) {
      __builtin_amdgcn_global_load_lds((const unsigned*)(Ag + (size_t)(32 * i) * lda + t * GBK), (LAS unsigned*)(smem + buf * 32768 + (wave_u + 4 * i) * 1024), 16, 0, 0);
      __builtin_amdgcn_global_load_lds((const unsigned*)(Bg + (size_t)(32 * i) * K + t * GBK), (LAS unsigned*)(smem + buf * 32768 + 16384 + (wave_u + 4 * i) * 1024), 16, 0, 0);
    }
  };
  const int kswz = (r >> 1) & 7;
  issue(0, 0);
  for (int t = 0; t < nt; ++t) {
    asm volatile("s_waitcnt vmcnt(0)" ::: "memory");
    __syncthreads();
    if (t + 1 < nt) issue(t + 1, (t + 1) & 1);
    const bf16* as = (const bf16*)(smem + (t & 1) * 32768) + (wm * 64 + r) * 64;
    const bf16* bs = (const bf16*)(smem + (t & 1) * 32768 + 16384) + (wn * 64 + r) * 64;
#pragma unroll
    for (int ks = 0; ks < 4; ++ks) {
      const int so = 8 * (((2 * ks + h) ^ kswz) & 7);
      const bf16x8 a0 = *(const bf16x8*)(as + so), a1 = *(const bf16x8*)(as + 32 * 64 + so);
      const bf16x8 b0 = *(const bf16x8*)(bs + so), b1 = *(const bf16x8*)(bs + 32 * 64 + so);
      acc[0][0] = mfma32(a0, b0, acc[0][0]);
      acc[0][1] = mfma32(a0, b1, acc[0][1]);
      acc[1][0] = mfma32(a1, b0, acc[1][0]);
      acc[1][1] = mfma32(a1, b1, acc[1][1]);
    }
  }
  __syncthreads();
  if constexpr (EPI == EPI_BF16) {
    constexpr int CLD = 136;
    bf16* Cs = (bf16*)smem;
#pragma unroll
    for (int mi = 0; mi < 2; ++mi)
#pragma unroll
      for (int ni = 0; ni < 2; ++ni)
#pragma unroll
        for (int i = 0; i < 16; ++i) Cs[(wm * 64 + mi * 32 + crow(i, h)) * CLD + wn * 64 + ni * 32 + r] = (bf16)acc[mi][ni][i];
    __syncthreads();
    const int ch = tid & 15, r0 = tid >> 4;
#pragma unroll
    for (int k = 0; k < 8; ++k) {
      const int lrow = r0 + 16 * k, row = m0 + lrow;
      int orow = row;
      if (e.rowmap) orow = row < NLAT ? (row / SEQ) * NKEY + NCX + (row % SEQ) : ((row - NLAT) / NCX) * NKEY + ((row - NLAT) % NCX);
      *(u32x4*)(e.Cb + (size_t)orow * e.ldc + n0 + ch * 8) = *(const u32x4*)(Cs + lrow * CLD + ch * 8);
    }
  } else {
    constexpr int CLD = 132;
    float* Cs = (float*)smem;
#pragma unroll
    for (int mi = 0; mi < 2; ++mi)
#pragma unroll
      for (int ni = 0; ni < 2; ++ni)
#pragma unroll
        for (int i = 0; i < 16; ++i) Cs[(wm * 64 + mi * 32 + crow(i, h)) * CLD + wn * 64 + ni * 32 + r] = acc[mi][ni][i];
    __syncthreads();
    const int ch = tid & 31, r0 = tid >> 5;
    const bool lat = m0 < NLAT;
    const int b = lat ? m0 / SEQ : 4;
    const float4 g = *(const float4*)(e.modl + (size_t)b * 6144 + e.gchunk * 1024 + n0 + ch * 4);
    float* outp = lat ? e.out_lat + (size_t)m0 * DM : e.out_ctx + (size_t)(m0 - NLAT) * DM;
    const float* resp = lat ? e.res_lat + (size_t)m0 * DM : e.res_ctx + (size_t)(m0 - NLAT) * DM;
#pragma unroll
    for (int k = 0; k < 16; ++k) {
      const int lrow = r0 + 8 * k;
      const float4 c = *(const float4*)(Cs + lrow * CLD + ch * 4);
      float4 x = *(const float4*)(resp + (size_t)lrow * DM + n0 + ch * 4);
      x.x += g.x * c.x; x.y += g.y * c.y; x.z += g.z * c.z; x.w += g.w * c.w;
      *(float4*)(outp + (size_t)lrow * DM + n0 + ch * 4) = x;
    }
  }
  __syncthreads();
}
template <int EPI>
DI void gemm_phase(const bf16* __restrict__ A, int lda, const bf16* __restrict__ Bt, int K, const GemmEpi& e, int M, int N, char* smem) {
  const int ntn = N / GBN, nitems = (M / GBM) * ntn;
  for (int item = blockIdx.x; item < nitems; item += gridDim.x) {
    gemm_tile<EPI>(A, lda, Bt, K, e, (item / ntn) * GBM, (item % ntn) * GBN, smem);
  }
}

struct Post0 {
  const bf16* P;
  const float *aqn, *akn, *bqn, *bkn, *cs, *sn;
  bf16 *QA, *QB, *CQA, *CQB, *KA, *VA, *KB, *VB;
};
DI void qkv_post0_item(int item, const Post0& p) {
  const int lane = threadIdx.x & 63, wave = threadIdx.x >> 6;
  const int row = item * 4 + wave;
  const bool lat = row < NLAT;
  int b, t;
  if (lat) { b = row / SEQ; t = row % SEQ; } else { const int rc = row - NLAT; b = rc / NCX; t = rc % NCX; }
  const int key = lat ? NCX + t : t;
  const int c8 = lane & 7;
  float4 cs4 = {1.f, 1.f, 1.f, 1.f}, sn4 = {0.f, 0.f, 0.f, 0.f};
  if (lat) { cs4 = *(const float4*)(p.cs + t * 32 + c8 * 4); sn4 = *(const float4*)(p.sn + t * 32 + c8 * 4); }
#pragma unroll
  for (int k = 0; k < 3; ++k) {
    const int c = lane + 64 * k, slot = c >> 3;
    const bf16x8 pv = *(const bf16x8*)(p.P + (size_t)row * 1536 + c * 8);
    float v[8];
#pragma unroll
    for (int j = 0; j < 8; ++j) v[j] = (float)pv[j];
    const bool isv = (slot == 10 || slot == 11 || slot == 22 || slot == 23);
    float ss = 0.f;
#pragma unroll
    for (int j = 0; j < 8; ++j) ss += v[j] * v[j];
    ss += __shfl_xor(ss, 4); ss += __shfl_xor(ss, 2); ss += __shfl_xor(ss, 1);
    if (!isv) {
      const float rs = rsqrtf(ss * (1.f / 64.f) + EPS);
      const float* g = (slot < 8 ? p.aqn : slot < 10 ? p.akn : slot < 20 ? p.bqn : p.bkn) + c8 * 8;
      const float4 g0 = *(const float4*)g, g1 = *(const float4*)(g + 4);
      v[0] *= rs * g0.x; v[1] *= rs * g0.y; v[2] *= rs * g0.z; v[3] *= rs * g0.w;
      v[4] *= rs * g1.x; v[5] *= rs * g1.y; v[6] *= rs * g1.z; v[7] *= rs * g1.w;
      if (lat) {
        float o0;
        o0 = v[0] * cs4.x - v[1] * sn4.x; v[1] = v[0] * sn4.x + v[1] * cs4.x; v[0] = o0;
        o0 = v[2] * cs4.y - v[3] * sn4.y; v[3] = v[2] * sn4.y + v[3] * cs4.y; v[2] = o0;
        o0 = v[4] * cs4.z - v[5] * sn4.z; v[5] = v[4] * sn4.z + v[5] * cs4.z; v[4] = o0;
        o0 = v[6] * cs4.w - v[7] * sn4.w; v[7] = v[6] * sn4.w + v[7] * cs4.w; v[6] = o0;
      }
    }
    bf16x8 ov;
#pragma unroll
    for (int j = 0; j < 8; ++j) ov[j] = (bf16)v[j];
    bf16* dst;
    if (slot < 8) dst = lat ? p.QA + ((size_t)(b * 8 + slot) * SEQ + t) * 64 : p.CQA + ((size_t)(b * 8 + slot) * NCX + t) * 64;
    else if (slot < 10) dst = p.KA + ((size_t)(b * 2 + slot - 8) * NKEY + key) * 64;
    else if (slot < 12) dst = p.VA + ((size_t)(b * 2 + slot - 10) * NKEY + key) * 64;
    else if (slot < 20) dst = lat ? p.QB + ((size_t)(b * 8 + slot - 12) * SEQ + t) * 64 : p.CQB + ((size_t)(b * 8 + slot - 12) * NCX + t) * 64;
    else if (slot < 22) dst = p.KB + ((size_t)(b * 2 + slot - 20) * NKEY + key) * 64;
    else dst = p.VB + ((size_t)(b * 2 + slot - 22) * NKEY + key) * 64;
    *(bf16x8*)(dst + c8 * 8) = ov;
  }
}

struct AttnParams {
  const bf16* Q; long q_bs, q_hs; int q_ts;
  const bf16* K; long k_bs, k_hs; int k_ts;
  const bf16* K2; long k2_bs; int k2_ts;
  const bf16* V; long v_bs, v_hs; int v_ts;
  bf16* O; int o_row0, o_bs, o_col0;
  const float* sink;
  int nkeys;
  int G;
  int window;
  float scale_log2;
};

template <int DQK, int DV, int DSPLIT, int VBUFS, bool WINDOW>
DI void attn_item(const AttnParams& p, int qblk, int head, int b, char* smem) {
  constexpr int KCH = DQK / 8, VCH = DV / 8;
  constexpr int KPW = KCH / 4, VPW = VCH / 4;
  constexpr int KBYTES = 64 * DQK * 2, VBYTES = 64 * DV * 2;
  constexpr int NKS = DQK / 16, NDB = DV / 32;
  char* Kbase = smem;
  char* Vbase = smem + 2 * KBYTES;
  const int tid = threadIdx.x, lane = tid & 63, wave = tid >> 6;
  const int wave_u = __builtin_amdgcn_readfirstlane(wave);
  const int r = lane & 31, h = lane >> 5;
  const int q0 = qblk * 128;
  const int hkv = head / p.G;
  const int tq = q0 + wave * 32 + r;

  bf16x8 qf[NKS];
  {
    const bf16* qp = p.Q + (size_t)b * p.q_bs + (size_t)head * p.q_hs + (size_t)tq * p.q_ts + 8 * h;
#pragma unroll
    for (int ks = 0; ks < NKS; ++ks) qf[ks] = *(const bf16x8*)(qp + ks * 16);
  }
  int ntiles, lo = 0;
  if (WINDOW) {
    lo = q0 - 128 < 0 ? 0 : q0 - 128;
    const int hi = q0 + 256 > SEQ ? SEQ : q0 + 256;
    ntiles = 4 + (hi - lo) / 64;
  } else {
    ntiles = p.nkeys / 64;
  }
  const bf16* Kb = p.K + (size_t)b * p.k_bs + (size_t)hkv * p.k_hs;
  const bf16* K2b = (DSPLIT < DQK) ? p.K2 + (size_t)b * p.k2_bs : nullptr;
  const bf16* Vb = p.V + (size_t)b * p.v_bs + (size_t)hkv * p.v_hs;

  auto key0_of = [&](int j) -> int { return WINDOW ? (j < 4 ? j * 64 : NCX + lo + (j - 4) * 64) : j * 64; };
  const int krow_l = 8 * wave_u + (lane >> 3);
  const int kcol_l = (lane & 7) ^ ((((wave_u & 1) << 2) | (lane >> 4)) & 7);
  auto issue_k = [&](int j, int buf) {
    const int k0 = key0_of(j);
#pragma unroll
    for (int i = 0; i < KPW; ++i) {
      const int g = i >> 1, row = krow_l + 32 * (i & 1);
      const bf16* src;
      if (DSPLIT == DQK || g * 64 < DSPLIT) src = Kb + (size_t)(k0 + row) * p.k_ts + (8 * g + kcol_l) * 8;
      else src = K2b + (size_t)(k0 + row) * p.k2_ts + ((8 * g + kcol_l) * 8 - DSPLIT);
      __builtin_amdgcn_global_load_lds((const unsigned*)src, (LAS unsigned*)(Kbase + buf * KBYTES + g * 8192 + (wave_u + 4 * (i & 1)) * 1024), 16, 0, 0);
    }
  };
  const int vrow_l = (DV == 128) ? 4 * wave_u + (lane >> 4) : 8 * wave_u + (lane >> 3);
  const int vcol_l = (DV == 128) ? ((lane & 15) ^ (((lane >> 4) << 2) | (wave_u & 3))) : ((lane & 7) ^ (((lane >> 4) & 1) << 2));
  auto issue_v = [&](int j, int buf) {
    const int k0 = key0_of(j);
#pragma unroll
    for (int i = 0; i < VPW; ++i) {
      const int row = vrow_l + ((DV == 128) ? 16 : 32) * i;
      const bf16* src = Vb + (size_t)(k0 + row) * p.v_ts + vcol_l * 8;
      __builtin_amdgcn_global_load_lds((const unsigned*)src, (LAS unsigned*)(Vbase + buf * VBYTES + (wave_u + 4 * i) * 1024), 16, 0, 0);
    }
  };

  f32x16 o[NDB];
#pragma unroll
  for (int d = 0; d < NDB; ++d)
#pragma unroll
    for (int i = 0; i < 16; ++i) o[d][i] = 0.f;
  float m = -1e30f, l = 0.f;
  const int i16 = lane & 15, q4 = i16 >> 2, p4 = i16 & 3, g1 = (lane >> 4) & 1;
  const int kswz = (r >> 1) & 7;

  __syncthreads();
  issue_k(0, 0);
  if (VBUFS == 2) issue_v(0, 0);
  for (int j = 0; j < ntiles; ++j) {
    asm volatile("s_waitcnt vmcnt(0)" ::: "memory");
    __syncthreads();
    if (VBUFS == 1) issue_v(j, 0);
    if (j + 1 < ntiles) { issue_k(j + 1, (j + 1) & 1); if (VBUFS == 2) issue_v(j + 1, (j + 1) & 1); }
    const bf16* Ks = (const bf16*)(Kbase + (j & 1) * KBYTES);
    const bf16* Vs = (const bf16*)(Vbase + (VBUFS == 2 ? (j & 1) * VBYTES : 0));

    f32x16 s[2];
#pragma unroll
    for (int mb = 0; mb < 2; ++mb)
#pragma unroll
      for (int i = 0; i < 16; ++i) s[mb][i] = 0.f;
    {
      constexpr int GPM = NKS / 4, NG = 2 * GPM;
      bf16x8 fa[4], fb[4];
#define ATTN_KRD(F, g)                                                                                                   \
  _Pragma("unroll") for (int i = 0; i < 4; ++i) {                                                                      \
    const int c = 2 * ((((g) % GPM) * 4) + i) + h;                                                                      \
    F[i] = *(const bf16x8*)(&Ks[(c >> 3) * 4096 + (((g) / GPM) * 32 + r) * 64 + 8 * ((c ^ kswz) & 7)]);                \
  }
      ATTN_KRD(fa, 0)
#pragma unroll
      for (int g = 0; g < NG; ++g) {
        if (g + 1 < NG) { if (g & 1) { ATTN_KRD(fa, g + 1) } else { ATTN_KRD(fb, g + 1) } }
        __builtin_amdgcn_sched_barrier(0);
#pragma unroll
        for (int i = 0; i < 4; ++i) s[g / GPM] = mfma32((g & 1) ? fb[i] : fa[i], qf[(g % GPM) * 4 + i], s[g / GPM]);
        __builtin_amdgcn_sched_barrier(0);
      }
#undef ATTN_KRD
    }
    const bool band = WINDOW && j >= 4;
    const int pos0 = lo + (j - 4) * 64;
    float mx = -1e30f;
#pragma unroll
    for (int mb = 0; mb < 2; ++mb)
#pragma unroll
      for (int i = 0; i < 16; ++i) {
        if (WINDOW) {
          if (band) {
            const int dlt = pos0 + mb * 32 + crow(i, h) - tq;
            if (dlt > 128 || dlt < -128) s[mb][i] = -1e30f;
          }
        }
        mx = fmaxf(mx, s[mb][i]);
      }
    mx = fmaxf(mx, __shfl_xor(mx, 32)) * p.scale_log2;
    if (__any(mx > m + 8.f)) {
      const float mn = fmaxf(m, mx);
      const float alpha = __builtin_amdgcn_exp2f(m - mn);
      m = mn;
      l *= alpha;
#pragma unroll
      for (int d = 0; d < NDB; ++d)
#pragma unroll
        for (int i = 0; i < 16; ++i) o[d][i] *= alpha;
    }
    float ls = 0.f;
#pragma unroll
    for (int mb = 0; mb < 2; ++mb)
#pragma unroll
      for (int i = 0; i < 16; ++i) {
        const float ev = __builtin_amdgcn_exp2f(__builtin_fmaf(s[mb][i], p.scale_log2, -m));
        s[mb][i] = ev;
        ls += ev;
      }
    l += ls;
    bf16x8 pf[2][2];
#pragma unroll
    for (int mb = 0; mb < 2; ++mb)
#pragma unroll
      for (int s2 = 0; s2 < 2; ++s2)
#pragma unroll
        for (int jj = 0; jj < 8; ++jj) pf[mb][s2][jj] = (bf16)s[mb][8 * s2 + jj];
    if (VBUFS == 1) {
      asm volatile("s_waitcnt vmcnt(0)" ::: "memory");
      __syncthreads();
    }
    {
      const unsigned vbase = (unsigned)(size_t)Vs;
      bf16x4 ta[8], tb[8];
#define ATTN_VADDR(d)                                                                                                   \
      const int row0_ = 4 * h + q4;                                                                                     \
      const int ch_ = (d) * 4 + 2 * g1 + (p4 >> 1);                                                                     \
      const int f0_ = (DV == 128) ? ((q4 << 2) | ((row0_ >> 2) & 3)) : (((row0_ >> 1) & 1) << 2);                       \
      const int f1_ = (DV == 128) ? ((q4 << 2) | (((row0_ + 8) >> 2) & 3)) : ((((row0_ + 8) >> 1) & 1) << 2);           \
      const unsigned a_lo_ = vbase + (unsigned)((row0_ * DV + 8 * (ch_ ^ f0_) + 4 * (p4 & 1)) * 2);                     \
      const unsigned a_hi_ = vbase + (unsigned)(((row0_ + 8) * DV + 8 * (ch_ ^ f1_) + 4 * (p4 & 1)) * 2);
#define ATTN_VRD(T, d)                                                                                                  \
      {                                                                                                                 \
        ATTN_VADDR(d)                                                                                                   \
        asm volatile(                                                                                                   \
            "ds_read_b64_tr_b16 %0, %8\n\t"                                                                             \
            "ds_read_b64_tr_b16 %1, %9\n\t"                                                                             \
            "ds_read_b64_tr_b16 %2, %8 offset:%10\n\t"                                                                  \
            "ds_read_b64_tr_b16 %3, %9 offset:%10\n\t"                                                                  \
            "ds_read_b64_tr_b16 %4, %8 offset:%11\n\t"                                                                  \
            "ds_read_b64_tr_b16 %5, %9 offset:%11\n\t"                                                                  \
            "ds_read_b64_tr_b16 %6, %8 offset:%12\n\t"                                                                  \
            "ds_read_b64_tr_b16 %7, %9 offset:%12"                                                                      \
            : "=&v"(T[0]), "=&v"(T[1]), "=&v"(T[2]), "=&v"(T[3]), "=&v"(T[4]), "=&v"(T[5]), "=&v"(T[6]), "=&v"(T[7])    \
            : "v"(a_lo_), "v"(a_hi_), "i"(16 * DV * 2), "i"(32 * DV * 2), "i"(48 * DV * 2)                              \
            : "memory");                                                                                                \
      }
#define ATTN_VWAIT(T, N)                                                                                                \
      asm volatile("s_waitcnt lgkmcnt(" #N ")"                                                                          \
                   : "+v"(T[0]), "+v"(T[1]), "+v"(T[2]), "+v"(T[3]), "+v"(T[4]), "+v"(T[5]), "+v"(T[6]), "+v"(T[7]) : : "memory");
#define ATTN_VMMA(T, d)                                                                                                 \
      o[d] = mfma32(__builtin_shufflevector(T[0], T[1], 0, 1, 2, 3, 4, 5, 6, 7), pf[0][0], o[d]);                       \
      o[d] = mfma32(__builtin_shufflevector(T[2], T[3], 0, 1, 2, 3, 4, 5, 6, 7), pf[0][1], o[d]);                       \
      o[d] = mfma32(__builtin_shufflevector(T[4], T[5], 0, 1, 2, 3, 4, 5, 6, 7), pf[1][0], o[d]);                       \
      o[d] = mfma32(__builtin_shufflevector(T[6], T[7], 0, 1, 2, 3, 4, 5, 6, 7), pf[1][1], o[d]);
      ATTN_VRD(ta, 0)
#pragma unroll
      for (int d = 0; d < NDB; ++d) {
        if (d + 1 < NDB) {
          if (d & 1) { ATTN_VRD(ta, d + 1) ATTN_VWAIT(tb, 8) ATTN_VMMA(tb, d) }
          else       { ATTN_VRD(tb, d + 1) ATTN_VWAIT(ta, 8) ATTN_VMMA(ta, d) }
        } else {
          if (d & 1) { ATTN_VWAIT(tb, 0) ATTN_VMMA(tb, d) }
          else       { ATTN_VWAIT(ta, 0) ATTN_VMMA(ta, d) }
        }
      }
#undef ATTN_VADDR
#undef ATTN_VRD
#undef ATTN_VWAIT
#undef ATTN_VMMA
    }
  }
  float lt = l + __shfl_xor(l, 32);
  if (p.sink) lt += __builtin_amdgcn_exp2f(p.sink[head] * LOG2E - m);
  const float inv = 1.f / lt;
  bf16* op = p.O + (size_t)(p.o_row0 + b * p.o_bs + tq) * DM + p.o_col0 + head * DV;
#pragma unroll
  for (int d = 0; d < NDB; ++d)
#pragma unroll
    for (int g = 0; g < 4; ++g) {
      bf16x4 ov;
#pragma unroll
      for (int jj = 0; jj < 4; ++jj) ov[jj] = (bf16)(o[d][4 * g + jj] * inv);
      *(bf16x4*)(op + d * 32 + 8 * g + 4 * h) = ov;
    }
}

struct PairTab { int i[50]; int j[50]; };
constexpr PairTab make_pairs() {
  PairTab t{}; int c = 0;
  for (int i = 0; i < 16; ++i) for (int j = 0; j < 16; ++j) if ((i + 1) * (j + 1) <= 16) { t.i[c] = i; t.j[c] = j; ++c; }
  return t;
}
constexpr PairTab PAIRS = make_pairs();
DI float as_f(unsigned u) { return __builtin_bit_cast(float, u); }
DI unsigned as_u(float f) { return __builtin_bit_cast(unsigned, f); }

DI void ce_desc(float& a, float& b) { const float hi = fmaxf(a, b), lo = fminf(a, b); a = hi; b = lo; }
DI void sort16_desc(float (&v)[16]) {
#pragma unroll
  for (int k = 2; k <= 16; k <<= 1)
#pragma unroll
    for (int j = k >> 1; j > 0; j >>= 1)
#pragma unroll
      for (int i = 0; i < 16; ++i) {
        const int l = i ^ j;
        if (l > i) { if ((i & k) == 0) ce_desc(v[i], v[l]); else ce_desc(v[l], v[i]); }
      }
}
DI void bmerge16_desc(float (&v)[16]) {
#pragma unroll
  for (int j = 8; j > 0; j >>= 1)
#pragma unroll
    for (int i = 0; i < 16; ++i) { const int l = i ^ j; if (l > i) ce_desc(v[i], v[l]); }
}
DI void top16_merge(float (&a)[16], const float (&b)[16]) {
#pragma unroll
  for (int i = 0; i < 16; ++i) a[i] = fmaxf(a[i], b[15 - i]);
  bmerge16_desc(a);
}
DI void top16_merge_partner(float (&a)[16]) {
  float b[16];
#pragma unroll
  for (int i = 0; i < 16; ++i) b[i] = __shfl_xor(a[i], 32);
  top16_merge(a, b);
}

DI void peer_select_item(int tile, int hhalf, const bf16* __restrict__ QP, const bf16* __restrict__ SK,
                         int* __restrict__ IDX, float* __restrict__ GW, char* smem) {
  unsigned (*lidx)[64][9] = (unsigned (*)[64][9])smem;
  const int tid = threadIdx.x, lane = tid & 63, wave = tid >> 6;
  const int r = lane & 31, h = lane >> 5;
  const int tok = tile * 32 + r;
  const int head = hhalf * 4 + wave;
  const float NINF = -__builtin_inff();
  float top[2][16];
#pragma unroll
  for (int p = 0; p < 2; ++p) {
    const bf16* qp = QP + (size_t)tok * 2048 + (head * 2 + p) * 128 + 8 * h;
    const bf16* kp = SK + ((size_t)(head * 2 + p) * 128 + r) * 128 + 8 * h;
    f32x16 acc[4];
#pragma unroll
    for (int nb = 0; nb < 4; ++nb)
#pragma unroll
      for (int i = 0; i < 16; ++i) acc[nb][i] = 0.f;
#pragma unroll 2
    for (int ks = 0; ks < 8; ++ks) {
      const bf16x8 bq = *(const bf16x8*)(qp + ks * 16);
#pragma unroll
      for (int nb = 0; nb < 4; ++nb) {
        const bf16x8 a = *(const bf16x8*)(kp + (size_t)nb * 32 * 128 + ks * 16);
        acc[nb] = mfma32(a, bq, acc[nb]);
      }
    }
    float k0[16], k1[16], k2[16], k3[16];
#pragma unroll
    for (int i = 0; i < 16; ++i) {
      k0[i] = as_f((as_u(acc[0][i]) & 0xFFFFFF80u) | (unsigned)(0 * 32 + crow(i, h)));
      k1[i] = as_f((as_u(acc[1][i]) & 0xFFFFFF80u) | (unsigned)(1 * 32 + crow(i, h)));
      k2[i] = as_f((as_u(acc[2][i]) & 0xFFFFFF80u) | (unsigned)(2 * 32 + crow(i, h)));
      k3[i] = as_f((as_u(acc[3][i]) & 0xFFFFFF80u) | (unsigned)(3 * 32 + crow(i, h)));
    }
    sort16_desc(k0); sort16_desc(k1); top16_merge(k0, k1);
    sort16_desc(k2); sort16_desc(k3); top16_merge(k2, k3);
    top16_merge(k0, k2);
    top16_merge_partner(k0);
#pragma unroll
    for (int i = 0; i < 16; ++i) top[p][i] = k0[i];
  }
  float c0[16], c1[16];
  {
    constexpr int LE[8] = {16, 5, 3, 2, 1, 1, 1, 1}, LO[8] = {8, 4, 2, 2, 1, 1, 1, 1};
    int n1 = 0;
#pragma unroll
    for (int ii = 0; ii < 8; ++ii) {
      const float a = h ? top[0][2 * ii + 1] : top[0][2 * ii];
#pragma unroll
      for (int j = 0; j < LE[ii]; ++j) {
        const float sum = a + top[1][j];
        float key = as_f((as_u(sum) & 0xFFFFFF00u) | (unsigned)((2 * ii) * 16 + j) | ((unsigned)h << 4));
        if (j >= LO[ii]) key = h ? NINF : key;
        if (ii == 0) c0[j] = key; else c1[n1++] = key;
      }
    }
    c1[14] = NINF; c1[15] = NINF;
  }
  sort16_desc(c1);
  top16_merge(c0, c1);
  top16_merge_partner(c0);
  float ex[16], sum = 0.f;
#pragma unroll
  for (int k = 0; k < 16; ++k) { ex[k] = __expf(c0[k] - c0[0]); sum += ex[k]; }
  const float inv = 1.f / sum;
  unsigned* my = lidx[wave][lane];
#pragma unroll
  for (int q = 0; q < 4; ++q) {
    my[q] = (as_u(top[0][4 * q]) & 0x7Fu) | ((as_u(top[0][4 * q + 1]) & 0x7Fu) << 8) | ((as_u(top[0][4 * q + 2]) & 0x7Fu) << 16) | ((as_u(top[0][4 * q + 3]) & 0x7Fu) << 24);
    my[4 + q] = (as_u(top[1][4 * q]) & 0x7Fu) | ((as_u(top[1][4 * q + 1]) & 0x7Fu) << 8) | ((as_u(top[1][4 * q + 2]) & 0x7Fu) << 16) | ((as_u(top[1][4 * q + 3]) & 0x7Fu) << 24);
  }
#pragma unroll
  for (int k = 0; k < 16; ++k) {
    const unsigned code = as_u(c0[k]) & 0xFFu;
    const unsigned i = code >> 4, j = code & 15u;
    const unsigned e0 = (my[i >> 2] >> ((i & 3u) * 8u)) & 0x7Fu;
    const unsigned e1 = (my[4 + (j >> 2)] >> ((j & 3u) * 8u)) & 0x7Fu;
    if (h == 0) {
      IDX[(size_t)tok * 128 + head * 16 + k] = (int)(e0 * 128u + e1);
      GW[(size_t)tok * 128 + head * 16 + k] = ex[k] * inv;
    }
  }
}

typedef float f32x4v __attribute__((ext_vector_type(4)));
typedef float f32x2v __attribute__((ext_vector_type(2)));
constexpr float U_SCALE = 64.f, V_SCALE = 8.f;
DI float gelu_exact(float x) { return 0.5f * x * (1.f + erff(x * 0.70710678118654752f)); }
DI bf16x8 fp8x8_to_bf16(unsigned w0, unsigned w1) {
  const f32x2v a = __builtin_amdgcn_cvt_pk_f32_fp8((int)w0, false), b = __builtin_amdgcn_cvt_pk_f32_fp8((int)w0, true);
  const f32x2v c = __builtin_amdgcn_cvt_pk_f32_fp8((int)w1, false), d = __builtin_amdgcn_cvt_pk_f32_fp8((int)w1, true);
  bf16x8 r;
  r[0] = (bf16)a[0]; r[1] = (bf16)a[1]; r[2] = (bf16)b[0]; r[3] = (bf16)b[1];
  r[4] = (bf16)c[0]; r[5] = (bf16)c[1]; r[6] = (bf16)d[0]; r[7] = (bf16)d[1];
  return r;
}

DI void peer_apply_item(int item, const bf16* __restrict__ H2, const int* __restrict__ IDX, const float* __restrict__ GW,
                        const unsigned char* __restrict__ U8, const unsigned char* __restrict__ V8,
                        float* __restrict__ x_lat, float* __restrict__ x_ctx, const float* __restrict__ modl, char* smem) {
  bf16 (*hs)[DM] = (bf16 (*)[DM])smem;
  int tid = threadIdx.x;
  asm volatile("" : "+v"(tid));
  const int lane = tid & 63, wave = tid >> 6;
  const int token = item * 4 + wave;
  const int col16 = lane & 15, kq = lane >> 4;
  __syncthreads();
  {
    const bf16* hp = H2 + (size_t)token * DM;
    *(u32x4*)(&hs[wave][8 * lane]) = *(const u32x4*)(hp + 8 * lane);
    *(u32x4*)(&hs[wave][512 + 8 * lane]) = *(const u32x4*)(hp + 512 + 8 * lane);
  }
  __syncthreads();
  const bf16* hbp = &hs[wave][16 * kq];
  const int id0 = IDX[(size_t)token * 128 + lane], id1 = IDX[(size_t)token * 128 + 64 + lane];
  float y[16];
#pragma unroll
  for (int i = 0; i < 16; ++i) y[i] = 0.f;
  u32x4 wbuf[16], vbuf[8];
  const unsigned voff = 16u * (unsigned)lane;
  {
    const unsigned e = (unsigned)__shfl(id0, col16);
    const unsigned char* up = U8 + (e * 1024u + 16u * (unsigned)kq);
#pragma unroll
    for (int S = 0; S < 8; ++S) wbuf[S] = *(const u32x4*)(up + 64 * S);
  }
  for (int g = 0; g < 8; ++g) {
    asm volatile("" ::: "memory");
    const int idsel = g < 4 ? id0 : id1;
    const int lbase = (g * 16) & 63;
#pragma unroll
    for (int k = 0; k < 8; ++k) {
      const unsigned es = (unsigned)__builtin_amdgcn_readlane(idsel, lbase + k);
      vbuf[k] = *(const u32x4*)(V8 + (es * 1024u + voff));
    }
    {
      const unsigned e = (unsigned)__shfl(idsel, lbase + col16);
      const unsigned char* up = U8 + (e * 1024u + 16u * (unsigned)kq);
#pragma unroll
      for (int S = 8; S < 16; ++S) wbuf[S] = *(const u32x4*)(up + 64 * S);
    }
    f32x4v c = {0.f, 0.f, 0.f, 0.f};
#pragma unroll
    for (int S = 0; S < 16; ++S) {
      const bf16x8 a0 = fp8x8_to_bf16(wbuf[S][0], wbuf[S][1]), a1 = fp8x8_to_bf16(wbuf[S][2], wbuf[S][3]);
      c = __builtin_amdgcn_mfma_f32_16x16x32_bf16(a0, *(const bf16x8*)(hbp + 64 * S), c, 0, 0, 0);
      c = __builtin_amdgcn_mfma_f32_16x16x32_bf16(a1, *(const bf16x8*)(hbp + 64 * S + 8), c, 0, 0, 0);
      if ((S & 1) == 1) __builtin_amdgcn_sched_barrier(0);
    }
    const float4 gw = *(const float4*)(GW + (size_t)token * 128 + g * 16 + kq * 4);
    float w[4];
    w[0] = gelu_exact(c[0] * (1.f / U_SCALE)) * gw.x; w[1] = gelu_exact(c[1] * (1.f / U_SCALE)) * gw.y;
    w[2] = gelu_exact(c[2] * (1.f / U_SCALE)) * gw.z; w[3] = gelu_exact(c[3] * (1.f / U_SCALE)) * gw.w;
    __builtin_amdgcn_sched_barrier(0);
    if (g < 7) {
      const int idn = (g + 1) < 4 ? id0 : id1;
      const unsigned e = (unsigned)__shfl(idn, (((g + 1) * 16) & 63) + col16);
      const unsigned char* up = U8 + (e * 1024u + 16u * (unsigned)kq);
#pragma unroll
      for (int S = 0; S < 8; ++S) wbuf[S] = *(const u32x4*)(up + 64 * S);
    }
    __builtin_amdgcn_sched_barrier(0);
#pragma unroll
    for (int k = 0; k < 16; ++k) {
      const float ws = as_f((unsigned)__builtin_amdgcn_readlane((int)as_u(w[k & 3]), (k >> 2) * 16));
#pragma unroll
      for (int j = 0; j < 4; ++j) {
        const f32x2v lo = __builtin_amdgcn_cvt_pk_f32_fp8((int)vbuf[k & 7][j], false), hi = __builtin_amdgcn_cvt_pk_f32_fp8((int)vbuf[k & 7][j], true);
        y[4 * j + 0] += ws * lo[0]; y[4 * j + 1] += ws * lo[1]; y[4 * j + 2] += ws * hi[0]; y[4 * j + 3] += ws * hi[1];
      }
      if (k < 8) {
        const unsigned es = (unsigned)__builtin_amdgcn_readlane(idsel, lbase + k + 8);
        vbuf[k] = *(const u32x4*)(V8 + (es * 1024u + voff));
      }
      __builtin_amdgcn_sched_barrier(0);
    }
  }
  float* xr; int b;
  if (token < NLAT) { xr = x_lat + (size_t)token * DM; b = token / SEQ; } else { xr = x_ctx + (size_t)(token - NLAT) * DM; b = 4; }
  const float* gate = modl + (size_t)b * 6144 + 5 * 1024;
#pragma unroll
  for (int q = 0; q < 4; ++q) {
    const int col = 16 * lane + 4 * q;
    float4 xv = *(float4*)(xr + col);
    const float4 gv = *(const float4*)(gate + col);
    xv.x += gv.x * y[4 * q + 0] * (1.f / V_SCALE); xv.y += gv.y * y[4 * q + 1] * (1.f / V_SCALE);
    xv.z += gv.z * y[4 * q + 2] * (1.f / V_SCALE); xv.w += gv.w * y[4 * q + 3] * (1.f / V_SCALE);
    *(float4*)(xr + col) = xv;
  }
}

DI void mla_post1_item(int item, bf16* __restrict__ P1, const float* __restrict__ qan, const float* __restrict__ kvan,
                       const float* __restrict__ krn, const float* __restrict__ cs, const float* __restrict__ sn,
                       bf16* __restrict__ KPE) {
  const int lane = threadIdx.x & 63, wave = threadIdx.x >> 6;
  const int row = item * 4 + wave;
  bf16* pr = P1 + (size_t)row * 768;
  const bool act1 = lane < 24;
  const bf16x8 va = *(const bf16x8*)(pr + 8 * lane);
  bf16x8 vb;
#pragma unroll
  for (int j = 0; j < 8; ++j) vb[j] = (bf16)0.f;
  if (act1) vb = *(const bf16x8*)(pr + 512 + 8 * lane);
  float a[8], c[8];
  float sa = 0.f, sb = 0.f;
#pragma unroll
  for (int j = 0; j < 8; ++j) { a[j] = (float)va[j]; c[j] = (float)vb[j]; sa += a[j] * a[j]; sb += c[j] * c[j]; }
  const float ss_q = wave_sum(lane < 48 ? sa : 0.f);
  const float ss_kv = wave_sum((lane >= 48 ? sa : 0.f) + (lane < 16 ? sb : 0.f));
  const float ss_kr = wave_sum((lane >= 16 && lane < 24) ? sb : 0.f);
  {
    const float rs = lane < 48 ? rsqrtf(ss_q * (1.f / 384.f) + EPS) : rsqrtf(ss_kv * (1.f / 256.f) + EPS);
    const float* g = lane < 48 ? qan + 8 * lane : kvan + 8 * (lane - 48);
    const float4 g0 = *(const float4*)g, g1 = *(const float4*)(g + 4);
    bf16x8 ov;
    ov[0] = (bf16)(a[0] * rs * g0.x); ov[1] = (bf16)(a[1] * rs * g0.y); ov[2] = (bf16)(a[2] * rs * g0.z); ov[3] = (bf16)(a[3] * rs * g0.w);
    ov[4] = (bf16)(a[4] * rs * g1.x); ov[5] = (bf16)(a[5] * rs * g1.y); ov[6] = (bf16)(a[6] * rs * g1.z); ov[7] = (bf16)(a[7] * rs * g1.w);
    *(bf16x8*)(pr + 8 * lane) = ov;
  }
  if (lane < 16) {
    const float rs = rsqrtf(ss_kv * (1.f / 256.f) + EPS);
    const float* g = kvan + 128 + 8 * lane;
    const float4 g0 = *(const float4*)g, g1 = *(const float4*)(g + 4);
    bf16x8 ov;
    ov[0] = (bf16)(c[0] * rs * g0.x); ov[1] = (bf16)(c[1] * rs * g0.y); ov[2] = (bf16)(c[2] * rs * g0.z); ov[3] = (bf16)(c[3] * rs * g0.w);
    ov[4] = (bf16)(c[4] * rs * g1.x); ov[5] = (bf16)(c[5] * rs * g1.y); ov[6] = (bf16)(c[6] * rs * g1.z); ov[7] = (bf16)(c[7] * rs * g1.w);
    *(bf16x8*)(pr + 512 + 8 * lane) = ov;
  } else if (lane < 24) {
    const int c8 = lane - 16;
    const float rs = rsqrtf(ss_kr * (1.f / 64.f) + EPS);
    const float4 g0 = *(const float4*)(krn + 8 * c8), g1 = *(const float4*)(krn + 8 * c8 + 4);
    float y[8] = {c[0] * rs * g0.x, c[1] * rs * g0.y, c[2] * rs * g0.z, c[3] * rs * g0.w, c[4] * rs * g1.x, c[5] * rs * g1.y, c[6] * rs * g1.z, c[7] * rs * g1.w};
    int orow;
    if (row < NLAT) {
      const int b = row / SEQ, t = row % SEQ;
      const float4 cs4 = *(const float4*)(cs + t * 32 + c8 * 4), sn4 = *(const float4*)(sn + t * 32 + c8 * 4);
      float o0;
      o0 = y[0] * cs4.x - y[1] * sn4.x; y[1] = y[0] * sn4.x + y[1] * cs4.x; y[0] = o0;
      o0 = y[2] * cs4.y - y[3] * sn4.y; y[3] = y[2] * sn4.y + y[3] * cs4.y; y[2] = o0;
      o0 = y[4] * cs4.z - y[5] * sn4.z; y[5] = y[4] * sn4.z + y[5] * cs4.z; y[4] = o0;
      o0 = y[6] * cs4.w - y[7] * sn4.w; y[7] = y[6] * sn4.w + y[7] * cs4.w; y[6] = o0;
      orow = b * NKEY + NCX + t;
    } else {
      const int rc = row - NLAT;
      orow = (rc / NCX) * NKEY + (rc % NCX);
    }
    bf16x8 ov;
#pragma unroll
    for (int j = 0; j < 8; ++j) ov[j] = (bf16)y[j];
    *(bf16x8*)(KPE + (size_t)orow * 64 + 8 * c8) = ov;
  }
}

DI void mla_qpost_item(int item, bf16* __restrict__ Q, const float* __restrict__ qnn, const float* __restrict__ qnr,
                       const float* __restrict__ cs, const float* __restrict__ sn) {
  const int lane = threadIdx.x & 63, wave = threadIdx.x >> 6;
  const int row = item * 4 + wave;
  const int t = row % SEQ;
  bf16* qr = Q + (size_t)row * 1536;
#pragma unroll
  for (int k = 0; k < 2; ++k) {
    const int head = (lane >> 4) + 4 * k, pos = lane & 15;
    bf16* qp = qr + head * 192 + pos * 8;
    const bf16x8 nv = *(const bf16x8*)qp;
    float v[8]; float ss = 0.f;
#pragma unroll
    for (int j = 0; j < 8; ++j) { v[j] = (float)nv[j]; ss += v[j] * v[j]; }
    ss += __shfl_xor(ss, 8); ss += __shfl_xor(ss, 4); ss += __shfl_xor(ss, 2); ss += __shfl_xor(ss, 1);
    const float rs = rsqrtf(ss * (1.f / 128.f) + EPS);
    const float4 g0 = *(const float4*)(qnn + pos * 8), g1 = *(const float4*)(qnn + pos * 8 + 4);
    bf16x8 ov;
    ov[0] = (bf16)(v[0] * rs * g0.x); ov[1] = (bf16)(v[1] * rs * g0.y); ov[2] = (bf16)(v[2] * rs * g0.z); ov[3] = (bf16)(v[3] * rs * g0.w);
    ov[4] = (bf16)(v[4] * rs * g1.x); ov[5] = (bf16)(v[5] * rs * g1.y); ov[6] = (bf16)(v[6] * rs * g1.z); ov[7] = (bf16)(v[7] * rs * g1.w);
    *(bf16x8*)qp = ov;
  }
  {
    const int head = lane >> 3, c8 = lane & 7;
    bf16* qp = qr + head * 192 + 128 + c8 * 8;
    const bf16x8 pv = *(const bf16x8*)qp;
    float y[8]; float ss = 0.f;
#pragma unroll
    for (int j = 0; j < 8; ++j) { y[j] = (float)pv[j]; ss += y[j] * y[j]; }
    ss += __shfl_xor(ss, 4); ss += __shfl_xor(ss, 2); ss += __shfl_xor(ss, 1);
    const float rs = rsqrtf(ss * (1.f / 64.f) + EPS);
    const float4 g0 = *(const float4*)(qnr + c8 * 8), g1 = *(const float4*)(qnr + c8 * 8 + 4);
    y[0] *= rs * g0.x; y[1] *= rs * g0.y; y[2] *= rs * g0.z; y[3] *= rs * g0.w; y[4] *= rs * g1.x; y[5] *= rs * g1.y; y[6] *= rs * g1.z; y[7] *= rs * g1.w;
    const float4 cs4 = *(const float4*)(cs + t * 32 + c8 * 4), sn4 = *(const float4*)(sn + t * 32 + c8 * 4);
    float o0;
    o0 = y[0] * cs4.x - y[1] * sn4.x; y[1] = y[0] * sn4.x + y[1] * cs4.x; y[0] = o0;
    o0 = y[2] * cs4.y - y[3] * sn4.y; y[3] = y[2] * sn4.y + y[3] * cs4.y; y[2] = o0;
    o0 = y[4] * cs4.z - y[5] * sn4.z; y[5] = y[4] * sn4.z + y[5] * cs4.z; y[4] = o0;
    o0 = y[6] * cs4.w - y[7] * sn4.w; y[7] = y[6] * sn4.w + y[7] * cs4.w; y[6] = o0;
    bf16x8 ov;
#pragma unroll
    for (int j = 0; j < 8; ++j) ov[j] = (bf16)y[j];
    *(bf16x8*)qp = ov;
  }
}

DI void mla_kpost_item(int item, bf16* __restrict__ KV, const float* __restrict__ knn) {
  const int lane = threadIdx.x & 63, wave = threadIdx.x >> 6;
  const int row = item * 4 + wave;
#pragma unroll
  for (int k = 0; k < 2; ++k) {
    const int head = (lane >> 4) + 4 * k, pos = lane & 15;
    bf16* kp = KV + (size_t)row * 2048 + head * 256 + pos * 8;
    const bf16x8 nv = *(const bf16x8*)kp;
    float v[8]; float ss = 0.f;
#pragma unroll
    for (int j = 0; j < 8; ++j) { v[j] = (float)nv[j]; ss += v[j] * v[j]; }
    ss += __shfl_xor(ss, 8); ss += __shfl_xor(ss, 4); ss += __shfl_xor(ss, 2); ss += __shfl_xor(ss, 1);
    const float rs = rsqrtf(ss * (1.f / 128.f) + EPS);
    const float4 g0 = *(const float4*)(knn + pos * 8), g1 = *(const float4*)(knn + pos * 8 + 4);
    bf16x8 ov;
    ov[0] = (bf16)(v[0] * rs * g0.x); ov[1] = (bf16)(v[1] * rs * g0.y); ov[2] = (bf16)(v[2] * rs * g0.z); ov[3] = (bf16)(v[3] * rs * g0.w);
    ov[4] = (bf16)(v[4] * rs * g1.x); ov[5] = (bf16)(v[5] * rs * g1.y); ov[6] = (bf16)(v[6] * rs * g1.z); ov[7] = (bf16)(v[7] * rs * g1.w);
    *(bf16x8*)kp = ov;
  }
}

struct MegaParams {
  const float *x, *c, *ctx, *c_ctx, *mod_w, *mod_b, *mix_norm, *ffn_norm, *even_w_in, *even_w_out, *a_q_norm, *a_k_norm, *b_q_norm,
      *b_k_norm, *b_sink, *mla_w_in, *mla_q_a_norm, *mla_kv_a_norm, *mla_w_uq, *mla_w_ukv, *mla_q_nope_norm, *mla_q_rope_norm,
      *mla_k_nope_norm, *mla_k_rope_norm, *mla_w_out, *peer_w_query, *peer_sub_keys, *peer_u, *peer_v;
  float* out;
  unsigned* bar;
  float *MOD, *RCS, *RSN, *CTXS;
  bf16 *W_EIN, *W_EOUT, *W_PQ, *W_MIN, *W_UQ, *W_UKV, *W_MOUT, *SKB, *HA, *HB;
  unsigned char *U8, *V8;
  int* IDX;
  float* GW;
  char* R;
};

DI unsigned long long uptr64(const LAS unsigned long long* slot) {
  const unsigned long long v = *slot;
  const unsigned lo = __builtin_amdgcn_readfirstlane((unsigned)v), hi = __builtin_amdgcn_readfirstlane((unsigned)(v >> 32));
  return ((unsigned long long)hi << 32) | lo;
}
template <class T> DI T* as_global(T*, unsigned long long v) { return (T*)(__attribute__((address_space(1))) T*)v; }
#define LP(f) as_global((decltype(sp.f))nullptr, uptr64((const LAS unsigned long long*)&sp.f))

#define rP0 ((bf16*)Rb)
#define rQA ((bf16*)(Rb + (size_t)NTOK * 1536 * 2))
#define rQB (rQA + (size_t)NB * 8 * SEQ * 64)
#define rCQA (rQB + (size_t)NB * 8 * SEQ * 64)
#define rCQB (rCQA + (size_t)NB * 8 * NCX * 64)
#define rKA (rCQB + (size_t)NB * 8 * NCX * 64)
#define rVA (rKA + (size_t)NB * 2 * NKEY * 64)
#define rKB (rVA + (size_t)NB * 2 * NKEY * 64)
#define rVB (rKB + (size_t)NB * 2 * NKEY * 64)
#define rQP ((bf16*)Rb)
#define rKPE ((bf16*)Rb)
#define rQRAW (rKPE + (size_t)NB * NKEY * 64)
#define rKVRAW (rQRAW + (size_t)NLAT * 1536)

__global__ __launch_bounds__(256, 2) void mega_kernel(MegaParams kp) {
  __shared__ __attribute__((aligned(16))) char lds_all[SMEM_BYTES + 16 + ((sizeof(MegaParams) + 15) / 16) * 16];
  char* const smem = lds_all;
  uint4& xb_words = *(uint4*)(lds_all + SMEM_BYTES);
  MegaParams& sp = *(MegaParams*)(lds_all + SMEM_BYTES + 16);
  if (threadIdx.x == 0) { xb_words = make_uint4(0u, 0u, 0u, 0u); sp = kp; }
  __syncthreads();
  XcdBarrier bar = xcd_barrier_post(LP(bar), (volatile LAS unsigned*)&xb_words);
  const int G = gridDim.x, bid = blockIdx.x;

  {
    const float *c = LP(c), *c_ctx = LP(c_ctx), *mod_w = LP(mod_w), *mod_b = LP(mod_b); float* MOD = LP(MOD);
    for (int item = bid; item < 192; item += G) mod_item(item, c, c_ctx, mod_w, mod_b, MOD, smem);
  }
  rope_phase(LP(RCS), LP(RSN));
  transpose_phase(LP(even_w_in), LP(W_EIN), 1024, 1536, 1536, smem);
  transpose_phase(LP(even_w_out), LP(W_EOUT), 1024, 1024, 1024, smem);
  transpose_phase(LP(peer_w_query), LP(W_PQ), 1024, 2048, 2048, smem);
  transpose_phase(LP(peer_w_query) + (size_t)1024 * 2048, LP(W_PQ) + (size_t)2048 * 1024, 1024, 2048, 2048, smem);
  transpose_phase(LP(mla_w_in), LP(W_MIN), 1024, 704, 768, smem);
  transpose_phase(LP(mla_w_uq), LP(W_UQ), 384, 1536, 1536, smem);
  transpose_phase(LP(mla_w_ukv), LP(W_UKV), 256, 2048, 2048, smem);
  transpose_phase(LP(mla_w_out), LP(W_MOUT), 1024, 1024, 1024, smem);
  convert_phase((const float4*)LP(peer_sub_keys), (bf16x4*)LP(SKB), (size_t)2 * 16 * 128 * 128 / 4);
  convert_fp8_phase((const float4*)LP(peer_u), (unsigned*)LP(U8), (size_t)2 * 16384 * 1024 / 4, U_SCALE);
  convert_fp8_phase((const float4*)LP(peer_v), (unsigned*)LP(V8), (size_t)2 * 16384 * 1024 / 4, V_SCALE);
  xcd_barrier(bar);

  {
    const float *x = LP(x), *ctx = LP(ctx), *g = LP(mix_norm), *M = LP(MOD); bf16* H = LP(HA);
    for (int it = bid; it < NTOK / 4; it += G) norm_mod_item(it, x, ctx, g, M, 0, H);
  }
  xcd_barrier(bar);
  {
    char* const Rb = LP(R);
    GemmEpi e{}; e.Cb = rP0; e.ldc = 1536;
    gemm_phase<EPI_BF16>(LP(HA), 1024, LP(W_EIN), 1024, e, NTOK, 1536, smem);
  }
  xcd_barrier(bar);
  {
    char* const Rb = LP(R);
    Post0 q{}; q.P = rP0; q.aqn = LP(a_q_norm); q.akn = LP(a_k_norm); q.bqn = LP(b_q_norm); q.bkn = LP(b_k_norm); q.cs = LP(RCS); q.sn = LP(RSN);
    q.QA = rQA; q.QB = rQB; q.CQA = rCQA; q.CQB = rCQB; q.KA = rKA; q.VA = rVA; q.KB = rKB; q.VB = rVB;
    for (int it = bid; it < NTOK / 4; it += G) qkv_post0_item(it, q);
  }
  xcd_barrier(bar);
  {
    char* const Rb = LP(R);
    bf16* const HBp = LP(HB);
    const float* const sinkp = LP(b_sink);
    const int xcd = bid & 7, nj = G >> 3;
    const int b = xcd >> 1, hkv = xcd & 1;
    for (int t = bid >> 3; t < 528; t += nj) {
      AttnParams a{};
      const bool isC = t >= 512;
      const bool isB = isC ? (t >= 520) : (t >= 256);
      a.q_ts = 64; a.k_ts = 64; a.v_ts = 64; a.G = 4; a.scale_log2 = 0.125f * LOG2E;
      a.K = isB ? rKB : rKA; a.V = isB ? rVB : rVA;
      a.k_bs = (long)2 * NKEY * 64; a.k_hs = (long)NKEY * 64; a.v_bs = a.k_bs; a.v_hs = a.k_hs;
      a.O = HBp; a.o_col0 = isB ? 512 : 0; a.sink = isB ? sinkp : nullptr;
      int qblk, head;
      if (!isC) {
        const int li = t & 255;
        qblk = li & 63; head = hkv * 4 + (li >> 6);
        a.Q = isB ? rQB : rQA; a.q_bs = (long)8 * SEQ * 64; a.q_hs = (long)SEQ * 64;
        a.o_row0 = 0; a.o_bs = SEQ; a.nkeys = NKEY;
      } else {
        const int li = (t - 512) & 7;
        qblk = li & 1; head = hkv * 4 + (li >> 1);
        a.Q = isB ? rCQB : rCQA; a.q_bs = (long)8 * NCX * 64; a.q_hs = (long)NCX * 64;
        a.o_row0 = NLAT; a.o_bs = NCX; a.nkeys = NCX;
      }
      if (isB && !isC) attn_item<64, 64, 64, 2, true>(a, qblk, head, b, smem);
      else attn_item<64, 64, 64, 2, false>(a, qblk, head, b, smem);
    }
  }
  xcd_barrier(bar);
  {
    GemmEpi e{}; e.out_lat = LP(out); e.res_lat = LP(x); e.out_ctx = LP(CTXS); e.res_ctx = LP(ctx); e.modl = LP(MOD); e.gchunk = 2;
    gemm_phase<EPI_RESID>(LP(HB), 1024, LP(W_EOUT), 1024, e, NTOK, 1024, smem);
  }
  xcd_barrier(bar);
  {
    const float *x = LP(out), *ctx = LP(CTXS), *g = LP(ffn_norm), *M = LP(MOD); bf16* H = LP(HA);
    for (int it = bid; it < NTOK / 4; it += G) norm_mod_item(it, x, ctx, g, M, 3, H);
  }
  xcd_barrier(bar);
  {
    char* const Rb = LP(R);
    GemmEpi e{}; e.Cb = rQP; e.ldc = 2048;
    gemm_phase<EPI_BF16>(LP(HA), 1024, LP(W_PQ), 1024, e, NTOK, 2048, smem);
  }
  xcd_barrier(bar);
  {
    char* const Rb = LP(R);
    const bf16* QPp = rQP; const bf16* SK = LP(SKB); int* IDX = LP(IDX); float* GW = LP(GW);
    for (int item = bid; item < (NTOK / 32) * 2; item += G) peer_select_item(item >> 1, item & 1, QPp, SK, IDX, GW, smem);
  }
  xcd_barrier(bar);
  {
    const bf16* H = LP(HA); const int* IDX = LP(IDX); const float* GW = LP(GW); const unsigned char *U8 = LP(U8), *V8 = LP(V8);
    float *xo = LP(out), *xc = LP(CTXS); const float* M = LP(MOD);
    for (int item = bid; item < NTOK / 4; item += G) peer_apply_item(item, H, IDX, GW, U8, V8, xo, xc, M, smem);
  }
  xcd_barrier(bar);

  {
    const float *x = LP(out), *ctx = LP(CTXS), *g = LP(mix_norm) + 1024, *M = LP(MOD) + 5 * 6144; bf16* H = LP(HA);
    for (int it = bid; it < NTOK / 4; it += G) norm_mod_item(it, x, ctx, g, M, 0, H);
  }
  xcd_barrier(bar);
  {
    GemmEpi e{}; e.Cb = LP(HB); e.ldc = 768;
    gemm_phase<EPI_BF16>(LP(HA), 1024, LP(W_MIN), 1024, e, NTOK, 768, smem);
  }
  xcd_barrier(bar);
  {
    char* const Rb = LP(R);
    bf16* P1 = LP(HB); const float *qa = LP(mla_q_a_norm), *kva = LP(mla_kv_a_norm), *krn = LP(mla_k_rope_norm), *cs = LP(RCS), *sn = LP(RSN);
    bf16* KPEp = rKPE;
    for (int it = bid; it < NTOK / 4; it += G) mla_post1_item(it, P1, qa, kva, krn, cs, sn, KPEp);
  }
  xcd_barrier(bar);
  {
    char* const Rb = LP(R);
    GemmEpi e{}; e.Cb = rQRAW; e.ldc = 1536;
    gemm_phase<EPI_BF16>(LP(HB), 768, LP(W_UQ), 384, e, NLAT, 1536, smem);
    GemmEpi e2{}; e2.Cb = rKVRAW; e2.ldc = 2048; e2.rowmap = 1;
    gemm_phase<EPI_BF16>(LP(HB) + 384, 768, LP(W_UKV), 256, e2, NTOK, 2048, smem);
  }
  xcd_barrier(bar);
  {
    char* const Rb = LP(R);
    bf16* Qr = rQRAW; bf16* KVr = rKVRAW;
    const float *qnn = LP(mla_q_nope_norm), *qnr = LP(mla_q_rope_norm), *knn = LP(mla_k_nope_norm), *cs = LP(RCS), *sn = LP(RSN);
    for (int it = bid; it < NLAT / 4; it += G) mla_qpost_item(it, Qr, qnn, qnr, cs, sn);
    for (int it = bid; it < NB * NKEY / 4; it += G) mla_kpost_item(it, KVr, knn);
  }
  xcd_barrier(bar);
  {
    char* const Rb = LP(R);
    AttnParams a{}; a.Q = rQRAW; a.q_bs = (long)SEQ * 1536; a.q_hs = 192; a.q_ts = 1536;
    a.K = rKVRAW; a.k_bs = (long)NKEY * 2048; a.k_hs = 256; a.k_ts = 2048;
    a.K2 = rKPE; a.k2_bs = (long)NKEY * 64; a.k2_ts = 64;
    a.V = rKVRAW + 128; a.v_bs = (long)NKEY * 2048; a.v_hs = 256; a.v_ts = 2048;
    a.O = LP(HA); a.o_row0 = 0; a.o_bs = SEQ; a.o_col0 = 0; a.sink = nullptr; a.nkeys = NKEY; a.G = 1; a.window = 0;
    a.scale_log2 = 0.07216878364870322f * LOG2E;
    const int xcd = bid & 7, nj = G >> 3;
    for (int t = bid >> 3; t < 256; t += nj) {
      const int bh = (t >> 6) * 8 + xcd;
      attn_item<192, 128, 128, 1, false>(a, t & 63, bh & 7, bh >> 3, smem);
    }
  }
  xcd_barrier(bar);
  {
    GemmEpi e{}; e.out_lat = LP(out); e.res_lat = LP(out); e.out_ctx = LP(CTXS); e.res_ctx = LP(CTXS); e.modl = LP(MOD) + 5 * 6144; e.gchunk = 2;
    gemm_phase<EPI_RESID>(LP(HA), 1024, LP(W_MOUT), 1024, e, NLAT, 1024, smem);
  }
  xcd_barrier(bar);
  {
    const float *x = LP(out), *ctx = LP(CTXS), *g = LP(ffn_norm) + 1024, *M = LP(MOD) + 5 * 6144; bf16* H = LP(HB);
    for (int it = bid; it < NLAT / 4; it += G) norm_mod_item(it, x, ctx, g, M, 3, H);
  }
  xcd_barrier(bar);
  {
    char* const Rb = LP(R);
    GemmEpi e{}; e.Cb = rQP; e.ldc = 2048;
    gemm_phase<EPI_BF16>(LP(HB), 1024, LP(W_PQ) + (size_t)2048 * 1024, 1024, e, NLAT, 2048, smem);
  }
  xcd_barrier(bar);
  {
    char* const Rb = LP(R);
    const bf16* QPp = rQP; const bf16* SK = LP(SKB) + (size_t)16 * 128 * 128; int* IDX = LP(IDX); float* GW = LP(GW);
    for (int item = bid; item < (NLAT / 32) * 2; item += G) peer_select_item(item >> 1, item & 1, QPp, SK, IDX, GW, smem);
  }
  xcd_barrier(bar);
  {
    const bf16* H = LP(HB); const int* IDX = LP(IDX); const float* GW = LP(GW);
    const unsigned char *U8 = LP(U8) + (size_t)16384 * 1024, *V8 = LP(V8) + (size_t)16384 * 1024;
    float *xo = LP(out), *xc = LP(CTXS); const float* M = LP(MOD) + 5 * 6144;
    for (int item = bid; item < NLAT / 4; item += G) peer_apply_item(item, H, IDX, GW, U8, V8, xo, xc, M, smem);
  }
}

static inline size_t align_up(size_t v, size_t a) { return (v + a - 1) / a * a; }

extern "C" void kernel_launch(void* const* d_in, const int* in_sizes, int n_in,
                              void* d_out, int out_size, void* d_ws, size_t ws_size,
                              hipStream_t stream) {
  MegaParams p{};
  const float** fp = (const float**)&p;
  for (int i = 0; i < 29; ++i) fp[i] = (const float*)d_in[i];
  p.out = (float*)d_out;
  char* w = (char*)d_ws;
  size_t off = 0;
  auto take = [&](size_t bytes) { char* q = w + off; off = align_up(off + bytes, 256); return q; };
  p.bar = (unsigned*)take(XCD_BAR_WORDS * 4);
  p.MOD = (float*)take(2 * 5 * 6144 * 4);
  p.RCS = (float*)take((size_t)SEQ * 32 * 4);
  p.RSN = (float*)take((size_t)SEQ * 32 * 4);
  p.CTXS = (float*)take((size_t)NCTXT * DM * 4);
  p.W_EIN = (bf16*)take((size_t)1536 * 1024 * 2);
  p.W_EOUT = (bf16*)take((size_t)1024 * 1024 * 2);
  p.W_PQ = (bf16*)take((size_t)2 * 2048 * 1024 * 2);
  p.W_MIN = (bf16*)take((size_t)768 * 1024 * 2);
  p.W_UQ = (bf16*)take((size_t)1536 * 384 * 2);
  p.W_UKV = (bf16*)take((size_t)2048 * 256 * 2);
  p.W_MOUT = (bf16*)take((size_t)1024 * 1024 * 2);
  p.SKB = (bf16*)take((size_t)2 * 16 * 128 * 128 * 2);
  p.HA = (bf16*)take((size_t)NTOK * DM * 2);
  p.HB = (bf16*)take((size_t)NTOK * DM * 2);
  p.U8 = (unsigned char*)take((size_t)2 * 16384 * 1024);
  p.V8 = (unsigned char*)take((size_t)2 * 16384 * 1024);
  p.IDX = (int*)take((size_t)NTOK * 128 * 4);
  p.GW = (float*)take((size_t)NTOK * 128 * 4);
  p.R = take((size_t)250 * 1024 * 1024);

  static int grid = 0;
  if (!grid) {
    int dev = 0, cus = 0, per_cu = 0;
    hipGetDevice(&dev);
    hipDeviceGetAttribute(&cus, hipDeviceAttributeMultiprocessorCount, dev);
    hipOccupancyMaxActiveBlocksPerMultiprocessor(&per_cu, mega_kernel, 256, 0);
    if (per_cu > 2) per_cu = 2;
    if (per_cu < 1) per_cu = 1;
    grid = cus * per_cu;
  }
  hipMemsetAsync(p.bar, 0, XCD_BAR_WORDS * 4, stream);
  mega_kernel<<<grid, 256, 0, stream>>>(p);
}
```

```cpp
#include <hip/hip_runtime.h>
#include <stdint.h>

typedef __bf16 bf16;
typedef __bf16 bf16x8 __attribute__((ext_vector_type(8)));
typedef __bf16 bf16x4 __attribute__((ext_vector_type(4)));
typedef __bf16 bf16x2 __attribute__((ext_vector_type(2)));
typedef float f32x16 __attribute__((ext_vector_type(16)));
typedef unsigned u32x4 __attribute__((ext_vector_type(4)));
#define LAS __attribute__((address_space(3)))
#define DI __device__ __forceinline__

constexpr int DM = 1024, NB = 4, SEQ = 8192, NCX = 256;
constexpr int NLAT = NB * SEQ, NCTXT = NB * NCX, NTOK = NLAT + NCTXT, NKEY = SEQ + NCX;
constexpr float EPS = 1e-6f;
constexpr float LOG2E = 1.4426950408889634f;

DI int crow(int i, int h) { return (i & 3) + 8 * (i >> 2) + 4 * h; }
DI f32x16 mfma32(bf16x8 a, bf16x8 b, f32x16 c) { return __builtin_amdgcn_mfma_f32_32x32x16_bf16(a, b, c, 0, 0, 0); }
DI float silu(float v) { return v / (1.f + __expf(-v)); }


#define XB_TMO      128
#define XB_XCNT(j)  (256  + 64 * (j))
#define XB_XSUB(j)  (1280 + 64 * (j))
#define XB_XGEN(j)  (2304 + 64 * (j))
#define XB_TOP      3328
#define XB_TOPGEN   3392
#define XCD_BAR_WORDS 3456
#define XB_SPIN_CAP (1u << 18)

__device__ __forceinline__ unsigned xb_ld(unsigned* p)              { return __hip_atomic_load(p, __ATOMIC_RELAXED, __HIP_MEMORY_SCOPE_AGENT); }
__device__ __forceinline__ unsigned xb_add(unsigned* p, unsigned v) { return __hip_atomic_fetch_add(p, v, __ATOMIC_RELAXED, __HIP_MEMORY_SCOPE_AGENT); }
__device__ __forceinline__ unsigned xb_xcc_id() { return (unsigned)__builtin_amdgcn_s_getreg((3 << 11) | 20) & 0xFu; }
#define XB_SPIN(cond, bar) do { unsigned _sp = 0; while (cond) { __builtin_amdgcn_s_sleep(1); \
    if ((++_sp & 255u) == 0u) { if (xb_ld(&(bar)[XB_TMO])) break; if (_sp > XB_SPIN_CAP) { atomicAdd(&(bar)[XB_TMO], 1u); break; } } } } while (0)

struct XcdBarrier { unsigned* bar; unsigned x; volatile LAS unsigned* st; };

__device__ __forceinline__ XcdBarrier xcd_barrier_post(unsigned* bar, volatile LAS unsigned* st) {
    XcdBarrier b; b.bar = bar; b.x = xb_xcc_id(); b.st = st;
    if (threadIdx.x == 0) (void)xb_add(&bar[XB_XCNT(b.x)], 1u);
    return b;
}
__device__ __forceinline__ void xcd_barrier_complete(unsigned* bar, unsigned x, unsigned& nloc, unsigned& nx) {
    const unsigned G = gridDim.x * gridDim.y * gridDim.z;
    unsigned sum, cnt, mine, sp = 0u;
    for (;;) {
        sum = 0u; cnt = 0u; mine = 0u;
#pragma unroll
        for (unsigned j = 0; j < 16; ++j) { const unsigned c = xb_ld(&bar[XB_XCNT(j)]); sum += c; cnt += (c > 0u) ? 1u : 0u; mine = (j == x) ? c : mine; }
        if (sum == G) break;
        __builtin_amdgcn_s_sleep(1);
        if ((++sp & 255u) == 0u) { if (xb_ld(&bar[XB_TMO])) break; if (sp > XB_SPIN_CAP) { atomicAdd(&bar[XB_TMO], 1u); break; } }
    }
    nloc = mine > 0u ? mine : 1u; nx = cnt > 0u ? cnt : 1u;
}
__device__ __forceinline__ void xcd_barrier(const XcdBarrier& b) {
    asm volatile("s_waitcnt vmcnt(0)" ::: "memory");
    __syncthreads();
    if (threadIdx.x == 0) {
        unsigned* bar = b.bar;
        __builtin_amdgcn_s_waitcnt(0);
        unsigned nloc = b.st[0], nx = b.st[1];
        if (nloc == 0u) { xcd_barrier_complete(bar, b.x, nloc, nx); b.st[0] = nloc; b.st[1] = nx; }
        const unsigned old = xb_add(&bar[XB_XSUB(b.x)], 1u);
        const unsigned gen = old / nloc;
        if (old + 1u == (gen + 1u) * nloc) {
            __builtin_amdgcn_fence(__ATOMIC_RELEASE, "agent");
            asm volatile("s_waitcnt vmcnt(0)" ::: "memory");
            const unsigned og = xb_add(&bar[XB_TOP], 1u);
            const unsigned tg = og / nx;
            if (og + 1u == (tg + 1u) * nx) xb_add(&bar[XB_TOPGEN], 1u);
            else XB_SPIN(xb_ld(&bar[XB_TOPGEN]) == tg, bar);
            __builtin_amdgcn_fence(__ATOMIC_ACQUIRE, "agent");
            xb_add(&bar[XB_XGEN(b.x)], 1u);
            asm volatile("s_waitcnt vmcnt(0)" ::: "memory");
        } else {
            XB_SPIN(xb_ld(&bar[XB_XGEN(b.x)]) == gen, bar);
            __builtin_amdgcn_fence(__ATOMIC_ACQUIRE, "agent");
            asm volatile("s_waitcnt vmcnt(0)" ::: "memory");
        }
    }
    __syncthreads();
}

constexpr int SMEM_BYTES = 73728;

DI void mod_item(int item, const float* __restrict__ c, const float* __restrict__ c_ctx, const float* __restrict__ mod_w,
                 const float* __restrict__ mod_b, float* __restrict__ mod, char* smem) {
  float (*sv)[1024] = (float (*)[1024])smem;
  float (*part)[5][64] = (float (*)[5][64])(smem + 5 * 1024 * 4);
  const int tid = threadIdx.x, l = item / 96, bx = item % 96;
  for (int i = tid; i < 5 * 1024; i += 256) {
    const int b = i >> 10, k = i & 1023;
    const float v = b < 4 ? c[b * 1024 + k] : c_ctx[k];
    sv[b][k] = silu(v);
  }
  __syncthreads();
  const int nn = tid & 63, kg = tid >> 6;
  const int n = bx * 64 + nn;
  const float* w = mod_w + (size_t)l * 1024 * 6144 + n;
  float a0 = 0, a1 = 0, a2 = 0, a3 = 0, a4 = 0;
  for (int k = kg * 256; k < kg * 256 + 256; ++k) {
    const float wv = w[(size_t)k * 6144];
    a0 += sv[0][k] * wv; a1 += sv[1][k] * wv; a2 += sv[2][k] * wv; a3 += sv[3][k] * wv; a4 += sv[4][k] * wv;
  }
  part[kg][0][nn] = a0; part[kg][1][nn] = a1; part[kg][2][nn] = a2; part[kg][3][nn] = a3; part[kg][4][nn] = a4;
  __syncthreads();
  for (int i = tid; i < 5 * 64; i += 256) {
    const int b = i >> 6, j = i & 63;
    const float s = part[0][b][j] + part[1][b][j] + part[2][b][j] + part[3][b][j];
    mod[((size_t)l * 5 + b) * 6144 + bx * 64 + j] = s + mod_b[(size_t)l * 6144 + bx * 64 + j];
  }
  __syncthreads();
}

DI void rope_phase(float* __restrict__ cs, float* __restrict__ sn) {
  for (int idx = blockIdx.x * 256 + threadIdx.x; idx < SEQ * 32; idx += gridDim.x * 256) {
    const int t = idx >> 5, i = idx & 31;
    const int row = t >> 6, col = t & 63;
    const int fi = i & 15;
    const float inv = powf(10000.f, -(float)(2 * fi) / 32.f);
    const float ang = (i < 16 ? (float)row : (float)col) * inv;
    cs[idx] = cosf(ang);
    sn[idx] = sinf(ang);
  }
}

DI void transpose_item(int item, const float* __restrict__ W, bf16* __restrict__ Wt, int K, int N, int Npad, char* smem) {
  float (*tile)[33] = (float (*)[33])smem;
  const int tx = threadIdx.x & 31, ty = threadIdx.x >> 5;
  const int ntn = Npad / 32;
  const int n0 = (item % ntn) * 32, k0 = (item / ntn) * 32;
  for (int j = ty; j < 32; j += 8) {
    const int k = k0 + j, n = n0 + tx;
    tile[j][tx] = (n < N) ? W[(size_t)k * N + n] : 0.f;
  }
  __syncthreads();
  for (int j = ty; j < 32; j += 8) {
    const int n = n0 + j, k = k0 + tx;
    Wt[(size_t)n * K + k] = (bf16)tile[tx][j];
  }
  __syncthreads();
}
DI void transpose_phase(const float* __restrict__ W, bf16* __restrict__ Wt, int K, int N, int Npad, char* smem) {
  const int nitems = (Npad / 32) * (K / 32);
  for (int item = blockIdx.x; item < nitems; item += gridDim.x) transpose_item(item, W, Wt, K, N, Npad, smem);
}

DI void convert_phase(const float4* __restrict__ src, bf16x4* __restrict__ dst, size_t n4) {
  for (size_t i = blockIdx.x * (size_t)256 + threadIdx.x; i < n4; i += (size_t)gridDim.x * 256) {
    const float4 v = src[i];
    bf16x4 o; o[0] = (bf16)v.x; o[1] = (bf16)v.y; o[2] = (bf16)v.z; o[3] = (bf16)v.w;
    dst[i] = o;
  }
}


DI void convert_fp8_phase(const float4* __restrict__ src, unsigned* __restrict__ dst, size_t n4, float scale) {
  for (size_t i = blockIdx.x * (size_t)256 + threadIdx.x; i < n4; i += (size_t)gridDim.x * 256) {
    const float4 v = src[i];
    int w = 0;
    w = __builtin_amdgcn_cvt_pk_fp8_f32(v.x * scale, v.y * scale, w, false);
    w = __builtin_amdgcn_cvt_pk_fp8_f32(v.z * scale, v.w * scale, w, true);
    dst[i] = (unsigned)w;
  }
}

typedef float f32x16v __attribute__((ext_vector_type(16)));
typedef float f32x32v __attribute__((ext_vector_type(32)));
typedef unsigned u32x6 __attribute__((ext_vector_type(6)));
typedef unsigned u32x2 __attribute__((ext_vector_type(2)));
template <bool VLAYOUT>
DI void convert_fp6_phase(const float* __restrict__ src, unsigned char* __restrict__ dst, size_t nblk, float scale) {
  for (size_t i = blockIdx.x * (size_t)256 + threadIdx.x; i < nblk; i += (size_t)gridDim.x * 256) {
    const float4* sp4 = (const float4*)(src + i * 32);
    f32x16v a, b;
#pragma unroll
    for (int q = 0; q < 8; ++q) {
      const float4 v = sp4[q];
      a[2 * q] = v.x * scale; b[2 * q] = v.y * scale; a[2 * q + 1] = v.z * scale; b[2 * q + 1] = v.w * scale;
    }
    const u32x6 p = __builtin_amdgcn_cvt_scalef32_2xpk16_fp6_f32(a, b, 1.0f);
    u32x2 t0, t1, t2; t0[0] = p[0]; t0[1] = p[1]; t1[0] = p[2]; t1[1] = p[3]; t2[0] = p[4]; t2[1] = p[5];
    unsigned char* row = dst + (i >> 5) * 768;
    const int q = (int)(i & 31);
    if (VLAYOUT) {
      *(u32x2*)(row + 8 * q) = t0; *(u32x2*)(row + 256 + 8 * q) = t1; *(u32x2*)(row + 512 + 8 * q) = t2;
    } else {
      const int Q = q >> 1, S = Q >> 2, kq = Q & 3;
      unsigned char* ch = row + 192 * S + 16 * kq;
      if ((q & 1) == 0) { *(u32x2*)(ch) = t0; *(u32x2*)(ch + 8) = t1; *(u32x2*)(ch + 64) = t2; }
      else              { *(u32x2*)(ch + 64 + 8) = t0; *(u32x2*)(ch + 128) = t1; *(u32x2*)(ch + 128 + 8) = t2; }
    }
  }
}

DI float wave_sum(float v) {
#pragma unroll
  for (int o = 32; o > 0; o >>= 1) v += __shfl_xor(v, o);
  return v;
}
DI void norm_mod_item(int item, const float* __restrict__ src_lat, const float* __restrict__ src_ctx, const float* __restrict__ gain,
                      const float* __restrict__ modl, int chunk, bf16* __restrict__ H) {
  const int lane = threadIdx.x & 63, wave = threadIdx.x >> 6;
  const int row = item * 4 + wave;
  const float* src; int b;
  if (row < NLAT) { src = src_lat + (size_t)row * DM; b = row / SEQ; } else { src = src_ctx + (size_t)(row - NLAT) * DM; b = 4; }
  float4 v[4];
#pragma unroll
  for (int k = 0; k < 4; ++k) v[k] = ((const float4*)src)[lane + 64 * k];
  float ss = 0.f;
#pragma unroll
  for (int k = 0; k < 4; ++k) ss += v[k].x * v[k].x + v[k].y * v[k].y + v[k].z * v[k].z + v[k].w * v[k].w;
  ss = wave_sum(ss);
  const float rs = rsqrtf(ss * (1.f / DM) + EPS);
  const float4* gp = (const float4*)gain;
  const float4* shp = (const float4*)(modl + (size_t)b * 6144 + chunk * 1024);
  const float4* scp = (const float4*)(modl + (size_t)b * 6144 + (chunk + 1) * 1024);
#pragma unroll
  for (int k = 0; k < 4; ++k) {
    const float4 g = gp[lane + 64 * k], sh = shp[lane + 64 * k], sc = scp[lane + 64 * k];
    bf16x4 o;
    o[0] = (bf16)(v[k].x * rs * g.x * (1.f + sc.x) + sh.x);
    o[1] = (bf16)(v[k].y * rs * g.y * (1.f + sc.y) + sh.y);
    o[2] = (bf16)(v[k].z * rs * g.z * (1.f + sc.z) + sh.z);
    o[3] = (bf16)(v[k].w * rs * g.w * (1.f + sc.w) + sh.w);
    ((bf16x4*)(H + (size_t)row * DM))[lane + 64 * k] = o;
  }
}

constexpr int GBM = 128, GBN = 128, GBK = 64, GLD = 72;
enum { EPI_BF16 = 0, EPI_RESID = 1 };
struct GemmEpi {
  bf16* Cb; int ldc; int rowmap;
  float* out_lat; const float* res_lat; float* out_ctx; const float* res_ctx; const float* modl; int gchunk;
};

template <int EPI>
DI void gemm_tile(const bf16* __restrict__ A, int lda, const bf16* __restrict__ Bt, int K, const GemmEpi& e, int m0, int n0, char* smem) {
  const int tid = threadIdx.x, lane = tid & 63, wave = tid >> 6, wm = wave >> 1, wn = wave & 1;
  const int wave_u = __builtin_amdgcn_readfirstlane(wave);
  const int r = lane & 31, h = lane >> 5;
  const int drow = 8 * wave_u + (lane >> 3);
  const int dcol = ((lane & 7) ^ ((((wave_u & 1) << 2) | (lane >> 4)) & 7)) * 8;
  const bf16* Ag = A + (size_t)(m0 + drow) * lda + dcol;
  const bf16* Bg = Bt + (size_t)(n0 + drow) * K + dcol;
  f32x16 acc[2][2];
#pragma unroll
  for (int i = 0; i < 2; ++i)
#pragma unroll
    for (int j = 0; j < 2; ++j)
#pragma unroll
      for (int q = 0; q < 16; ++q) acc[i][j][q] = 0.f;
  const int nt = K / GBK;
  auto issue = [&](int t, int buf) {
#pragma unroll
    for (int i = 0; i < 4; ++i) {
      __builtin_amdgcn_global_load_lds((const unsigned*)(Ag + (size_t)(32 * i) * lda + t * GBK), (LAS unsigned*)(smem + buf * 32768 + (wave_u + 4 * i) * 1024), 16, 0, 0);
      __builtin_amdgcn_global_load_lds((const unsigned*)(Bg + (size_t)(32 * i) * K + t * GBK), (LAS unsigned*)(smem + buf * 32768 + 16384 + (wave_u + 4 * i) * 1024), 16, 0, 0);
    }
  };
  const int kswz = (r >> 1) & 7;
  issue(0, 0);
  for (int t = 0; t < nt; ++t) {
    asm volatile("s_waitcnt vmcnt(0)" ::: "memory");
    __syncthreads();
    if (t + 1 < nt) issue(t + 1, (t + 1) & 1);
    const bf16* as = (const bf16*)(smem + (t & 1) * 32768) + (wm * 64 + r) * 64;
    const bf16* bs = (const bf16*)(smem + (t & 1) * 32768 + 16384) + (wn * 64 + r) * 64;
#pragma unroll
    for (int ks = 0; ks < 4; ++ks) {
      const int so = 8 * (((2 * ks + h) ^ kswz) & 7);
      const bf16x8 a0 = *(const bf16x8*)(as + so), a1 = *(const bf16x8*)(as + 32 * 64 + so);
      const bf16x8 b0 = *(const bf16x8*)(bs + so), b1 = *(const bf16x8*)(bs + 32 * 64 + so);
      acc[0][0] = mfma32(a0, b0, acc[0][0]);
      acc[0][1] = mfma32(a0, b1, acc[0][1]);
      acc[1][0] = mfma32(a1, b0, acc[1][0]);
      acc[1][1] = mfma32(a1, b1, acc[1][1]);
    }
  }
  __syncthreads();
  if constexpr (EPI == EPI_BF16) {
    constexpr int CLD = 136;
    bf16* Cs = (bf16*)smem;
#pragma unroll
    for (int mi = 0; mi < 2; ++mi)
#pragma unroll
      for (int ni = 0; ni < 2; ++ni)
#pragma unroll
        for (int i = 0; i < 16; ++i) Cs[(wm * 64 + mi * 32 + crow(i, h)) * CLD + wn * 64 + ni * 32 + r] = (bf16)acc[mi][ni][i];
    __syncthreads();
    const int ch = tid & 15, r0 = tid >> 4;
#pragma unroll
    for (int k = 0; k < 8; ++k) {
      const int lrow = r0 + 16 * k, row = m0 + lrow;
      int orow = row;
      if (e.rowmap) orow = row < NLAT ? (row / SEQ) * NKEY + NCX + (row % SEQ) : ((row - NLAT) / NCX) * NKEY + ((row - NLAT) % NCX);
      *(u32x4*)(e.Cb + (size_t)orow * e.ldc + n0 + ch * 8) = *(const u32x4*)(Cs + lrow * CLD + ch * 8);
    }
  } else {
    constexpr int CLD = 132;
    float* Cs = (float*)smem;
#pragma unroll
    for (int mi = 0; mi < 2; ++mi)
#pragma unroll
      for (int ni = 0; ni < 2; ++ni)
#pragma unroll
        for (int i = 0; i < 16; ++i) Cs[(wm * 64 + mi * 32 + crow(i, h)) * CLD + wn * 64 + ni * 32 + r] = acc[mi][ni][i];
    __syncthreads();
    const int ch = tid & 31, r0 = tid >> 5;
    const bool lat = m0 < NLAT;
    const int b = lat ? m0 / SEQ : 4;
    const float4 g = *(const float4*)(e.modl + (size_t)b * 6144 + e.gchunk * 1024 + n0 + ch * 4);
    float* outp = lat ? e.out_lat + (size_t)m0 * DM : e.out_ctx + (size_t)(m0 - NLAT) * DM;
    const float* resp = lat ? e.res_lat + (size_t)m0 * DM : e.res_ctx + (size_t)(m0 - NLAT) * DM;
#pragma unroll
    for (int k = 0; k < 16; ++k) {
      const int lrow = r0 + 8 * k;
      const float4 c = *(const float4*)(Cs + lrow * CLD + ch * 4);
      float4 x = *(const float4*)(resp + (size_t)lrow * DM + n0 + ch * 4);
      x.x += g.x * c.x; x.y += g.y * c.y; x.z += g.z * c.z; x.w += g.w * c.w;
      *(float4*)(outp + (size_t)lrow * DM + n0 + ch * 4) = x;
    }
  }
  __syncthreads();
}
template <int EPI>
DI void gemm_phase(const bf16* __restrict__ A, int lda, const bf16* __restrict__ Bt, int K, const GemmEpi& e, int M, int N, char* smem) {
  const int ntn = N / GBN, ntm = M / GBM;
  const int G = gridDim.x;
  if ((G & 7) == 0 && (ntm & 7) == 0) {
    const int xcd = blockIdx.x & 7, nj = G >> 3, pm = ntm >> 3, nloc = pm * ntn;
    for (int u = blockIdx.x >> 3; u < nloc; u += nj) gemm_tile<EPI>(A, lda, Bt, K, e, (xcd * pm + u / ntn) * GBM, (u % ntn) * GBN, smem);
  } else {
    const int nitems = ntm * ntn;
    for (int item = blockIdx.x; item < nitems; item += G) gemm_tile<EPI>(A, lda, Bt, K, e, (item / ntn) * GBM, (item % ntn) * GBN, smem);
  }
}

struct Post0 {
  const bf16* P;
  const float *aqn, *akn, *bqn, *bkn, *cs, *sn;
  bf16 *QA, *QB, *CQA, *CQB, *KA, *VA, *KB, *VB;
};
DI void qkv_post0_item(int item, const Post0& p) {
  const int lane = threadIdx.x & 63, wave = threadIdx.x >> 6;
  const int row = item * 4 + wave;
  const bool lat = row < NLAT;
  int b, t;
  if (lat) { b = row / SEQ; t = row % SEQ; } else { const int rc = row - NLAT; b = rc / NCX; t = rc % NCX; }
  const int key = lat ? NCX + t : t;
  const int c8 = lane & 7;
  float4 cs4 = {1.f, 1.f, 1.f, 1.f}, sn4 = {0.f, 0.f, 0.f, 0.f};
  if (lat) { cs4 = *(const float4*)(p.cs + t * 32 + c8 * 4); sn4 = *(const float4*)(p.sn + t * 32 + c8 * 4); }
#pragma unroll
  for (int k = 0; k < 3; ++k) {
    const int c = lane + 64 * k, slot = c >> 3;
    const bf16x8 pv = *(const bf16x8*)(p.P + (size_t)row * 1536 + c * 8);
    float v[8];
#pragma unroll
    for (int j = 0; j < 8; ++j) v[j] = (float)pv[j];
    const bool isv = (slot == 10 || slot == 11 || slot == 22 || slot == 23);
    float ss = 0.f;
#pragma unroll
    for (int j = 0; j < 8; ++j) ss += v[j] * v[j];
    ss += __shfl_xor(ss, 4); ss += __shfl_xor(ss, 2); ss += __shfl_xor(ss, 1);
    if (!isv) {
      const float rs = rsqrtf(ss * (1.f / 64.f) + EPS);
      const float* g = (slot < 8 ? p.aqn : slot < 10 ? p.akn : slot < 20 ? p.bqn : p.bkn) + c8 * 8;
      const float4 g0 = *(const float4*)g, g1 = *(const float4*)(g + 4);
      v[0] *= rs * g0.x; v[1] *= rs * g0.y; v[2] *= rs * g0.z; v[3] *= rs * g0.w;
      v[4] *= rs * g1.x; v[5] *= rs * g1.y; v[6] *= rs * g1.z; v[7] *= rs * g1.w;
      if (lat) {
        float o0;
        o0 = v[0] * cs4.x - v[1] * sn4.x; v[1] = v[0] * sn4.x + v[1] * cs4.x; v[0] = o0;
        o0 = v[2] * cs4.y - v[3] * sn4.y; v[3] = v[2] * sn4.y + v[3] * cs4.y; v[2] = o0;
        o0 = v[4] * cs4.z - v[5] * sn4.z; v[5] = v[4] * sn4.z + v[5] * cs4.z; v[4] = o0;
        o0 = v[6] * cs4.w - v[7] * sn4.w; v[7] = v[6] * sn4.w + v[7] * cs4.w; v[6] = o0;
      }
    }
    bf16x8 ov;
#pragma unroll
    for (int j = 0; j < 8; ++j) ov[j] = (bf16)v[j];
    bf16* dst;
    if (slot < 8) dst = lat ? p.QA + ((size_t)(b * 8 + slot) * SEQ + t) * 64 : p.CQA + ((size_t)(b * 8 + slot) * NCX + t) * 64;
    else if (slot < 10) dst = p.KA + ((size_t)(b * 2 + slot - 8) * NKEY + key) * 64;
    else if (slot < 12) dst = p.VA + ((size_t)(b * 2 + slot - 10) * NKEY + key) * 64;
    else if (slot < 20) dst = lat ? p.QB + ((size_t)(b * 8 + slot - 12) * SEQ + t) * 64 : p.CQB + ((size_t)(b * 8 + slot - 12) * NCX + t) * 64;
    else if (slot < 22) dst = p.KB + ((size_t)(b * 2 + slot - 20) * NKEY + key) * 64;
    else dst = p.VB + ((size_t)(b * 2 + slot - 22) * NKEY + key) * 64;
    *(bf16x8*)(dst + c8 * 8) = ov;
  }
}

struct AttnParams {
  const bf16* Q; long q_bs, q_hs; int q_ts;
  const bf16* K; long k_bs, k_hs; int k_ts;
  const bf16* K2; long k2_bs; int k2_ts;
  const bf16* V; long v_bs, v_hs; int v_ts;
  bf16* O; int o_row0, o_bs, o_col0;
  const float* sink;
  int nkeys;
  int G;
  int window;
  float scale_log2;
};

template <int DQK, int DV, int DSPLIT, int VBUFS, bool WINDOW>
DI void attn_item(const AttnParams& p, int qblk, int head, int b, char* smem) {
  constexpr int KCH = DQK / 8, VCH = DV / 8;
  constexpr int KPW = KCH / 4, VPW = VCH / 4;
  constexpr int KBYTES = 64 * DQK * 2, VBYTES = 64 * DV * 2;
  constexpr int NKS = DQK / 16, NDB = DV / 32;
  char* Kbase = smem;
  char* Vbase = smem + 2 * KBYTES;
  const int tid = threadIdx.x, lane = tid & 63, wave = tid >> 6;
  const int wave_u = __builtin_amdgcn_readfirstlane(wave);
  const int r = lane & 31, h = lane >> 5;
  const int q0 = qblk * 128;
  const int hkv = head / p.G;
  const int tq = q0 + wave * 32 + r;

  bf16x8 qf[NKS];
  {
    const bf16* qp = p.Q + (size_t)b * p.q_bs + (size_t)head * p.q_hs + (size_t)tq * p.q_ts + 8 * h;
#pragma unroll
    for (int ks = 0; ks < NKS; ++ks) qf[ks] = *(const bf16x8*)(qp + ks * 16);
  }
  int ntiles, lo = 0;
  if (WINDOW) {
    lo = q0 - 128 < 0 ? 0 : q0 - 128;
    const int hi = q0 + 256 > SEQ ? SEQ : q0 + 256;
    ntiles = 4 + (hi - lo) / 64;
  } else {
    ntiles = p.nkeys / 64;
  }
  const bf16* Kb = p.K + (size_t)b * p.k_bs + (size_t)hkv * p.k_hs;
  const bf16* K2b = (DSPLIT < DQK) ? p.K2 + (size_t)b * p.k2_bs : nullptr;
  const bf16* Vb = p.V + (size_t)b * p.v_bs + (size_t)hkv * p.v_hs;

  auto key0_of = [&](int j) -> int { return WINDOW ? (j < 4 ? j * 64 : NCX + lo + (j - 4) * 64) : j * 64; };
  const int krow_l = 8 * wave_u + (lane >> 3);
  const int kcol_l = (lane & 7) ^ ((((wave_u & 1) << 2) | (lane >> 4)) & 7);
  auto issue_k = [&](int j, int buf) {
    const int k0 = key0_of(j);
#pragma unroll
    for (int i = 0; i < KPW; ++i) {
      const int g = i >> 1, row = krow_l + 32 * (i & 1);
      const bf16* src;
      if (DSPLIT == DQK || g * 64 < DSPLIT) src = Kb + (size_t)(k0 + row) * p.k_ts + (8 * g + kcol_l) * 8;
      else src = K2b + (size_t)(k0 + row) * p.k2_ts + ((8 * g + kcol_l) * 8 - DSPLIT);
      __builtin_amdgcn_global_load_lds((const unsigned*)src, (LAS unsigned*)(Kbase + buf * KBYTES + g * 8192 + (wave_u + 4 * (i & 1)) * 1024), 16, 0, 0);
    }
  };
  const int vrow_l = (DV == 128) ? 4 * wave_u + (lane >> 4) : 8 * wave_u + (lane >> 3);
  const int vcol_l = (DV == 128) ? ((lane & 15) ^ (((lane >> 4) << 2) | (wave_u & 3))) : ((lane & 7) ^ (((lane >> 4) & 1) << 2));
  auto issue_v = [&](int j, int buf) {
    const int k0 = key0_of(j);
#pragma unroll
    for (int i = 0; i < VPW; ++i) {
      const int row = vrow_l + ((DV == 128) ? 16 : 32) * i;
      const bf16* src = Vb + (size_t)(k0 + row) * p.v_ts + vcol_l * 8;
      __builtin_amdgcn_global_load_lds((const unsigned*)src, (LAS unsigned*)(Vbase + buf * VBYTES + (wave_u + 4 * i) * 1024), 16, 0, 0);
    }
  };

  f32x16 o[NDB];
#pragma unroll
  for (int d = 0; d < NDB; ++d)
#pragma unroll
    for (int i = 0; i < 16; ++i) o[d][i] = 0.f;
  float m = -1e30f, l = 0.f;
  const int i16 = lane & 15, q4 = i16 >> 2, p4 = i16 & 3, g1 = (lane >> 4) & 1;
  const int kswz = (r >> 1) & 7;

  __syncthreads();
  issue_k(0, 0);
  if (VBUFS == 2) issue_v(0, 0);
  for (int j = 0; j < ntiles; ++j) {
    asm volatile("s_waitcnt vmcnt(0)" ::: "memory");
    __syncthreads();
    if (VBUFS == 1) issue_v(j, 0);
    if (j + 1 < ntiles) { issue_k(j + 1, (j + 1) & 1); if (VBUFS == 2) issue_v(j + 1, (j + 1) & 1); }
    const bf16* Ks = (const bf16*)(Kbase + (j & 1) * KBYTES);
    const bf16* Vs = (const bf16*)(Vbase + (VBUFS == 2 ? (j & 1) * VBYTES : 0));

    f32x16 s[2];
#pragma unroll
    for (int mb = 0; mb < 2; ++mb)
#pragma unroll
      for (int i = 0; i < 16; ++i) s[mb][i] = 0.f;
    {
      constexpr int GPM = NKS / 4, NG = 2 * GPM;
      bf16x8 fa[4], fb[4];
#define ATTN_KRD(F, g)                                                                                                   \
  _Pragma("unroll") for (int i = 0; i < 4; ++i) {                                                                      \
    const int c = 2 * ((((g) % GPM) * 4) + i) + h;                                                                      \
    F[i] = *(const bf16x8*)(&Ks[(c >> 3) * 4096 + (((g) / GPM) * 32 + r) * 64 + 8 * ((c ^ kswz) & 7)]);                \
  }
      ATTN_KRD(fa, 0)
#pragma unroll
      for (int g = 0; g < NG; ++g) {
        if (g + 1 < NG) { if (g & 1) { ATTN_KRD(fa, g + 1) } else { ATTN_KRD(fb, g + 1) } }
        __builtin_amdgcn_sched_barrier(0);
#pragma unroll
        for (int i = 0; i < 4; ++i) s[g / GPM] = mfma32((g & 1) ? fb[i] : fa[i], qf[(g % GPM) * 4 + i], s[g / GPM]);
        __builtin_amdgcn_sched_barrier(0);
      }
#undef ATTN_KRD
    }
    const bool band = WINDOW && j >= 4;
    const int pos0 = lo + (j - 4) * 64;
    float mx = -1e30f;
#pragma unroll
    for (int mb = 0; mb < 2; ++mb)
#pragma unroll
      for (int i = 0; i < 16; ++i) {
        if (WINDOW) {
          if (band) {
            const int dlt = pos0 + mb * 32 + crow(i, h) - tq;
            if (dlt > 128 || dlt < -128) s[mb][i] = -1e30f;
          }
        }
        mx = fmaxf(mx, s[mb][i]);
      }
    mx = fmaxf(mx, __shfl_xor(mx, 32)) * p.scale_log2;
    if (__any(mx > m + 8.f)) {
      const float mn = fmaxf(m, mx);
      const float alpha = __builtin_amdgcn_exp2f(m - mn);
      m = mn;
      l *= alpha;
#pragma unroll
      for (int d = 0; d < NDB; ++d)
#pragma unroll
        for (int i = 0; i < 16; ++i) o[d][i] *= alpha;
    }
    float ls = 0.f;
#pragma unroll
    for (int mb = 0; mb < 2; ++mb)
#pragma unroll
      for (int i = 0; i < 16; ++i) {
        const float ev = __builtin_amdgcn_exp2f(__builtin_fmaf(s[mb][i], p.scale_log2, -m));
        s[mb][i] = ev;
        ls += ev;
      }
    l += ls;
    bf16x8 pf[2][2];
#pragma unroll
    for (int mb = 0; mb < 2; ++mb)
#pragma unroll
      for (int s2 = 0; s2 < 2; ++s2)
#pragma unroll
        for (int jj = 0; jj < 8; ++jj) pf[mb][s2][jj] = (bf16)s[mb][8 * s2 + jj];
    if (VBUFS == 1) {
      asm volatile("s_waitcnt vmcnt(0)" ::: "memory");
      __syncthreads();
    }
    {
      const unsigned vbase = (unsigned)(size_t)Vs;
      bf16x4 ta[8], tb[8];
#define ATTN_VADDR(d)                                                                                                   \
      const int row0_ = 4 * h + q4;                                                                                     \
      const int ch_ = (d) * 4 + 2 * g1 + (p4 >> 1);                                                                     \
      const int f0_ = (DV == 128) ? ((q4 << 2) | ((row0_ >> 2) & 3)) : (((row0_ >> 1) & 1) << 2);                       \
      const int f1_ = (DV == 128) ? ((q4 << 2) | (((row0_ + 8) >> 2) & 3)) : ((((row0_ + 8) >> 1) & 1) << 2);           \
      const unsigned a_lo_ = vbase + (unsigned)((row0_ * DV + 8 * (ch_ ^ f0_) + 4 * (p4 & 1)) * 2);                     \
      const unsigned a_hi_ = vbase + (unsigned)(((row0_ + 8) * DV + 8 * (ch_ ^ f1_) + 4 * (p4 & 1)) * 2);
#define ATTN_VRD(T, d)                                                                                                  \
      {                                                                                                                 \
        ATTN_VADDR(d)                                                                                                   \
        asm volatile(                                                                                                   \
            "ds_read_b64_tr_b16 %0, %8\n\t"                                                                             \
            "ds_read_b64_tr_b16 %1, %9\n\t"                                                                             \
            "ds_read_b64_tr_b16 %2, %8 offset:%10\n\t"                                                                  \
            "ds_read_b64_tr_b16 %3, %9 offset:%10\n\t"                                                                  \
            "ds_read_b64_tr_b16 %4, %8 offset:%11\n\t"                                                                  \
            "ds_read_b64_tr_b16 %5, %9 offset:%11\n\t"                                                                  \
            "ds_read_b64_tr_b16 %6, %8 offset:%12\n\t"                                                                  \
            "ds_read_b64_tr_b16 %7, %9 offset:%12"                                                                      \
            : "=&v"(T[0]), "=&v"(T[1]), "=&v"(T[2]), "=&v"(T[3]), "=&v"(T[4]), "=&v"(T[5]), "=&v"(T[6]), "=&v"(T[7])    \
            : "v"(a_lo_), "v"(a_hi_), "i"(16 * DV * 2), "i"(32 * DV * 2), "i"(48 * DV * 2)                              \
            : "memory");                                                                                                \
      }
#define ATTN_VWAIT(T, N)                                                                                                \
      asm volatile("s_waitcnt lgkmcnt(" #N ")"                                                                          \
                   : "+v"(T[0]), "+v"(T[1]), "+v"(T[2]), "+v"(T[3]), "+v"(T[4]), "+v"(T[5]), "+v"(T[6]), "+v"(T[7]) : : "memory");
#define ATTN_VMMA(T, d)                                                                                                 \
      o[d] = mfma32(__builtin_shufflevector(T[0], T[1], 0, 1, 2, 3, 4, 5, 6, 7), pf[0][0], o[d]);                       \
      o[d] = mfma32(__builtin_shufflevector(T[2], T[3], 0, 1, 2, 3, 4, 5, 6, 7), pf[0][1], o[d]);                       \
      o[d] = mfma32(__builtin_shufflevector(T[4], T[5], 0, 1, 2, 3, 4, 5, 6, 7), pf[1][0], o[d]);                       \
      o[d] = mfma32(__builtin_shufflevector(T[6], T[7], 0, 1, 2, 3, 4, 5, 6, 7), pf[1][1], o[d]);
      ATTN_VRD(ta, 0)
#pragma unroll
      for (int d = 0; d < NDB; ++d) {
        if (d + 1 < NDB) {
          if (d & 1) { ATTN_VRD(ta, d + 1) ATTN_VWAIT(tb, 8) ATTN_VMMA(tb, d) }
          else       { ATTN_VRD(tb, d + 1) ATTN_VWAIT(ta, 8) ATTN_VMMA(ta, d) }
        } else {
          if (d & 1) { ATTN_VWAIT(tb, 0) ATTN_VMMA(tb, d) }
          else       { ATTN_VWAIT(ta, 0) ATTN_VMMA(ta, d) }
        }
      }
#undef ATTN_VADDR
#undef ATTN_VRD
#undef ATTN_VWAIT
#undef ATTN_VMMA
    }
  }
  float lt = l + __shfl_xor(l, 32);
  if (p.sink) lt += __builtin_amdgcn_exp2f(p.sink[head] * LOG2E - m);
  const float inv = 1.f / lt;
  bf16* op = p.O + (size_t)(p.o_row0 + b * p.o_bs + tq) * DM + p.o_col0 + head * DV;
#pragma unroll
  for (int d = 0; d < NDB; ++d)
#pragma unroll
    for (int g = 0; g < 4; ++g) {
      bf16x4 ov;
#pragma unroll
      for (int jj = 0; jj < 4; ++jj) ov[jj] = (bf16)(o[d][4 * g + jj] * inv);
      *(bf16x4*)(op + d * 32 + 8 * g + 4 * h) = ov;
    }
}

struct PairTab { int i[50]; int j[50]; };
constexpr PairTab make_pairs() {
  PairTab t{}; int c = 0;
  for (int i = 0; i < 16; ++i) for (int j = 0; j < 16; ++j) if ((i + 1) * (j + 1) <= 16) { t.i[c] = i; t.j[c] = j; ++c; }
  return t;
}
constexpr PairTab PAIRS = make_pairs();
DI float as_f(unsigned u) { return __builtin_bit_cast(float, u); }
DI unsigned as_u(float f) { return __builtin_bit_cast(unsigned, f); }

DI void ce_desc(float& a, float& b) { const float hi = fmaxf(a, b), lo = fminf(a, b); a = hi; b = lo; }
DI void sort16_desc(float (&v)[16]) {
#pragma unroll
  for (int k = 2; k <= 16; k <<= 1)
#pragma unroll
    for (int j = k >> 1; j > 0; j >>= 1)
#pragma unroll
      for (int i = 0; i < 16; ++i) {
        const int l = i ^ j;
        if (l > i) { if ((i & k) == 0) ce_desc(v[i], v[l]); else ce_desc(v[l], v[i]); }
      }
}
DI void bmerge16_desc(float (&v)[16]) {
#pragma unroll
  for (int j = 8; j > 0; j >>= 1)
#pragma unroll
    for (int i = 0; i < 16; ++i) { const int l = i ^ j; if (l > i) ce_desc(v[i], v[l]); }
}
DI void top16_merge(float (&a)[16], const float (&b)[16]) {
#pragma unroll
  for (int i = 0; i < 16; ++i) a[i] = fmaxf(a[i], b[15 - i]);
  bmerge16_desc(a);
}
DI void top16_merge_partner(float (&a)[16]) {
  float b[16];
#pragma unroll
  for (int i = 0; i < 16; ++i) b[i] = __shfl_xor(a[i], 32);
  top16_merge(a, b);
}

DI void peer_select_item(int tile, int hhalf, const bf16* __restrict__ QP, const bf16* __restrict__ SK,
                         int* __restrict__ IDX, float* __restrict__ GW, char* smem) {
  unsigned (*lidx)[64][9] = (unsigned (*)[64][9])smem;
  const int tid = threadIdx.x, lane = tid & 63, wave = tid >> 6;
  const int r = lane & 31, h = lane >> 5;
  const int tok = tile * 32 + r;
  const int head = hhalf * 4 + wave;
  const float NINF = -__builtin_inff();
  float top[2][16];
#pragma unroll
  for (int p = 0; p < 2; ++p) {
    const bf16* qp = QP + (size_t)tok * 2048 + (head * 2 + p) * 128 + 8 * h;
    const bf16* kp = SK + ((size_t)(head * 2 + p) * 128 + r) * 128 + 8 * h;
    f32x16 acc[4];
#pragma unroll
    for (int nb = 0; nb < 4; ++nb)
#pragma unroll
      for (int i = 0; i < 16; ++i) acc[nb][i] = 0.f;
#pragma unroll 2
    for (int ks = 0; ks < 8; ++ks) {
      const bf16x8 bq = *(const bf16x8*)(qp + ks * 16);
#pragma unroll
      for (int nb = 0; nb < 4; ++nb) {
        const bf16x8 a = *(const bf16x8*)(kp + (size_t)nb * 32 * 128 + ks * 16);
        acc[nb] = mfma32(a, bq, acc[nb]);
      }
    }
    float k0[16], k1[16], k2[16], k3[16];
#pragma unroll
    for (int i = 0; i < 16; ++i) {
      k0[i] = as_f((as_u(acc[0][i]) & 0xFFFFFF80u) | (unsigned)(0 * 32 + crow(i, h)));
      k1[i] = as_f((as_u(acc[1][i]) & 0xFFFFFF80u) | (unsigned)(1 * 32 + crow(i, h)));
      k2[i] = as_f((as_u(acc[2][i]) & 0xFFFFFF80u) | (unsigned)(2 * 32 + crow(i, h)));
      k3[i] = as_f((as_u(acc[3][i]) & 0xFFFFFF80u) | (unsigned)(3 * 32 + crow(i, h)));
    }
    sort16_desc(k0); sort16_desc(k1); top16_merge(k0, k1);
    sort16_desc(k2); sort16_desc(k3); top16_merge(k2, k3);
    top16_merge(k0, k2);
    top16_merge_partner(k0);
#pragma unroll
    for (int i = 0; i < 16; ++i) top[p][i] = k0[i];
  }
  float c0[16], c1[16];
  {
    constexpr int LE[8] = {16, 5, 3, 2, 1, 1, 1, 1}, LO[8] = {8, 4, 2, 2, 1, 1, 1, 1};
    int n1 = 0;
#pragma unroll
    for (int ii = 0; ii < 8; ++ii) {
      const float a = h ? top[0][2 * ii + 1] : top[0][2 * ii];
#pragma unroll
      for (int j = 0; j < LE[ii]; ++j) {
        const float sum = a + top[1][j];
        float key = as_f((as_u(sum) & 0xFFFFFF00u) | (unsigned)((2 * ii) * 16 + j) | ((unsigned)h << 4));
        if (j >= LO[ii]) key = h ? NINF : key;
        if (ii == 0) c0[j] = key; else c1[n1++] = key;
      }
    }
    c1[14] = NINF; c1[15] = NINF;
  }
  sort16_desc(c1);
  top16_merge(c0, c1);
  top16_merge_partner(c0);
  float ex[16], sum = 0.f;
#pragma unroll
  for (int k = 0; k < 16; ++k) { ex[k] = __expf(c0[k] - c0[0]); sum += ex[k]; }
  const float inv = 1.f / sum;
  unsigned* my = lidx[wave][lane];
#pragma unroll
  for (int q = 0; q < 4; ++q) {
    my[q] = (as_u(top[0][4 * q]) & 0x7Fu) | ((as_u(top[0][4 * q + 1]) & 0x7Fu) << 8) | ((as_u(top[0][4 * q + 2]) & 0x7Fu) << 16) | ((as_u(top[0][4 * q + 3]) & 0x7Fu) << 24);
    my[4 + q] = (as_u(top[1][4 * q]) & 0x7Fu) | ((as_u(top[1][4 * q + 1]) & 0x7Fu) << 8) | ((as_u(top[1][4 * q + 2]) & 0x7Fu) << 16) | ((as_u(top[1][4 * q + 3]) & 0x7Fu) << 24);
  }
#pragma unroll
  for (int k = 0; k < 16; ++k) {
    const unsigned code = as_u(c0[k]) & 0xFFu;
    const unsigned i = code >> 4, j = code & 15u;
    const unsigned e0 = (my[i >> 2] >> ((i & 3u) * 8u)) & 0x7Fu;
    const unsigned e1 = (my[4 + (j >> 2)] >> ((j & 3u) * 8u)) & 0x7Fu;
    if (h == 0) {
      IDX[(size_t)tok * 128 + head * 16 + k] = (int)(e0 * 128u + e1);
      GW[(size_t)tok * 128 + head * 16 + k] = ex[k] * inv;
    }
  }
}

typedef float f32x4v __attribute__((ext_vector_type(4)));
typedef __bf16 bf16x32 __attribute__((ext_vector_type(32)));
constexpr float U_SCALE = 64.f, V_SCALE = 4.f;
constexpr int EROW = 768;
DI float gelu_exact(float x) { return 0.5f * x * (1.f + erff(x * 0.70710678118654752f)); }

DI void peer_apply_item(int item, const bf16* __restrict__ H2, const int* __restrict__ IDX, const float* __restrict__ GW,
                        const unsigned char* __restrict__ U6, const unsigned char* __restrict__ V6,
                        float* __restrict__ x_lat, float* __restrict__ x_ctx, const float* __restrict__ modl, char* smem) {
  bf16 (*hs)[DM] = (bf16 (*)[DM])smem;
  float (*cbuf)[128] = (float (*)[128])(smem + 4 * DM * 2);
  int tid = threadIdx.x;
  asm volatile("" : "+v"(tid));
  const int lane = tid & 63, wave = tid >> 6;
  const int token = item * 4 + wave;
  const int col16 = lane & 15, kq = lane >> 4;
  const int hh = lane >> 5, c32 = lane & 31;
  __syncthreads();
  {
    const bf16* hp = H2 + (size_t)token * DM;
    *(u32x4*)(&hs[wave][8 * lane]) = *(const u32x4*)(hp + 8 * lane);
    *(u32x4*)(&hs[wave][512 + 8 * lane]) = *(const u32x4*)(hp + 512 + 8 * lane);
  }
  __syncthreads();
  const bf16* hbp = &hs[wave][64 * kq];
  const int id0 = IDX[(size_t)token * 128 + lane], id1 = IDX[(size_t)token * 128 + 64 + lane];
  const float gw0 = GW[(size_t)token * 128 + lane], gw1 = GW[(size_t)token * 128 + 64 + lane];
  {
    u32x4 wbuf[12];
    {
      const unsigned e = (unsigned)__shfl(id0, col16);
      const unsigned char* up = U6 + (e * (unsigned)EROW + 16u * (unsigned)kq);
#pragma unroll
      for (int S = 0; S < 4; ++S)
#pragma unroll
        for (int t = 0; t < 3; ++t) wbuf[3 * S + t] = *(const u32x4*)(up + 192 * S + 64 * t);
    }
    for (int g = 0; g < 8; ++g) {
      asm volatile("" ::: "memory");
      const int gn = g < 7 ? g + 1 : 7;
      const unsigned en = (unsigned)__shfl(gn < 4 ? id0 : id1, ((gn * 16) & 63) + col16);
      const unsigned char* upn = U6 + (en * (unsigned)EROW + 16u * (unsigned)kq);
      f32x4v c = {0.f, 0.f, 0.f, 0.f};
#pragma unroll
      for (int S = 0; S < 4; ++S) {
        u32x6 pk0, pk1;
        pk0[0] = wbuf[3 * S][0]; pk0[1] = wbuf[3 * S][1]; pk0[2] = wbuf[3 * S][2]; pk0[3] = wbuf[3 * S][3]; pk0[4] = wbuf[3 * S + 1][0]; pk0[5] = wbuf[3 * S + 1][1];
        pk1[0] = wbuf[3 * S + 1][2]; pk1[1] = wbuf[3 * S + 1][3]; pk1[2] = wbuf[3 * S + 2][0]; pk1[3] = wbuf[3 * S + 2][1]; pk1[4] = wbuf[3 * S + 2][2]; pk1[5] = wbuf[3 * S + 2][3];
        const bf16x32 f0 = __builtin_amdgcn_cvt_scalef32_pk32_bf16_fp6(pk0, 1.0f);
        const bf16x32 f1 = __builtin_amdgcn_cvt_scalef32_pk32_bf16_fp6(pk1, 1.0f);
        if (g < 7) {
#pragma unroll
          for (int t = 0; t < 3; ++t) wbuf[3 * S + t] = *(const u32x4*)(upn + 192 * S + 64 * t);
        }
        c = __builtin_amdgcn_mfma_f32_16x16x32_bf16(__builtin_shufflevector(f0, f0, 0, 1, 2, 3, 4, 5, 6, 7), *(const bf16x8*)(hbp + 256 * S + 0), c, 0, 0, 0);
        c = __builtin_amdgcn_mfma_f32_16x16x32_bf16(__builtin_shufflevector(f0, f0, 8, 9, 10, 11, 12, 13, 14, 15), *(const bf16x8*)(hbp + 256 * S + 8), c, 0, 0, 0);
        c = __builtin_amdgcn_mfma_f32_16x16x32_bf16(__builtin_shufflevector(f0, f0, 16, 17, 18, 19, 20, 21, 22, 23), *(const bf16x8*)(hbp + 256 * S + 16), c, 0, 0, 0);
        c = __builtin_amdgcn_mfma_f32_16x16x32_bf16(__builtin_shufflevector(f0, f0, 24, 25, 26, 27, 28, 29, 30, 31), *(const bf16x8*)(hbp + 256 * S + 24), c, 0, 0, 0);
        c = __builtin_amdgcn_mfma_f32_16x16x32_bf16(__builtin_shufflevector(f1, f1, 0, 1, 2, 3, 4, 5, 6, 7), *(const bf16x8*)(hbp + 256 * S + 32), c, 0, 0, 0);
        c = __builtin_amdgcn_mfma_f32_16x16x32_bf16(__builtin_shufflevector(f1, f1, 8, 9, 10, 11, 12, 13, 14, 15), *(const bf16x8*)(hbp + 256 * S + 40), c, 0, 0, 0);
        c = __builtin_amdgcn_mfma_f32_16x16x32_bf16(__builtin_shufflevector(f1, f1, 16, 17, 18, 19, 20, 21, 22, 23), *(const bf16x8*)(hbp + 256 * S + 48), c, 0, 0, 0);
        c = __builtin_amdgcn_mfma_f32_16x16x32_bf16(__builtin_shufflevector(f1, f1, 24, 25, 26, 27, 28, 29, 30, 31), *(const bf16x8*)(hbp + 256 * S + 56), c, 0, 0, 0);
        __builtin_amdgcn_sched_barrier(0);
      }
      if (col16 == 0) *(f32x4v*)(&cbuf[wave][g * 16 + kq * 4]) = c;
    }
  }
  u32x2 vbuf[8][3];
  const unsigned voff = 8u * (unsigned)c32;
#pragma unroll
  for (int p = 0; p < 8; ++p) {
    const unsigned es = (unsigned)__shfl(id0, 2 * p + hh);
    const unsigned char* vp = V6 + (es * (unsigned)EROW + voff);
#pragma unroll
    for (int t = 0; t < 3; ++t) vbuf[p][t] = *(const u32x2*)(vp + 256 * t);
  }
  asm volatile("" ::: "memory");
  const float w0 = gelu_exact(cbuf[wave][lane] * (1.f / U_SCALE)) * gw0;
  const float w1 = gelu_exact(cbuf[wave][64 + lane] * (1.f / U_SCALE)) * gw1;
  float y[32];
#pragma unroll
  for (int i = 0; i < 32; ++i) y[i] = 0.f;
  for (int G2 = 0; G2 < 8; ++G2) {
    const float wsel = G2 < 4 ? w0 : w1;
    const int nsel = (G2 + 1) < 4 ? id0 : id1;
#pragma unroll
    for (int p = 0; p < 8; ++p) {
      const float ws = __shfl(wsel, ((16 * G2) & 63) + 2 * p + hh);
      asm volatile("" : "+v"(vbuf[p][0]), "+v"(vbuf[p][1]), "+v"(vbuf[p][2]));
      u32x6 pk; pk[0] = vbuf[p][0][0]; pk[1] = vbuf[p][0][1]; pk[2] = vbuf[p][1][0]; pk[3] = vbuf[p][1][1]; pk[4] = vbuf[p][2][0]; pk[5] = vbuf[p][2][1];
      const f32x32v f = __builtin_amdgcn_cvt_scalef32_pk32_f32_fp6(pk, 1.0f);
      if (G2 < 7) {
        const unsigned es = (unsigned)__shfl(nsel, ((16 * (G2 + 1)) & 63) + 2 * p + hh);
        const unsigned char* vp = V6 + (es * (unsigned)EROW + voff);
#pragma unroll
        for (int t = 0; t < 3; ++t) vbuf[p][t] = *(const u32x2*)(vp + 256 * t);
      }
#pragma unroll
      for (int j = 0; j < 32; ++j) y[j] += ws * f[j];
      asm volatile("" : "+v"(y[0]), "+v"(y[1]), "+v"(y[2]), "+v"(y[3]), "+v"(y[4]), "+v"(y[5]), "+v"(y[6]), "+v"(y[7]),
                        "+v"(y[8]), "+v"(y[9]), "+v"(y[10]), "+v"(y[11]), "+v"(y[12]), "+v"(y[13]), "+v"(y[14]), "+v"(y[15]));
      asm volatile("" : "+v"(y[16]), "+v"(y[17]), "+v"(y[18]), "+v"(y[19]), "+v"(y[20]), "+v"(y[21]), "+v"(y[22]), "+v"(y[23]),
                        "+v"(y[24]), "+v"(y[25]), "+v"(y[26]), "+v"(y[27]), "+v"(y[28]), "+v"(y[29]), "+v"(y[30]), "+v"(y[31]));
      __builtin_amdgcn_sched_barrier(0);
    }
  }
  float yo[16];
#pragma unroll
  for (int j = 0; j < 16; ++j) {
    const float lo = y[j] + __shfl_xor(y[j], 32), hi = y[16 + j] + __shfl_xor(y[16 + j], 32);
    yo[j] = hh ? hi : lo;
  }
  float* xr; int b;
  if (token < NLAT) { xr = x_lat + (size_t)token * DM; b = token / SEQ; } else { xr = x_ctx + (size_t)(token - NLAT) * DM; b = 4; }
  const float* gate = modl + (size_t)b * 6144 + 5 * 1024;
#pragma unroll
  for (int q = 0; q < 4; ++q) {
    const int col = 32 * c32 + 16 * hh + 4 * q;
    float4 xv = *(float4*)(xr + col);
    const float4 gv = *(const float4*)(gate + col);
    xv.x += gv.x * yo[4 * q + 0] * (1.f / V_SCALE); xv.y += gv.y * yo[4 * q + 1] * (1.f / V_SCALE);
    xv.z += gv.z * yo[4 * q + 2] * (1.f / V_SCALE); xv.w += gv.w * yo[4 * q + 3] * (1.f / V_SCALE);
    *(float4*)(xr + col) = xv;
  }
}

DI void mla_post1_item(int item, bf16* __restrict__ P1, const float* __restrict__ qan, const float* __restrict__ kvan,
                       const float* __restrict__ krn, const float* __restrict__ cs, const float* __restrict__ sn,
                       bf16* __restrict__ KPE) {
  const int lane = threadIdx.x & 63, wave = threadIdx.x >> 6;
  const int row = item * 4 + wave;
  bf16* pr = P1 + (size_t)row * 768;
  const bool act1 = lane < 24;
  const bf16x8 va = *(const bf16x8*)(pr + 8 * lane);
  bf16x8 vb;
#pragma unroll
  for (int j = 0; j < 8; ++j) vb[j] = (bf16)0.f;
  if (act1) vb = *(const bf16x8*)(pr + 512 + 8 * lane);
  float a[8], c[8];
  float sa = 0.f, sb = 0.f;
#pragma unroll
  for (int j = 0; j < 8; ++j) { a[j] = (float)va[j]; c[j] = (float)vb[j]; sa += a[j] * a[j]; sb += c[j] * c[j]; }
  const float ss_q = wave_sum(lane < 48 ? sa : 0.f);
  const float ss_kv = wave_sum((lane >= 48 ? sa : 0.f) + (lane < 16 ? sb : 0.f));
  const float ss_kr = wave_sum((lane >= 16 && lane < 24) ? sb : 0.f);
  {
    const float rs = lane < 48 ? rsqrtf(ss_q * (1.f / 384.f) + EPS) : rsqrtf(ss_kv * (1.f / 256.f) + EPS);
    const float* g = lane < 48 ? qan + 8 * lane : kvan + 8 * (lane - 48);
    const float4 g0 = *(const float4*)g, g1 = *(const float4*)(g + 4);
    bf16x8 ov;
    ov[0] = (bf16)(a[0] * rs * g0.x); ov[1] = (bf16)(a[1] * rs * g0.y); ov[2] = (bf16)(a[2] * rs * g0.z); ov[3] = (bf16)(a[3] * rs * g0.w);
    ov[4] = (bf16)(a[4] * rs * g1.x); ov[5] = (bf16)(a[5] * rs * g1.y); ov[6] = (bf16)(a[6] * rs * g1.z); ov[7] = (bf16)(a[7] * rs * g1.w);
    *(bf16x8*)(pr + 8 * lane) = ov;
  }
  if (lane < 16) {
    const float rs = rsqrtf(ss_kv * (1.f / 256.f) + EPS);
    const float* g = kvan + 128 + 8 * lane;
    const float4 g0 = *(const float4*)g, g1 = *(const float4*)(g + 4);
    bf16x8 ov;
    ov[0] = (bf16)(c[0] * rs * g0.x); ov[1] = (bf16)(c[1] * rs * g0.y); ov[2] = (bf16)(c[2] * rs * g0.z); ov[3] = (bf16)(c[3] * rs * g0.w);
    ov[4] = (bf16)(c[4] * rs * g1.x); ov[5] = (bf16)(c[5] * rs * g1.y); ov[6] = (bf16)(c[6] * rs * g1.z); ov[7] = (bf16)(c[7] * rs * g1.w);
    *(bf16x8*)(pr + 512 + 8 * lane) = ov;
  } else if (lane < 24) {
    const int c8 = lane - 16;
    const float rs = rsqrtf(ss_kr * (1.f / 64.f) + EPS);
    const float4 g0 = *(const float4*)(krn + 8 * c8), g1 = *(const float4*)(krn + 8 * c8 + 4);
    float y[8] = {c[0] * rs * g0.x, c[1] * rs * g0.y, c[2] * rs * g0.z, c[3] * rs * g0.w, c[4] * rs * g1.x, c[5] * rs * g1.y, c[6] * rs * g1.z, c[7] * rs * g1.w};
    int orow;
    if (row < NLAT) {
      const int b = row / SEQ, t = row % SEQ;
      const float4 cs4 = *(const float4*)(cs + t * 32 + c8 * 4), sn4 = *(const float4*)(sn + t * 32 + c8 * 4);
      float o0;
      o0 = y[0] * cs4.x - y[1] * sn4.x; y[1] = y[0] * sn4.x + y[1] * cs4.x; y[0] = o0;
      o0 = y[2] * cs4.y - y[3] * sn4.y; y[3] = y[2] * sn4.y + y[3] * cs4.y; y[2] = o0;
      o0 = y[4] * cs4.z - y[5] * sn4.z; y[5] = y[4] * sn4.z + y[5] * cs4.z; y[4] = o0;
      o0 = y[6] * cs4.w - y[7] * sn4.w; y[7] = y[6] * sn4.w + y[7] * cs4.w; y[6] = o0;
      orow = b * NKEY + NCX + t;
    } else {
      const int rc = row - NLAT;
      orow = (rc / NCX) * NKEY + (rc % NCX);
    }
    bf16x8 ov;
#pragma unroll
    for (int j = 0; j < 8; ++j) ov[j] = (bf16)y[j];
    *(bf16x8*)(KPE + (size_t)orow * 64 + 8 * c8) = ov;
  }
}

DI void mla_qpost_item(int item, bf16* __restrict__ Q, const float* __restrict__ qnn, const float* __restrict__ qnr,
                       const float* __restrict__ cs, const float* __restrict__ sn) {
  const int lane = threadIdx.x & 63, wave = threadIdx.x >> 6;
  const int row = item * 4 + wave;
  const int t = row % SEQ;
  bf16* qr = Q + (size_t)row * 1536;
#pragma unroll
  for (int k = 0; k < 2; ++k) {
    const int head = (lane >> 4) + 4 * k, pos = lane & 15;
    bf16* qp = qr + head * 192 + pos * 8;
    const bf16x8 nv = *(const bf16x8*)qp;
    float v[8]; float ss = 0.f;
#pragma unroll
    for (int j = 0; j < 8; ++j) { v[j] = (float)nv[j]; ss += v[j] * v[j]; }
    ss += __shfl_xor(ss, 8); ss += __shfl_xor(ss, 4); ss += __shfl_xor(ss, 2); ss += __shfl_xor(ss, 1);
    const float rs = rsqrtf(ss * (1.f / 128.f) + EPS);
    const float4 g0 = *(const float4*)(qnn + pos * 8), g1 = *(const float4*)(qnn + pos * 8 + 4);
    bf16x8 ov;
    ov[0] = (bf16)(v[0] * rs * g0.x); ov[1] = (bf16)(v[1] * rs * g0.y); ov[2] = (bf16)(v[2] * rs * g0.z); ov[3] = (bf16)(v[3] * rs * g0.w);
    ov[4] = (bf16)(v[4] * rs * g1.x); ov[5] = (bf16)(v[5] * rs * g1.y); ov[6] = (bf16)(v[6] * rs * g1.z); ov[7] = (bf16)(v[7] * rs * g1.w);
    *(bf16x8*)qp = ov;
  }
  {
    const int head = lane >> 3, c8 = lane & 7;
    bf16* qp = qr + head * 192 + 128 + c8 * 8;
    const bf16x8 pv = *(const bf16x8*)qp;
    float y[8]; float ss = 0.f;
#pragma unroll
    for (int j = 0; j < 8; ++j) { y[j] = (float)pv[j]; ss += y[j] * y[j]; }
    ss += __shfl_xor(ss, 4); ss += __shfl_xor(ss, 2); ss += __shfl_xor(ss, 1);
    const float rs = rsqrtf(ss * (1.f / 64.f) + EPS);
    const float4 g0 = *(const float4*)(qnr + c8 * 8), g1 = *(const float4*)(qnr + c8 * 8 + 4);
    y[0] *= rs * g0.x; y[1] *= rs * g0.y; y[2] *= rs * g0.z; y[3] *= rs * g0.w; y[4] *= rs * g1.x; y[5] *= rs * g1.y; y[6] *= rs * g1.z; y[7] *= rs * g1.w;
    const float4 cs4 = *(const float4*)(cs + t * 32 + c8 * 4), sn4 = *(const float4*)(sn + t * 32 + c8 * 4);
    float o0;
    o0 = y[0] * cs4.x - y[1] * sn4.x; y[1] = y[0] * sn4.x + y[1] * cs4.x; y[0] = o0;
    o0 = y[2] * cs4.y - y[3] * sn4.y; y[3] = y[2] * sn4.y + y[3] * cs4.y; y[2] = o0;
    o0 = y[4] * cs4.z - y[5] * sn4.z; y[5] = y[4] * sn4.z + y[5] * cs4.z; y[4] = o0;
    o0 = y[6] * cs4.w - y[7] * sn4.w; y[7] = y[6] * sn4.w + y[7] * cs4.w; y[6] = o0;
    bf16x8 ov;
#pragma unroll
    for (int j = 0; j < 8; ++j) ov[j] = (bf16)y[j];
    *(bf16x8*)qp = ov;
  }
}

DI void mla_kpost_item(int item, bf16* __restrict__ KV, const float* __restrict__ knn) {
  const int lane = threadIdx.x & 63, wave = threadIdx.x >> 6;
  const int row = item * 4 + wave;
#pragma unroll
  for (int k = 0; k < 2; ++k) {
    const int head = (lane >> 4) + 4 * k, pos = lane & 15;
    bf16* kp = KV + (size_t)row * 2048 + head * 256 + pos * 8;
    const bf16x8 nv = *(const bf16x8*)kp;
    float v[8]; float ss = 0.f;
#pragma unroll
    for (int j = 0; j < 8; ++j) { v[j] = (float)nv[j]; ss += v[j] * v[j]; }
    ss += __shfl_xor(ss, 8); ss += __shfl_xor(ss, 4); ss += __shfl_xor(ss, 2); ss += __shfl_xor(ss, 1);
    const float rs = rsqrtf(ss * (1.f / 128.f) + EPS);
    const float4 g0 = *(const float4*)(knn + pos * 8), g1 = *(const float4*)(knn + pos * 8 + 4);
    bf16x8 ov;
    ov[0] = (bf16)(v[0] * rs * g0.x); ov[1] = (bf16)(v[1] * rs * g0.y); ov[2] = (bf16)(v[2] * rs * g0.z); ov[3] = (bf16)(v[3] * rs * g0.w);
    ov[4] = (bf16)(v[4] * rs * g1.x); ov[5] = (bf16)(v[5] * rs * g1.y); ov[6] = (bf16)(v[6] * rs * g1.z); ov[7] = (bf16)(v[7] * rs * g1.w);
    *(bf16x8*)kp = ov;
  }
}

struct MegaParams {
  const float *x, *c, *ctx, *c_ctx, *mod_w, *mod_b, *mix_norm, *ffn_norm, *even_w_in, *even_w_out, *a_q_norm, *a_k_norm, *b_q_norm,
      *b_k_norm, *b_sink, *mla_w_in, *mla_q_a_norm, *mla_kv_a_norm, *mla_w_uq, *mla_w_ukv, *mla_q_nope_norm, *mla_q_rope_norm,
      *mla_k_nope_norm, *mla_k_rope_norm, *mla_w_out, *peer_w_query, *peer_sub_keys, *peer_u, *peer_v;
  float* out;
  unsigned* bar;
  float *MOD, *RCS, *RSN, *CTXS;
  bf16 *W_EIN, *W_EOUT, *W_PQ, *W_MIN, *W_UQ, *W_UKV, *W_MOUT, *SKB, *HA, *HB;
  unsigned char *U6, *V6;
  int* IDX;
  float* GW;
  char* R;
};

DI unsigned long long uptr64(const LAS unsigned long long* slot) {
  const unsigned long long v = *slot;
  const unsigned lo = __builtin_amdgcn_readfirstlane((unsigned)v), hi = __builtin_amdgcn_readfirstlane((unsigned)(v >> 32));
  return ((unsigned long long)hi << 32) | lo;
}
template <class T> DI T* as_global(T*, unsigned long long v) { return (T*)(__attribute__((address_space(1))) T*)v; }
#define LP(f) as_global((decltype(sp.f))nullptr, uptr64((const LAS unsigned long long*)&sp.f))

#define rP0 ((bf16*)Rb)
#define rQA ((bf16*)(Rb + (size_t)NTOK * 1536 * 2))
#define rQB (rQA + (size_t)NB * 8 * SEQ * 64)
#define rCQA (rQB + (size_t)NB * 8 * SEQ * 64)
#define rCQB (rCQA + (size_t)NB * 8 * NCX * 64)
#define rKA (rCQB + (size_t)NB * 8 * NCX * 64)
#define rVA (rKA + (size_t)NB * 2 * NKEY * 64)
#define rKB (rVA + (size_t)NB * 2 * NKEY * 64)
#define rVB (rKB + (size_t)NB * 2 * NKEY * 64)
#define rQP ((bf16*)Rb)
#define rKPE ((bf16*)Rb)
#define rQRAW (rKPE + (size_t)NB * NKEY * 64)
#define rKVRAW (rQRAW + (size_t)NLAT * 1536)

__global__ __launch_bounds__(256, 2) void mega_kernel(MegaParams kp) {
  __shared__ __attribute__((aligned(16))) char lds_all[SMEM_BYTES + 16 + ((sizeof(MegaParams) + 15) / 16) * 16];
  char* const smem = lds_all;
  uint4& xb_words = *(uint4*)(lds_all + SMEM_BYTES);
  MegaParams& sp = *(MegaParams*)(lds_all + SMEM_BYTES + 16);
  if (threadIdx.x == 0) { xb_words = make_uint4(0u, 0u, 0u, 0u); sp = kp; }
  __syncthreads();
  XcdBarrier bar = xcd_barrier_post(LP(bar), (volatile LAS unsigned*)&xb_words);
  const int G = gridDim.x, bid = blockIdx.x;

  {
    const float *c = LP(c), *c_ctx = LP(c_ctx), *mod_w = LP(mod_w), *mod_b = LP(mod_b); float* MOD = LP(MOD);
    for (int item = bid; item < 192; item += G) mod_item(item, c, c_ctx, mod_w, mod_b, MOD, smem);
  }
  rope_phase(LP(RCS), LP(RSN));
  transpose_phase(LP(even_w_in), LP(W_EIN), 1024, 1536, 1536, smem);
  transpose_phase(LP(even_w_out), LP(W_EOUT), 1024, 1024, 1024, smem);
  transpose_phase(LP(peer_w_query), LP(W_PQ), 1024, 2048, 2048, smem);
  transpose_phase(LP(peer_w_query) + (size_t)1024 * 2048, LP(W_PQ) + (size_t)2048 * 1024, 1024, 2048, 2048, smem);
  transpose_phase(LP(mla_w_in), LP(W_MIN), 1024, 704, 768, smem);
  transpose_phase(LP(mla_w_uq), LP(W_UQ), 384, 1536, 1536, smem);
  transpose_phase(LP(mla_w_ukv), LP(W_UKV), 256, 2048, 2048, smem);
  transpose_phase(LP(mla_w_out), LP(W_MOUT), 1024, 1024, 1024, smem);
  convert_phase((const float4*)LP(peer_sub_keys), (bf16x4*)LP(SKB), (size_t)2 * 16 * 128 * 128 / 4);
  convert_fp6_phase<false>(LP(peer_u), LP(U6), (size_t)2 * 16384 * 32, U_SCALE);
  convert_fp6_phase<true>(LP(peer_v), LP(V6), (size_t)2 * 16384 * 32, V_SCALE);
  xcd_barrier(bar);

  {
    const float *x = LP(x), *ctx = LP(ctx), *g = LP(mix_norm), *M = LP(MOD); bf16* H = LP(HA);
    for (int it = bid; it < NTOK / 4; it += G) norm_mod_item(it, x, ctx, g, M, 0, H);
  }
  xcd_barrier(bar);
  {
    char* const Rb = LP(R);
    GemmEpi e{}; e.Cb = rP0; e.ldc = 1536;
    gemm_phase<EPI_BF16>(LP(HA), 1024, LP(W_EIN), 1024, e, NTOK, 1536, smem);
  }
  xcd_barrier(bar);
  {
    char* const Rb = LP(R);
    Post0 q{}; q.P = rP0; q.aqn = LP(a_q_norm); q.akn = LP(a_k_norm); q.bqn = LP(b_q_norm); q.bkn = LP(b_k_norm); q.cs = LP(RCS); q.sn = LP(RSN);
    q.QA = rQA; q.QB = rQB; q.CQA = rCQA; q.CQB = rCQB; q.KA = rKA; q.VA = rVA; q.KB = rKB; q.VB = rVB;
    for (int it = bid; it < NTOK / 4; it += G) qkv_post0_item(it, q);
  }
  xcd_barrier(bar);
  {
    char* const Rb = LP(R);
    bf16* const HBp = LP(HB);
    const float* const sinkp = LP(b_sink);
    const int xcd = bid & 7, nj = G >> 3;
    const int b = xcd >> 1, hkv = xcd & 1;
    for (int t = bid >> 3; t < 528; t += nj) {
      AttnParams a{};
      const bool isC = t >= 512;
      const bool isB = isC ? (t >= 520) : (t >= 256);
      a.q_ts = 64; a.k_ts = 64; a.v_ts = 64; a.G = 4; a.scale_log2 = 0.125f * LOG2E;
      a.K = isB ? rKB : rKA; a.V = isB ? rVB : rVA;
      a.k_bs = (long)2 * NKEY * 64; a.k_hs = (long)NKEY * 64; a.v_bs = a.k_bs; a.v_hs = a.k_hs;
      a.O = HBp; a.o_col0 = isB ? 512 : 0; a.sink = isB ? sinkp : nullptr;
      int qblk, head;
      if (!isC) {
        const int li = t & 255;
        qblk = li & 63; head = hkv * 4 + (li >> 6);
        a.Q = isB ? rQB : rQA; a.q_bs = (long)8 * SEQ * 64; a.q_hs = (long)SEQ * 64;
        a.o_row0 = 0; a.o_bs = SEQ; a.nkeys = NKEY;
      } else {
        const int li = (t - 512) & 7;
        qblk = li & 1; head = hkv * 4 + (li >> 1);
        a.Q = isB ? rCQB : rCQA; a.q_bs = (long)8 * NCX * 64; a.q_hs = (long)NCX * 64;
        a.o_row0 = NLAT; a.o_bs = NCX; a.nkeys = NCX;
      }
      if (isB && !isC) attn_item<64, 64, 64, 2, true>(a, qblk, head, b, smem);
      else attn_item<64, 64, 64, 2, false>(a, qblk, head, b, smem);
    }
  }
  xcd_barrier(bar);
  {
    GemmEpi e{}; e.out_lat = LP(out); e.res_lat = LP(x); e.out_ctx = LP(CTXS); e.res_ctx = LP(ctx); e.modl = LP(MOD); e.gchunk = 2;
    gemm_phase<EPI_RESID>(LP(HB), 1024, LP(W_EOUT), 1024, e, NTOK, 1024, smem);
  }
  xcd_barrier(bar);
  {
    const float *x = LP(out), *ctx = LP(CTXS), *g = LP(ffn_norm), *M = LP(MOD); bf16* H = LP(HA);
    for (int it = bid; it < NTOK / 4; it += G) norm_mod_item(it, x, ctx, g, M, 3, H);
  }
  xcd_barrier(bar);
  {
    char* const Rb = LP(R);
    GemmEpi e{}; e.Cb = rQP; e.ldc = 2048;
    gemm_phase<EPI_BF16>(LP(HA), 1024, LP(W_PQ), 1024, e, NTOK, 2048, smem);
  }
  xcd_barrier(bar);
  {
    char* const Rb = LP(R);
    const bf16* QPp = rQP; const bf16* SK = LP(SKB); int* IDX = LP(IDX); float* GW = LP(GW);
    for (int item = bid; item < (NTOK / 32) * 2; item += G) peer_select_item(item >> 1, item & 1, QPp, SK, IDX, GW, smem);
  }
  xcd_barrier(bar);
  {
    const bf16* H = LP(HA); const int* IDX = LP(IDX); const float* GW = LP(GW); const unsigned char *U8 = LP(U6), *V8 = LP(V6);
    float *xo = LP(out), *xc = LP(CTXS); const float* M = LP(MOD);
    for (int item = bid; item < NTOK / 4; item += G) peer_apply_item(item, H, IDX, GW, U8, V8, xo, xc, M, smem);
  }
  xcd_barrier(bar);

  {
    const float *x = LP(out), *ctx = LP(CTXS), *g = LP(mix_norm) + 1024, *M = LP(MOD) + 5 * 6144; bf16* H = LP(HA);
    for (int it = bid; it < NTOK / 4; it += G) norm_mod_item(it, x, ctx, g, M, 0, H);
  }
  xcd_barrier(bar);
  {
    GemmEpi e{}; e.Cb = LP(HB); e.ldc = 768;
    gemm_phase<EPI_BF16>(LP(HA), 1024, LP(W_MIN), 1024, e, NTOK, 768, smem);
  }
  xcd_barrier(bar);
  {
    char* const Rb = LP(R);
    bf16* P1 = LP(HB); const float *qa = LP(mla_q_a_norm), *kva = LP(mla_kv_a_norm), *krn = LP(mla_k_rope_norm), *cs = LP(RCS), *sn = LP(RSN);
    bf16* KPEp = rKPE;
    for (int it = bid; it < NTOK / 4; it += G) mla_post1_item(it, P1, qa, kva, krn, cs, sn, KPEp);
  }
  xcd_barrier(bar);
  {
    char* const Rb = LP(R);
    GemmEpi e{}; e.Cb = rQRAW; e.ldc = 1536;
    gemm_phase<EPI_BF16>(LP(HB), 768, LP(W_UQ), 384, e, NLAT, 1536, smem);
    GemmEpi e2{}; e2.Cb = rKVRAW; e2.ldc = 2048; e2.rowmap = 1;
    gemm_phase<EPI_BF16>(LP(HB) + 384, 768, LP(W_UKV), 256, e2, NTOK, 2048, smem);
  }
  xcd_barrier(bar);
  {
    char* const Rb = LP(R);
    bf16* Qr = rQRAW; bf16* KVr = rKVRAW;
    const float *qnn = LP(mla_q_nope_norm), *qnr = LP(mla_q_rope_norm), *knn = LP(mla_k_nope_norm), *cs = LP(RCS), *sn = LP(RSN);
    for (int it = bid; it < NLAT / 4; it += G) mla_qpost_item(it, Qr, qnn, qnr, cs, sn);
    for (int it = bid; it < NB * NKEY / 4; it += G) mla_kpost_item(it, KVr, knn);
  }
  xcd_barrier(bar);
  {
    char* const Rb = LP(R);
    AttnParams a{}; a.Q = rQRAW; a.q_bs = (long)SEQ * 1536; a.q_hs = 192; a.q_ts = 1536;
    a.K = rKVRAW; a.k_bs = (long)NKEY * 2048; a.k_hs = 256; a.k_ts = 2048;
    a.K2 = rKPE; a.k2_bs = (long)NKEY * 64; a.k2_ts = 64;
    a.V = rKVRAW + 128; a.v_bs = (long)NKEY * 2048; a.v_hs = 256; a.v_ts = 2048;
    a.O = LP(HA); a.o_row0 = 0; a.o_bs = SEQ; a.o_col0 = 0; a.sink = nullptr; a.nkeys = NKEY; a.G = 1; a.window = 0;
    a.scale_log2 = 0.07216878364870322f * LOG2E;
    const int xcd = bid & 7, nj = G >> 3;
    for (int t = bid >> 3; t < 256; t += nj) {
      const int bh = (t >> 6) * 8 + xcd;
      attn_item<192, 128, 128, 1, false>(a, t & 63, bh & 7, bh >> 3, smem);
    }
  }
  xcd_barrier(bar);
  {
    GemmEpi e{}; e.out_lat = LP(out); e.res_lat = LP(out); e.out_ctx = LP(CTXS); e.res_ctx = LP(CTXS); e.modl = LP(MOD) + 5 * 6144; e.gchunk = 2;
    gemm_phase<EPI_RESID>(LP(HA), 1024, LP(W_MOUT), 1024, e, NLAT, 1024, smem);
  }
  xcd_barrier(bar);
  {
    const float *x = LP(out), *ctx = LP(CTXS), *g = LP(ffn_norm) + 1024, *M = LP(MOD) + 5 * 6144; bf16* H = LP(HB);
    for (int it = bid; it < NLAT / 4; it += G) norm_mod_item(it, x, ctx, g, M, 3, H);
  }
  xcd_barrier(bar);
  {
    char* const Rb = LP(R);
    GemmEpi e{}; e.Cb = rQP; e.ldc = 2048;
    gemm_phase<EPI_BF16>(LP(HB), 1024, LP(W_PQ) + (size_t)2048 * 1024, 1024, e, NLAT, 2048, smem);
  }
  xcd_barrier(bar);
  {
    char* const Rb = LP(R);
    const bf16* QPp = rQP; const bf16* SK = LP(SKB) + (size_t)16 * 128 * 128; int* IDX = LP(IDX); float* GW = LP(GW);
    for (int item = bid; item < (NLAT / 32) * 2; item += G) peer_select_item(item >> 1, item & 1, QPp, SK, IDX, GW, smem);
  }
  xcd_barrier(bar);
  {
    const bf16* H = LP(HB); const int* IDX = LP(IDX); const float* GW = LP(GW);
    const unsigned char *U8 = LP(U6) + (size_t)16384 * EROW, *V8 = LP(V6) + (size_t)16384 * EROW;
    float *xo = LP(out), *xc = LP(CTXS); const float* M = LP(MOD) + 5 * 6144;
    for (int item = bid; item < NLAT / 4; item += G) peer_apply_item(item, H, IDX, GW, U8, V8, xo, xc, M, smem);
  }
}

static inline size_t align_up(size_t v, size_t a) { return (v + a - 1) / a * a; }

extern "C" void kernel_launch(void* const* d_in, const int* in_sizes, int n_in,
                              void* d_out, int out_size, void* d_ws, size_t ws_size,
                              hipStream_t stream) {
  MegaParams p{};
  const float** fp = (const float**)&p;
  for (int i = 0; i < 29; ++i) fp[i] = (const float*)d_in[i];
  p.out = (float*)d_out;
  char* w = (char*)d_ws;
  size_t off = 0;
  auto take = [&](size_t bytes) { char* q = w + off; off = align_up(off + bytes, 256); return q; };
  p.bar = (unsigned*)take(XCD_BAR_WORDS * 4);
  p.MOD = (float*)take(2 * 5 * 6144 * 4);
  p.RCS = (float*)take((size_t)SEQ * 32 * 4);
  p.RSN = (float*)take((size_t)SEQ * 32 * 4);
  p.CTXS = (float*)take((size_t)NCTXT * DM * 4);
  p.W_EIN = (bf16*)take((size_t)1536 * 1024 * 2);
  p.W_EOUT = (bf16*)take((size_t)1024 * 1024 * 2);
  p.W_PQ = (bf16*)take((size_t)2 * 2048 * 1024 * 2);
  p.W_MIN = (bf16*)take((size_t)768 * 1024 * 2);
  p.W_UQ = (bf16*)take((size_t)1536 * 384 * 2);
  p.W_UKV = (bf16*)take((size_t)2048 * 256 * 2);
  p.W_MOUT = (bf16*)take((size_t)1024 * 1024 * 2);
  p.SKB = (bf16*)take((size_t)2 * 16 * 128 * 128 * 2);
  p.HA = (bf16*)take((size_t)NTOK * DM * 2);
  p.HB = (bf16*)take((size_t)NTOK * DM * 2);
  p.U6 = (unsigned char*)take((size_t)2 * 16384 * EROW);
  p.V6 = (unsigned char*)take((size_t)2 * 16384 * EROW);
  p.IDX = (int*)take((size_t)NTOK * 128 * 4);
  p.GW = (float*)take((size_t)NTOK * 128 * 4);
  p.R = take((size_t)250 * 1024 * 1024);

  static int grid = 0;
  if (!grid) {
    int dev = 0, cus = 0, per_cu = 0;
    hipGetDevice(&dev);
    hipDeviceGetAttribute(&cus, hipDeviceAttributeMultiprocessorCount, dev);
    hipOccupancyMaxActiveBlocksPerMultiprocessor(&per_cu, mega_kernel, 256, 0);
    if (per_cu > 2) per_cu = 2;
    if (per_cu < 1) per_cu = 1;
    grid = cus * per_cu;
  }
  hipMemsetAsync(p.bar, 0, XCD_BAR_WORDS * 4, stream);
  mega_kernel<<<grid, 256, 0, stream>>>(p);
}
```

```cpp
#include <hip/hip_runtime.h>
#include <stdint.h>

typedef __bf16 bf16;
typedef __bf16 bf16x8 __attribute__((ext_vector_type(8)));
typedef __bf16 bf16x4 __attribute__((ext_vector_type(4)));
typedef __bf16 bf16x2 __attribute__((ext_vector_type(2)));
typedef float f32x16 __attribute__((ext_vector_type(16)));
typedef unsigned u32x4 __attribute__((ext_vector_type(4)));
typedef unsigned u32x2g __attribute__((ext_vector_type(2)));
typedef int i32x8 __attribute__((ext_vector_type(8)));
#define LAS __attribute__((address_space(3)))
#define DI __device__ __forceinline__

constexpr int DM = 1024, NB = 4, SEQ = 8192, NCX = 256;
constexpr int NLAT = NB * SEQ, NCTXT = NB * NCX, NTOK = NLAT + NCTXT, NKEY = SEQ + NCX;
constexpr float EPS = 1e-6f;
constexpr float LOG2E = 1.4426950408889634f;

DI int crow(int i, int h) { return (i & 3) + 8 * (i >> 2) + 4 * h; }
DI f32x16 mfma32(bf16x8 a, bf16x8 b, f32x16 c) { return __builtin_amdgcn_mfma_f32_32x32x16_bf16(a, b, c, 0, 0, 0); }
DI float silu(float v) { return v / (1.f + __expf(-v)); }
DI u32x2g pack8_fp8(const float (&v)[8]) {
  int w0 = 0, w1 = 0;
  w0 = __builtin_amdgcn_cvt_pk_fp8_f32(v[0], v[1], w0, false); w0 = __builtin_amdgcn_cvt_pk_fp8_f32(v[2], v[3], w0, true);
  w1 = __builtin_amdgcn_cvt_pk_fp8_f32(v[4], v[5], w1, false); w1 = __builtin_amdgcn_cvt_pk_fp8_f32(v[6], v[7], w1, true);
  u32x2g r; r[0] = (unsigned)w0; r[1] = (unsigned)w1; return r;
}


#define XB_TMO      128
#define XB_XCNT(j)  (256  + 64 * (j))
#define XB_XSUB(j)  (1280 + 64 * (j))
#define XB_XGEN(j)  (2304 + 64 * (j))
#define XB_TOP      3328
#define XB_TOPGEN   3392
#define XCD_BAR_WORDS 3456
#define XB_SPIN_CAP (1u << 18)

__device__ __forceinline__ unsigned xb_ld(unsigned* p)              { return __hip_atomic_load(p, __ATOMIC_RELAXED, __HIP_MEMORY_SCOPE_AGENT); }
__device__ __forceinline__ unsigned xb_add(unsigned* p, unsigned v) { return __hip_atomic_fetch_add(p, v, __ATOMIC_RELAXED, __HIP_MEMORY_SCOPE_AGENT); }
__device__ __forceinline__ unsigned xb_xcc_id() { return (unsigned)__builtin_amdgcn_s_getreg((3 << 11) | 20) & 0xFu; }
#define XB_SPIN(cond, bar) do { unsigned _sp = 0; while (cond) { __builtin_amdgcn_s_sleep(1); \
    if ((++_sp & 255u) == 0u) { if (xb_ld(&(bar)[XB_TMO])) break; if (_sp > XB_SPIN_CAP) { atomicAdd(&(bar)[XB_TMO], 1u); break; } } } } while (0)

struct XcdBarrier { unsigned* bar; unsigned x; volatile LAS unsigned* st; };

__device__ __forceinline__ XcdBarrier xcd_barrier_post(unsigned* bar, volatile LAS unsigned* st) {
    XcdBarrier b; b.bar = bar; b.x = xb_xcc_id(); b.st = st;
    if (threadIdx.x == 0) (void)xb_add(&bar[XB_XCNT(b.x)], 1u);
    return b;
}
__device__ __forceinline__ void xcd_barrier_complete(unsigned* bar, unsigned x, unsigned& nloc, unsigned& nx) {
    const unsigned G = gridDim.x * gridDim.y * gridDim.z;
    unsigned sum, cnt, mine, sp = 0u;
    for (;;) {
        sum = 0u; cnt = 0u; mine = 0u;
#pragma unroll
        for (unsigned j = 0; j < 16; ++j) { const unsigned c = xb_ld(&bar[XB_XCNT(j)]); sum += c; cnt += (c > 0u) ? 1u : 0u; mine = (j == x) ? c : mine; }
        if (sum == G) break;
        __builtin_amdgcn_s_sleep(1);
        if ((++sp & 255u) == 0u) { if (xb_ld(&bar[XB_TMO])) break; if (sp > XB_SPIN_CAP) { atomicAdd(&bar[XB_TMO], 1u); break; } }
    }
    nloc = mine > 0u ? mine : 1u; nx = cnt > 0u ? cnt : 1u;
}
__device__ __forceinline__ void xcd_barrier(const XcdBarrier& b) {
    asm volatile("s_waitcnt vmcnt(0)" ::: "memory");
    __syncthreads();
    if (threadIdx.x == 0) {
        unsigned* bar = b.bar;
        __builtin_amdgcn_s_waitcnt(0);
        unsigned nloc = b.st[0], nx = b.st[1];
        if (nloc == 0u) { xcd_barrier_complete(bar, b.x, nloc, nx); b.st[0] = nloc; b.st[1] = nx; }
        const unsigned old = xb_add(&bar[XB_XSUB(b.x)], 1u);
        const unsigned gen = old / nloc;
        if (old + 1u == (gen + 1u) * nloc) {
            __builtin_amdgcn_fence(__ATOMIC_RELEASE, "agent");
            asm volatile("s_waitcnt vmcnt(0)" ::: "memory");
            const unsigned og = xb_add(&bar[XB_TOP], 1u);
            const unsigned tg = og / nx;
            if (og + 1u == (tg + 1u) * nx) xb_add(&bar[XB_TOPGEN], 1u);
            else XB_SPIN(xb_ld(&bar[XB_TOPGEN]) == tg, bar);
            __builtin_amdgcn_fence(__ATOMIC_ACQUIRE, "agent");
            xb_add(&bar[XB_XGEN(b.x)], 1u);
            asm volatile("s_waitcnt vmcnt(0)" ::: "memory");
        } else {
            XB_SPIN(xb_ld(&bar[XB_XGEN(b.x)]) == gen, bar);
            __builtin_amdgcn_fence(__ATOMIC_ACQUIRE, "agent");
            asm volatile("s_waitcnt vmcnt(0)" ::: "memory");
        }
    }
    __syncthreads();
}

constexpr int SMEM_BYTES = 73728;

DI void mod_item(int item, const float* __restrict__ c, const float* __restrict__ c_ctx, const float* __restrict__ mod_w,
                 const float* __restrict__ mod_b, float* __restrict__ mod, char* smem) {
  float (*sv)[1024] = (float (*)[1024])smem;
  float (*part)[5][64] = (float (*)[5][64])(smem + 5 * 1024 * 4);
  const int tid = threadIdx.x, l = item / 96, bx = item % 96;
  for (int i = tid; i < 5 * 1024; i += 256) {
    const int b = i >> 10, k = i & 1023;
    const float v = b < 4 ? c[b * 1024 + k] : c_ctx[k];
    sv[b][k] = silu(v);
  }
  __syncthreads();
  const int nn = tid & 63, kg = tid >> 6;
  const int n = bx * 64 + nn;
  const float* w = mod_w + (size_t)l * 1024 * 6144 + n;
  float a0 = 0, a1 = 0, a2 = 0, a3 = 0, a4 = 0;
  for (int k = kg * 256; k < kg * 256 + 256; ++k) {
    const float wv = w[(size_t)k * 6144];
    a0 += sv[0][k] * wv; a1 += sv[1][k] * wv; a2 += sv[2][k] * wv; a3 += sv[3][k] * wv; a4 += sv[4][k] * wv;
  }
  part[kg][0][nn] = a0; part[kg][1][nn] = a1; part[kg][2][nn] = a2; part[kg][3][nn] = a3; part[kg][4][nn] = a4;
  __syncthreads();
  for (int i = tid; i < 5 * 64; i += 256) {
    const int b = i >> 6, j = i & 63;
    const float s = part[0][b][j] + part[1][b][j] + part[2][b][j] + part[3][b][j];
    mod[((size_t)l * 5 + b) * 6144 + bx * 64 + j] = s + mod_b[(size_t)l * 6144 + bx * 64 + j];
  }
  __syncthreads();
}

DI void rope_phase(float* __restrict__ cs, float* __restrict__ sn) {
  for (int idx = blockIdx.x * 256 + threadIdx.x; idx < SEQ * 32; idx += gridDim.x * 256) {
    const int t = idx >> 5, i = idx & 31;
    const int row = t >> 6, col = t & 63;
    const int fi = i & 15;
    const float inv = powf(10000.f, -(float)(2 * fi) / 32.f);
    const float ang = (i < 16 ? (float)row : (float)col) * inv;
    cs[idx] = cosf(ang);
    sn[idx] = sinf(ang);
  }
}

constexpr float W8_SCALE = 32.f;
constexpr float O8_SCALE = 32.f;
template <bool QPERM, bool F8>
DI void transpose_item(int item, const float* __restrict__ W, bf16* __restrict__ Wt, int K, int N, int Npad, char* smem) {
  float (*tile)[33] = (float (*)[33])smem;
  const int tx = threadIdx.x & 31, ty = threadIdx.x >> 5;
  const int ntn = Npad / 32;
  const int n0 = (item % ntn) * 32, k0 = (item / ntn) * 32;
  for (int j = ty; j < 32; j += 8) {
    const int k = k0 + j, np = n0 + tx;
    const int n = QPERM ? (np < 1024 ? (np >> 7) * 192 + (np & 127) : ((np - 1024) >> 6) * 192 + 128 + ((np - 1024) & 63)) : np;
    tile[j][tx] = (np < N) ? W[(size_t)k * N + n] : 0.f;
  }
  __syncthreads();
  for (int j = ty; j < 32; j += 8) {
    const int n = n0 + j, k = k0 + tx;
    if (F8) ((unsigned char*)Wt)[(size_t)n * K + k] = (unsigned char)(__builtin_amdgcn_cvt_pk_fp8_f32(tile[tx][j] * W8_SCALE, 0.f, 0, false) & 0xFF);
    else Wt[(size_t)n * K + k] = (bf16)tile[tx][j];
  }
  __syncthreads();
}
template <bool QPERM = false, bool F8 = false>
DI void transpose_phase(const float* __restrict__ W, bf16* __restrict__ Wt, int K, int N, int Npad, char* smem) {
  const int nitems = (Npad / 32) * (K / 32);
  for (int item = blockIdx.x; item < nitems; item += gridDim.x) transpose_item<QPERM, F8>(item, W, Wt, K, N, Npad, smem);
}

DI void convert_phase(const float4* __restrict__ src, bf16x4* __restrict__ dst, size_t n4) {
  for (size_t i = blockIdx.x * (size_t)256 + threadIdx.x; i < n4; i += (size_t)gridDim.x * 256) {
    const float4 v = src[i];
    bf16x4 o; o[0] = (bf16)v.x; o[1] = (bf16)v.y; o[2] = (bf16)v.z; o[3] = (bf16)v.w;
    dst[i] = o;
  }
}


DI void convert_fp8_phase(const float4* __restrict__ src, unsigned* __restrict__ dst, size_t n4, float scale) {
  for (size_t i = blockIdx.x * (size_t)256 + threadIdx.x; i < n4; i += (size_t)gridDim.x * 256) {
    const float4 v = src[i];
    int w = 0;
    w = __builtin_amdgcn_cvt_pk_fp8_f32(v.x * scale, v.y * scale, w, false);
    w = __builtin_amdgcn_cvt_pk_fp8_f32(v.z * scale, v.w * scale, w, true);
    dst[i] = (unsigned)w;
  }
}

typedef float f32x16v __attribute__((ext_vector_type(16)));
typedef float f32x32v __attribute__((ext_vector_type(32)));
typedef unsigned u32x6 __attribute__((ext_vector_type(6)));
typedef unsigned u32x2 __attribute__((ext_vector_type(2)));
template <bool VLAYOUT>
DI void convert_fp6_phase(const float* __restrict__ src, unsigned char* __restrict__ dst, size_t nblk, float scale) {
  for (size_t i = blockIdx.x * (size_t)256 + threadIdx.x; i < nblk; i += (size_t)gridDim.x * 256) {
    const float4* sp4 = (const float4*)(src + i * 32);
    f32x16v a, b;
#pragma unroll
    for (int q = 0; q < 8; ++q) {
      const float4 v = sp4[q];
      a[2 * q] = v.x * scale; b[2 * q] = v.y * scale; a[2 * q + 1] = v.z * scale; b[2 * q + 1] = v.w * scale;
    }
    const u32x6 p = __builtin_amdgcn_cvt_scalef32_2xpk16_fp6_f32(a, b, 1.0f);
    u32x2 t0, t1, t2; t0[0] = p[0]; t0[1] = p[1]; t1[0] = p[2]; t1[1] = p[3]; t2[0] = p[4]; t2[1] = p[5];
    unsigned char* row = dst + (i >> 5) * 768;
    const int q = (int)(i & 31);
    if (VLAYOUT) {
      *(u32x2*)(row + 8 * q) = t0; *(u32x2*)(row + 256 + 8 * q) = t1; *(u32x2*)(row + 512 + 8 * q) = t2;
    } else {
      const int Q = q >> 1, S = Q >> 2, kq = Q & 3;
      unsigned char* ch = row + 192 * S + 16 * kq;
      if ((q & 1) == 0) { *(u32x2*)(ch) = t0; *(u32x2*)(ch + 8) = t1; *(u32x2*)(ch + 64) = t2; }
      else              { *(u32x2*)(ch + 64 + 8) = t0; *(u32x2*)(ch + 128) = t1; *(u32x2*)(ch + 128 + 8) = t2; }
    }
  }
}

DI float wave_sum(float v) {
#pragma unroll
  for (int o = 32; o > 0; o >>= 1) v += __shfl_xor(v, o);
  return v;
}
template <bool F8 = false>
DI void norm_mod_item(int item, const float* __restrict__ src_lat, const float* __restrict__ src_ctx, const float* __restrict__ gain,
                      const float* __restrict__ modl, int chunk, bf16* __restrict__ H) {
  const int lane = threadIdx.x & 63, wave = threadIdx.x >> 6;
  const int row = item * 4 + wave;
  const float* src; int b;
  if (row < NLAT) { src = src_lat + (size_t)row * DM; b = row / SEQ; } else { src = src_ctx + (size_t)(row - NLAT) * DM; b = 4; }
  float4 v[4];
#pragma unroll
  for (int k = 0; k < 4; ++k) v[k] = ((const float4*)src)[lane + 64 * k];
  float ss = 0.f;
#pragma unroll
  for (int k = 0; k < 4; ++k) ss += v[k].x * v[k].x + v[k].y * v[k].y + v[k].z * v[k].z + v[k].w * v[k].w;
  ss = wave_sum(ss);
  const float rs = rsqrtf(ss * (1.f / DM) + EPS);
  const float4* gp = (const float4*)gain;
  const float4* shp = (const float4*)(modl + (size_t)b * 6144 + chunk * 1024);
  const float4* scp = (const float4*)(modl + (size_t)b * 6144 + (chunk + 1) * 1024);
#pragma unroll
  for (int k = 0; k < 4; ++k) {
    const float4 g = gp[lane + 64 * k], sh = shp[lane + 64 * k], sc = scp[lane + 64 * k];
    const float y0 = v[k].x * rs * g.x * (1.f + sc.x) + sh.x, y1 = v[k].y * rs * g.y * (1.f + sc.y) + sh.y;
    const float y2 = v[k].z * rs * g.z * (1.f + sc.z) + sh.z, y3 = v[k].w * rs * g.w * (1.f + sc.w) + sh.w;
    if (F8) {
      int w = 0;
      w = __builtin_amdgcn_cvt_pk_fp8_f32(y0, y1, w, false); w = __builtin_amdgcn_cvt_pk_fp8_f32(y2, y3, w, true);
      ((unsigned*)((unsigned char*)H + (size_t)row * DM))[lane + 64 * k] = (unsigned)w;
    } else {
      bf16x4 o;
      o[0] = (bf16)y0; o[1] = (bf16)y1; o[2] = (bf16)y2; o[3] = (bf16)y3;
      ((bf16x4*)(H + (size_t)row * DM))[lane + 64 * k] = o;
    }
  }
}

constexpr int GBM = 128, GBN = 128, GBK = 64, GLD = 72;
enum { EPI_BF16 = 0, EPI_RESID = 1, EPI_QKV0 = 2, EPI_MLAQ = 3, EPI_MLAKV = 4 };
struct GemmEpi {
  bf16* Cb; int ldc; int rowmap;
  float* out_lat; const float* res_lat; float* out_ctx; const float* res_ctx; const float* modl; int gchunk;
  const float *n0g, *n1g, *n2g, *n3g, *cs, *sn;
  bf16 *QA, *QB, *CQA, *CQB, *KA, *VA, *KB, *VB;
  unsigned char* C8;
  unsigned char* V8T;
};


template <int DVH>
DI void store_vT_fp8(const float* Cs, int CLD, int m0, unsigned char* __restrict__ VT, int HV, int hv0) {
  int b, T0;
  if (m0 < NLAT) { b = m0 / SEQ; T0 = (NCX + (m0 % SEQ)) >> 6; } else { const int rc = m0 - NLAT; b = rc / NCX; T0 = (rc % NCX) >> 6; }
#pragma unroll 2
  for (int k = 0; k < 8; ++k) {
    const int u = (int)threadIdx.x + 256 * k;
    const int c = u & 7, d = (u >> 3) & 127, tile2 = u >> 10;
    const int kb = 32 * ((c >> 1) & 1) + 16 * (c & 1) + 4 * (c >> 2);
    float v[8];
#pragma unroll
    for (int e = 0; e < 8; ++e) v[e] = Cs[(tile2 * 64 + kb + 8 * (e >> 2) + (e & 3)) * CLD + d];
    const int head = hv0 + (DVH == 64 ? (d >> 6) : 0), dd = DVH == 64 ? (d & 63) : d;
    *(u32x2g*)(VT + ((((size_t)b * HV + head) * (NKEY / 64) + (T0 + tile2)) * DVH + dd) * 64 + 8 * c) = pack8_fp8(v);
  }
}

template <int EPI, bool F8 = false>
DI void gemm_tile(const bf16* __restrict__ A, int lda, const bf16* __restrict__ Bt, int K, const GemmEpi& e, int m0, int n0, char* smem) {
  const int tid = threadIdx.x, lane = tid & 63, wave = tid >> 6, wm = wave >> 1, wn = wave & 1;
  const int wave_u = __builtin_amdgcn_readfirstlane(wave);
  const int r = lane & 31, h = lane >> 5;
  const int drow = 8 * wave_u + (lane >> 3);
  const int dcol = ((lane & 7) ^ ((((wave_u & 1) << 2) | (lane >> 4)) & 7)) * 8;
  const bf16* Ag = A + (size_t)(m0 + drow) * lda + dcol;
  const bf16* Bg = Bt + (size_t)(n0 + drow) * K + dcol;
  f32x16 acc[2][2];
#pragma unroll
  for (int i = 0; i < 2; ++i)
#pragma unroll
    for (int j = 0; j < 2; ++j)
#pragma unroll
      for (int q = 0; q < 16; ++q) acc[i][j][q] = 0.f;
  const int nt = K / GBK;
  auto issue = [&](int t, int buf) {
#pragma unroll
    for (int i = 0; i < 4; ++i) {
      __builtin_amdgcn_global_load_lds((const unsigned*)(Ag + (size_t)(32 * i) * lda + t * GBK), (LAS unsigned*)(smem + buf * 32768 + (wave_u + 4 * i) * 1024), 16, 0, 0);
      __builtin_amdgcn_global_load_lds((const unsigned*)(Bg + (size_t)(32 * i) * K + t * GBK), (LAS unsigned*)(smem + buf * 32768 + 16384 + (wave_u + 4 * i) * 1024), 16, 0, 0);
    }
  };
  const int kswz = (r >> 1) & 7;
  __syncthreads();
  issue(0, 0);
  for (int t = 0; t < nt; ++t) {
    asm volatile("s_waitcnt vmcnt(0)" ::: "memory");
    __syncthreads();
    if (t + 1 < nt) issue(t + 1, (t + 1) & 1);
    const bf16* as = (const bf16*)(smem + (t & 1) * 32768) + (wm * 64 + r) * 64;
    const bf16* bs = (const bf16*)(smem + (t & 1) * 32768 + 16384) + (wn * 64 + r) * 64;
    if constexpr (F8) {
#pragma unroll
      for (int ks = 0; ks < 2; ++ks) {
        const int s0 = 8 * (((4 * ks + 2 * h) ^ kswz) & 7), s1 = 8 * (((4 * ks + 2 * h + 1) ^ kswz) & 7);
        i32x8 a8[2], b8[2];
#pragma unroll
        for (int i = 0; i < 2; ++i) {
          const u32x4 x0 = *(const u32x4*)(as + i * 32 * 64 + s0), x1 = *(const u32x4*)(as + i * 32 * 64 + s1);
          const u32x4 y0 = *(const u32x4*)(bs + i * 32 * 64 + s0), y1 = *(const u32x4*)(bs + i * 32 * 64 + s1);
          a8[i][0] = (int)x0[0]; a8[i][1] = (int)x0[1]; a8[i][2] = (int)x0[2]; a8[i][3] = (int)x0[3];
          a8[i][4] = (int)x1[0]; a8[i][5] = (int)x1[1]; a8[i][6] = (int)x1[2]; a8[i][7] = (int)x1[3];
          b8[i][0] = (int)y0[0]; b8[i][1] = (int)y0[1]; b8[i][2] = (int)y0[2]; b8[i][3] = (int)y0[3];
          b8[i][4] = (int)y1[0]; b8[i][5] = (int)y1[1]; b8[i][6] = (int)y1[2]; b8[i][7] = (int)y1[3];
        }
#pragma unroll
        for (int i = 0; i < 2; ++i)
#pragma unroll
          for (int jn = 0; jn < 2; ++jn)
            acc[i][jn] = __builtin_amdgcn_mfma_scale_f32_32x32x64_f8f6f4(a8[i], b8[jn], acc[i][jn], 0, 0, 0, 0x7F7F7F7F, 0, 0x7F7F7F7F);
      }
    } else
#pragma unroll
    for (int ks = 0; ks < 4; ++ks) {
      const int so = 8 * (((2 * ks + h) ^ kswz) & 7);
      const bf16x8 a0 = *(const bf16x8*)(as + so), a1 = *(const bf16x8*)(as + 32 * 64 + so);
      const bf16x8 b0 = *(const bf16x8*)(bs + so), b1 = *(const bf16x8*)(bs + 32 * 64 + so);
      acc[0][0] = mfma32(a0, b0, acc[0][0]);
      acc[0][1] = mfma32(a0, b1, acc[0][1]);
      acc[1][0] = mfma32(a1, b0, acc[1][0]);
      acc[1][1] = mfma32(a1, b1, acc[1][1]);
    }
  }
  if constexpr (F8) {
#pragma unroll
    for (int i = 0; i < 2; ++i)
#pragma unroll
      for (int jn = 0; jn < 2; ++jn)
#pragma unroll
        for (int q = 0; q < 16; ++q) acc[i][jn][q] *= (EPI == EPI_RESID ? 1.f / (W8_SCALE * O8_SCALE) : 1.f / W8_SCALE);
  }
  __syncthreads();
  if constexpr (EPI == EPI_BF16) {
    constexpr int CLD = 136;
    bf16* Cs = (bf16*)smem;
#pragma unroll
    for (int mi = 0; mi < 2; ++mi)
#pragma unroll
      for (int ni = 0; ni < 2; ++ni)
#pragma unroll
        for (int i = 0; i < 16; ++i) Cs[(wm * 64 + mi * 32 + crow(i, h)) * CLD + wn * 64 + ni * 32 + r] = (bf16)acc[mi][ni][i];
    __syncthreads();
    const int ch = tid & 15, r0 = tid >> 4;
#pragma unroll
    for (int k = 0; k < 8; ++k) {
      const int lrow = r0 + 16 * k, row = m0 + lrow;
      int orow = row;
      if (e.rowmap) orow = row < NLAT ? (row / SEQ) * NKEY + NCX + (row % SEQ) : ((row - NLAT) / NCX) * NKEY + ((row - NLAT) % NCX);
      *(u32x4*)(e.Cb + (size_t)orow * e.ldc + n0 + ch * 8) = *(const u32x4*)(Cs + lrow * CLD + ch * 8);
    }
  } else if constexpr (EPI == EPI_QKV0 || EPI == EPI_MLAQ || EPI == EPI_MLAKV) {
    constexpr int CLD = 132;
    float* Cs = (float*)smem;
#pragma unroll
    for (int mi = 0; mi < 2; ++mi)
#pragma unroll
      for (int ni = 0; ni < 2; ++ni)
#pragma unroll
        for (int i = 0; i < 16; ++i) Cs[(wm * 64 + mi * 32 + crow(i, h)) * CLD + wn * 64 + ni * 32 + r] = acc[mi][ni][i];
    __syncthreads();
    const int ch = tid & 15, r0 = tid >> 4, c8 = ch & 7;
    bool vtile = false;
    if constexpr (EPI == EPI_QKV0) {
      if (n0 == 640 || n0 == 1408) {
        store_vT_fp8<64>(Cs, CLD, m0, e.V8T + (n0 == 1408 ? (size_t)NB * 2 * (NKEY / 64) * 64 * 64 : 0), 2, 0);
        vtile = true;
      }
    } else if constexpr (EPI == EPI_MLAKV) {
      if ((n0 >> 7) & 1) { store_vT_fp8<128>(Cs, CLD, m0, e.V8T, 8, n0 >> 8); vtile = true; }
    }
    if (!vtile)
#pragma unroll 2
    for (int k = 0; k < 8; ++k) {
      const int lrow = r0 + 16 * k, row = m0 + lrow;
      const float4 va = *(const float4*)(Cs + lrow * CLD + ch * 8), vb = *(const float4*)(Cs + lrow * CLD + ch * 8 + 4);
      float v[8] = {va.x, va.y, va.z, va.w, vb.x, vb.y, vb.z, vb.w};
      float ss = 0.f;
#pragma unroll
      for (int j = 0; j < 8; ++j) ss += v[j] * v[j];
      const float ss8 = ss + __shfl_xor(ss, 4) + 0.f;
      float s8 = ss8; s8 += __shfl_xor(s8, 2); s8 += __shfl_xor(s8, 1);
      const float s16 = s8 + __shfl_xor(s8, 8);
      if constexpr (EPI == EPI_QKV0) {
        const bool lat = row < NLAT;
        int b, t;
        if (lat) { b = row / SEQ; t = row % SEQ; } else { const int rc = row - NLAT; b = rc / NCX; t = rc % NCX; }
        const int key = lat ? NCX + t : t;
        const int slot = (n0 >> 6) + (ch >> 3);
        const int isB = slot >= 12 ? 1 : 0, sp = slot - 12 * isB;
        const bool isq = sp < 8, isv = sp >= 10;
        {
          const float rs = rsqrtf(s8 * (1.f / 64.f) + EPS) * (isq ? LOG2E : 1.f);
          const float* gq = isB ? e.n2g : e.n0g;
          const float* gk = isB ? e.n3g : e.n1g;
          const float* g = (isq ? gq : gk) + c8 * 8;
          const float4 g0 = *(const float4*)g, g1 = *(const float4*)(g + 4);
          float w[8] = {v[0] * rs * g0.x, v[1] * rs * g0.y, v[2] * rs * g0.z, v[3] * rs * g0.w, v[4] * rs * g1.x, v[5] * rs * g1.y, v[6] * rs * g1.z, v[7] * rs * g1.w};
          if (lat) {
            const float4 cs4 = *(const float4*)(e.cs + t * 32 + c8 * 4), sn4 = *(const float4*)(e.sn + t * 32 + c8 * 4);
            float o0;
            o0 = w[0] * cs4.x - w[1] * sn4.x; w[1] = w[0] * sn4.x + w[1] * cs4.x; w[0] = o0;
            o0 = w[2] * cs4.y - w[3] * sn4.y; w[3] = w[2] * sn4.y + w[3] * cs4.y; w[2] = o0;
            o0 = w[4] * cs4.z - w[5] * sn4.z; w[5] = w[4] * sn4.z + w[5] * cs4.z; w[4] = o0;
            o0 = w[6] * cs4.w - w[7] * sn4.w; w[7] = w[6] * sn4.w + w[7] * cs4.w; w[6] = o0;
          }
#pragma unroll
          for (int j = 0; j < 8; ++j) v[j] = isv ? v[j] : w[j];
        }
        bf16x8 ov;
#pragma unroll
        for (int j = 0; j < 8; ++j) ov[j] = (bf16)v[j];
        constexpr size_t SZQ = (size_t)NB * 8 * SEQ * 64, SZC = (size_t)NB * 8 * NCX * 64, SZK = (size_t)NB * 2 * NKEY * 64;
        const size_t offq = lat ? (size_t)isB * SZQ + ((size_t)(b * 8 + sp) * SEQ + t) * 64
                                : 2 * SZQ + (size_t)isB * SZC + ((size_t)(b * 8 + sp) * NCX + t) * 64;
        const int hk = (sp - 8) & 1;
        const size_t offk = 2 * SZQ + 2 * SZC + (size_t)(2 * isB + (isv ? 1 : 0)) * SZK + ((size_t)(b * 2 + hk) * NKEY + key) * 64;
        const size_t off = isq ? offq : offk;
        if (isv) *(bf16x8*)(e.QA + off + c8 * 8) = ov;
        else *(u32x2g*)((unsigned char*)e.QA + off + c8 * 8) = pack8_fp8(v);
      } else if constexpr (EPI == EPI_MLAQ) {
        constexpr float QSC = 0.07216878364870322f * LOG2E * 8.f;
        if (n0 < 1024) {
          const float rs = rsqrtf(s16 * (1.f / 128.f) + EPS) * QSC;
          const float4 g0 = *(const float4*)(e.n0g + ch * 8), g1 = *(const float4*)(e.n0g + ch * 8 + 4);
          v[0] *= rs * g0.x; v[1] *= rs * g0.y; v[2] *= rs * g0.z; v[3] *= rs * g0.w;
          v[4] *= rs * g1.x; v[5] *= rs * g1.y; v[6] *= rs * g1.z; v[7] *= rs * g1.w;
        } else {
          const int t = row % SEQ;
          const float rs = rsqrtf(s8 * (1.f / 64.f) + EPS) * QSC;
          const float4 g0 = *(const float4*)(e.n1g + c8 * 8), g1 = *(const float4*)(e.n1g + c8 * 8 + 4);
          v[0] *= rs * g0.x; v[1] *= rs * g0.y; v[2] *= rs * g0.z; v[3] *= rs * g0.w;
          v[4] *= rs * g1.x; v[5] *= rs * g1.y; v[6] *= rs * g1.z; v[7] *= rs * g1.w;
          const float4 cs4 = *(const float4*)(e.cs + t * 32 + c8 * 4), sn4 = *(const float4*)(e.sn + t * 32 + c8 * 4);
          float o0;
          o0 = v[0] * cs4.x - v[1] * sn4.x; v[1] = v[0] * sn4.x + v[1] * cs4.x; v[0] = o0;
          o0 = v[2] * cs4.y - v[3] * sn4.y; v[3] = v[2] * sn4.y + v[3] * cs4.y; v[2] = o0;
          o0 = v[4] * cs4.z - v[5] * sn4.z; v[5] = v[4] * sn4.z + v[5] * cs4.z; v[4] = o0;
          o0 = v[6] * cs4.w - v[7] * sn4.w; v[7] = v[6] * sn4.w + v[7] * cs4.w; v[6] = o0;
        }
        *(u32x2g*)(e.C8 + (size_t)row * e.ldc + n0 + ch * 8) = pack8_fp8(v);
      } else {
        if (((n0 >> 7) & 1) == 0) {
          const float rs = rsqrtf(s16 * (1.f / 128.f) + EPS);
          const float4 g0 = *(const float4*)(e.n0g + ch * 8), g1 = *(const float4*)(e.n0g + ch * 8 + 4);
          v[0] *= rs * g0.x; v[1] *= rs * g0.y; v[2] *= rs * g0.z; v[3] *= rs * g0.w;
          v[4] *= rs * g1.x; v[5] *= rs * g1.y; v[6] *= rs * g1.z; v[7] *= rs * g1.w;
        }
        const int orow = row < NLAT ? (row / SEQ) * NKEY + NCX + (row % SEQ) : ((row - NLAT) / NCX) * NKEY + ((row - NLAT) % NCX);
        if (((n0 >> 7) & 1) == 0) {
          *(u32x2g*)(e.C8 + (size_t)orow * 1024 + (n0 >> 8) * 128 + ch * 8) = pack8_fp8(v);
        } else {
          bf16x8 ov;
#pragma unroll
          for (int j = 0; j < 8; ++j) ov[j] = (bf16)v[j];
          *(bf16x8*)(e.Cb + (size_t)orow * e.ldc + n0 + ch * 8) = ov;
        }
      }
    }
  } else {
    constexpr int CLD = 132;
    float* Cs = (float*)smem;
#pragma unroll
    for (int mi = 0; mi < 2; ++mi)
#pragma unroll
      for (int ni = 0; ni < 2; ++ni)
#pragma unroll
        for (int i = 0; i < 16; ++i) Cs[(wm * 64 + mi * 32 + crow(i, h)) * CLD + wn * 64 + ni * 32 + r] = acc[mi][ni][i];
    __syncthreads();
    const int ch = tid & 31, r0 = tid >> 5;
    const bool lat = m0 < NLAT;
    const int b = lat ? m0 / SEQ : 4;
    const float4 g = *(const float4*)(e.modl + (size_t)b * 6144 + e.gchunk * 1024 + n0 + ch * 4);
    float* outp = lat ? e.out_lat + (size_t)m0 * DM : e.out_ctx + (size_t)(m0 - NLAT) * DM;
    const float* resp = lat ? e.res_lat + (size_t)m0 * DM : e.res_ctx + (size_t)(m0 - NLAT) * DM;
#pragma unroll
    for (int k = 0; k < 16; ++k) {
      const int lrow = r0 + 8 * k;
      const float4 c = *(const float4*)(Cs + lrow * CLD + ch * 4);
      float4 x = *(const float4*)(resp + (size_t)lrow * DM + n0 + ch * 4);
      x.x += g.x * c.x; x.y += g.y * c.y; x.z += g.z * c.z; x.w += g.w * c.w;
      *(float4*)(outp + (size_t)lrow * DM + n0 + ch * 4) = x;
    }
  }
  __syncthreads();
}
template <int EPI, bool F8 = false>
DI void gemm_phase(const bf16* __restrict__ A, int lda, const bf16* __restrict__ Bt, int K, const GemmEpi& e, int M, int N, char* smem) {
  const int ntn = N / GBN, ntm = M / GBM;
  const int G = gridDim.x;
  if ((G & 7) == 0 && (ntm & 7) == 0) {
    const int xcd = blockIdx.x & 7, nj = G >> 3, pm = ntm >> 3, nloc = pm * ntn;
    for (int u = blockIdx.x >> 3; u < nloc; u += nj) gemm_tile<EPI, F8>(A, lda, Bt, K, e, (xcd * pm + u / ntn) * GBM, (u % ntn) * GBN, smem);
  } else {
    const int nitems = ntm * ntn;
    for (int item = blockIdx.x; item < nitems; item += G) gemm_tile<EPI, F8>(A, lda, Bt, K, e, (item / ntn) * GBM, (item % ntn) * GBN, smem);
  }
}

struct Post0 {
  const bf16* P;
  const float *aqn, *akn, *bqn, *bkn, *cs, *sn;
  bf16 *QA, *QB, *CQA, *CQB, *KA, *VA, *KB, *VB;
};
DI void qkv_post0_item(int item, const Post0& p) {
  const int lane = threadIdx.x & 63, wave = threadIdx.x >> 6;
  const int row = item * 4 + wave;
  const bool lat = row < NLAT;
  int b, t;
  if (lat) { b = row / SEQ; t = row % SEQ; } else { const int rc = row - NLAT; b = rc / NCX; t = rc % NCX; }
  const int key = lat ? NCX + t : t;
  const int c8 = lane & 7;
  float4 cs4 = {1.f, 1.f, 1.f, 1.f}, sn4 = {0.f, 0.f, 0.f, 0.f};
  if (lat) { cs4 = *(const float4*)(p.cs + t * 32 + c8 * 4); sn4 = *(const float4*)(p.sn + t * 32 + c8 * 4); }
#pragma unroll
  for (int k = 0; k < 3; ++k) {
    const int c = lane + 64 * k, slot = c >> 3;
    const bf16x8 pv = *(const bf16x8*)(p.P + (size_t)row * 1536 + c * 8);
    float v[8];
#pragma unroll
    for (int j = 0; j < 8; ++j) v[j] = (float)pv[j];
    const bool isv = (slot == 10 || slot == 11 || slot == 22 || slot == 23);
    float ss = 0.f;
#pragma unroll
    for (int j = 0; j < 8; ++j) ss += v[j] * v[j];
    ss += __shfl_xor(ss, 4); ss += __shfl_xor(ss, 2); ss += __shfl_xor(ss, 1);
    if (!isv) {
      const float rs = rsqrtf(ss * (1.f / 64.f) + EPS);
      const float* g = (slot < 8 ? p.aqn : slot < 10 ? p.akn : slot < 20 ? p.bqn : p.bkn) + c8 * 8;
      const float4 g0 = *(const float4*)g, g1 = *(const float4*)(g + 4);
      v[0] *= rs * g0.x; v[1] *= rs * g0.y; v[2] *= rs * g0.z; v[3] *= rs * g0.w;
      v[4] *= rs * g1.x; v[5] *= rs * g1.y; v[6] *= rs * g1.z; v[7] *= rs * g1.w;
      if (lat) {
        float o0;
        o0 = v[0] * cs4.x - v[1] * sn4.x; v[1] = v[0] * sn4.x + v[1] * cs4.x; v[0] = o0;
        o0 = v[2] * cs4.y - v[3] * sn4.y; v[3] = v[2] * sn4.y + v[3] * cs4.y; v[2] = o0;
        o0 = v[4] * cs4.z - v[5] * sn4.z; v[5] = v[4] * sn4.z + v[5] * cs4.z; v[4] = o0;
        o0 = v[6] * cs4.w - v[7] * sn4.w; v[7] = v[6] * sn4.w + v[7] * cs4.w; v[6] = o0;
      }
    }
    bf16x8 ov;
#pragma unroll
    for (int j = 0; j < 8; ++j) ov[j] = (bf16)v[j];
    bf16* dst;
    if (slot < 8) dst = lat ? p.QA + ((size_t)(b * 8 + slot) * SEQ + t) * 64 : p.CQA + ((size_t)(b * 8 + slot) * NCX + t) * 64;
    else if (slot < 10) dst = p.KA + ((size_t)(b * 2 + slot - 8) * NKEY + key) * 64;
    else if (slot < 12) dst = p.VA + ((size_t)(b * 2 + slot - 10) * NKEY + key) * 64;
    else if (slot < 20) dst = lat ? p.QB + ((size_t)(b * 8 + slot - 12) * SEQ + t) * 64 : p.CQB + ((size_t)(b * 8 + slot - 12) * NCX + t) * 64;
    else if (slot < 22) dst = p.KB + ((size_t)(b * 2 + slot - 20) * NKEY + key) * 64;
    else dst = p.VB + ((size_t)(b * 2 + slot - 22) * NKEY + key) * 64;
    *(bf16x8*)(dst + c8 * 8) = ov;
  }
}

struct AttnParams {
  const bf16* Q; long q_bs, q_hs; int q_ts; int q2_off, q2_hs;
  const bf16* K; long k_bs, k_hs; int k_ts;
  const bf16* K2; long k2_bs; int k2_ts;
  const bf16* V; long v_bs, v_hs; int v_ts;
  const unsigned char* V8; long v8_bs, v8_hs;
  bf16* O; int o_row0, o_bs, o_col0;
  const float* sink;
  int nkeys;
  int G;
  int window;
  float scale_log2;
};

template <int DQK, int DV, int DSPLIT, int VBUFS, bool WINDOW, bool FP8 = false>
DI void attn_item(const AttnParams& p, int qblk, int head, int b, char* smem) {
  constexpr int KCH = DQK / 8, VCH = DV / 8;
  constexpr int KPW = KCH / 4, VPW = VCH / 4;
  constexpr int KBYTES = FP8 ? 64 * DQK : 64 * DQK * 2, VBYTES = FP8 ? DV * 64 : 64 * DV * 2;
  constexpr float PSHIFT = FP8 ? 7.f : 0.f, THR = FP8 ? 1.f : 8.f;
  constexpr int NKS = DQK / 16, NDB = DV / 32;
  char* Kbase = smem;
  char* Vbase = smem + 2 * KBYTES;
  const int tid = threadIdx.x, lane = tid & 63, wave = tid >> 6;
  const int wave_u = __builtin_amdgcn_readfirstlane(wave);
  const int r = lane & 31, h = lane >> 5;
  const int q0 = qblk * 128;
  const int hkv = head / p.G;
  const int tq = q0 + wave * 32 + r;

  bf16x8 qf[FP8 ? 1 : NKS];
  i32x8 q8[FP8 ? DQK / 64 : 1];
  if constexpr (!FP8) {
    const bf16* qp = p.Q + (size_t)b * p.q_bs + (size_t)head * p.q_hs + (size_t)tq * p.q_ts + 8 * h;
    const bf16* qp2 = p.Q + (size_t)b * p.q_bs + (size_t)tq * p.q_ts + p.q2_off + head * p.q2_hs + 8 * h;
#pragma unroll
    for (int ks = 0; ks < NKS; ++ks) qf[ks] = (DSPLIT == DQK || ks * 16 < DSPLIT) ? *(const bf16x8*)(qp + ks * 16) : *(const bf16x8*)(qp2 + (ks * 16 - DSPLIT));
  } else {
    const unsigned char* q8p = (const unsigned char*)p.Q + (size_t)b * p.q_bs + (size_t)tq * p.q_ts;
#pragma unroll
    for (int kb = 0; kb < DQK / 64; ++kb) {
      const unsigned char* src = (kb * 64 < DSPLIT) ? q8p + head * p.q_hs + kb * 64 + 32 * h : q8p + p.q2_off + head * p.q2_hs + (kb * 64 - DSPLIT) + 32 * h;
      const u32x4 lo4 = *(const u32x4*)src, hi4 = *(const u32x4*)(src + 16);
      q8[kb][0] = (int)lo4[0]; q8[kb][1] = (int)lo4[1]; q8[kb][2] = (int)lo4[2]; q8[kb][3] = (int)lo4[3];
      q8[kb][4] = (int)hi4[0]; q8[kb][5] = (int)hi4[1]; q8[kb][6] = (int)hi4[2]; q8[kb][7] = (int)hi4[3];
    }
  }
  int ntiles, lo = 0;
  if (WINDOW) {
    lo = q0 - 128 < 0 ? 0 : q0 - 128;
    const int hi = q0 + 256 > SEQ ? SEQ : q0 + 256;
    ntiles = 4 + (hi - lo) / 64;
  } else {
    ntiles = p.nkeys / 64;
  }
  const bf16* Kb = p.K + (size_t)b * p.k_bs + (size_t)hkv * p.k_hs;
  const bf16* K2b = (DSPLIT < DQK) ? p.K2 + (size_t)b * p.k2_bs : nullptr;
  const bf16* Vb = p.V + (size_t)b * p.v_bs + (size_t)hkv * p.v_hs;

  auto key0_of = [&](int j) -> int { return WINDOW ? (j < 4 ? j * 64 : NCX + lo + (j - 4) * 64) : j * 64; };
  const int krow_l = 8 * wave_u + (lane >> 3);
  const int kcol_l = (lane & 7) ^ ((((wave_u & 1) << 2) | (lane >> 4)) & 7);
  auto issue_k = [&](int j, int buf) {
    const int k0 = key0_of(j);
    if constexpr (FP8) {
      const int row = 16 * wave_u + (lane >> 2);
      const int chunk = (lane & 3) ^ ((lane >> 4) & 3);
#pragma unroll
      for (int g = 0; g < DQK / 64; ++g) {
        const unsigned char* src = (g * 64 < DSPLIT)
            ? (const unsigned char*)p.K + (size_t)b * p.k_bs + (size_t)hkv * p.k_hs + (size_t)(k0 + row) * p.k_ts + g * 64 + 16 * chunk
            : (const unsigned char*)p.K2 + (size_t)b * p.k2_bs + (size_t)(k0 + row) * p.k2_ts + (g * 64 - DSPLIT) + 16 * chunk;
        __builtin_amdgcn_global_load_lds((const unsigned*)src, (LAS unsigned*)(Kbase + buf * KBYTES + g * 4096 + wave_u * 1024), 16, 0, 0);
      }
      return;
    }
#pragma unroll
    for (int i = 0; i < KPW; ++i) {
      const int g = i >> 1, row = krow_l + 32 * (i & 1);
      const bf16* src;
      if (DSPLIT == DQK || g * 64 < DSPLIT) src = Kb + (size_t)(k0 + row) * p.k_ts + (8 * g + kcol_l) * 8;
      else src = K2b + (size_t)(k0 + row) * p.k2_ts + ((8 * g + kcol_l) * 8 - DSPLIT);
      __builtin_amdgcn_global_load_lds((const unsigned*)src, (LAS unsigned*)(Kbase + buf * KBYTES + g * 8192 + (wave_u + 4 * (i & 1)) * 1024), 16, 0, 0);
    }
  };
  const int vrow_l = (DV == 128) ? 4 * wave_u + (lane >> 4) : 8 * wave_u + (lane >> 3);
  const int vcol_l = (DV == 128) ? ((lane & 15) ^ (((lane >> 4) << 2) | (wave_u & 3))) : ((lane & 7) ^ (((lane >> 4) & 1) << 2));
  auto issue_v = [&](int j, int buf) {
    const int k0 = key0_of(j);
    if constexpr (FP8) {
      const unsigned char* vsrc = p.V8 + (size_t)b * p.v8_bs + (size_t)hkv * p.v8_hs + (size_t)(k0 >> 6) * (DV * 64);
      const int chunk = (lane & 3) ^ ((lane >> 4) & 3);
#pragma unroll
      for (int i = 0; i < DV / 64; ++i) {
        const int I = wave_u + 4 * i, row = 16 * I + (lane >> 2);
        __builtin_amdgcn_global_load_lds((const unsigned*)(vsrc + row * 64 + 16 * chunk), (LAS unsigned*)(Vbase + buf * VBYTES + I * 1024), 16, 0, 0);
      }
      return;
    }
#pragma unroll
    for (int i = 0; i < VPW; ++i) {
      const int row = vrow_l + ((DV == 128) ? 16 : 32) * i;
      const bf16* src = Vb + (size_t)(k0 + row) * p.v_ts + vcol_l * 8;
      __builtin_amdgcn_global_load_lds((const unsigned*)src, (LAS unsigned*)(Vbase + buf * VBYTES + (wave_u + 4 * i) * 1024), 16, 0, 0);
    }
  };

  f32x16 o[NDB];
#pragma unroll
  for (int d = 0; d < NDB; ++d)
#pragma unroll
    for (int i = 0; i < 16; ++i) o[d][i] = 0.f;
  constexpr float M0 = -1000.f;
  float m = FP8 ? M0 : -1e30f, l = 0.f;
  f32x16 minit;
#pragma unroll
  for (int i = 0; i < 16; ++i) minit[i] = PSHIFT - M0;
  const int i16 = lane & 15, q4 = i16 >> 2, p4 = i16 & 3, g1 = (lane >> 4) & 1;
  const int kswz = (r >> 1) & 7;

  i32x8 p8;
#pragma unroll
  for (int i = 0; i < 8; ++i) p8[i] = 0;
  __syncthreads();
  issue_k(0, 0);
  if (VBUFS == 2) issue_v(0, 0);
  for (int j = 0; j < ntiles; ++j) {
    asm volatile("s_waitcnt vmcnt(0)" ::: "memory");
    __syncthreads();
    if (VBUFS == 1) issue_v(j, 0);
    if (j + 1 < ntiles) { issue_k(j + 1, (j + 1) & 1); if (VBUFS == 2) issue_v(j + 1, (j + 1) & 1); }
    const bf16* Ks = (const bf16*)(Kbase + (j & 1) * KBYTES);
    const bf16* Vs = (const bf16*)(Vbase + (VBUFS == 2 ? (j & 1) * VBYTES : 0));

    f32x16 s[2];
    if constexpr (!FP8) {
#pragma unroll
      for (int mb = 0; mb < 2; ++mb)
#pragma unroll
        for (int i = 0; i < 16; ++i) s[mb][i] = 0.f;
    }
    if constexpr (FP8) {
      const char* K8s = Kbase + (j & 1) * KBYTES;
      const int rsw = (r >> 2) & 3;
#pragma unroll
      for (int mb = 0; mb < 2; ++mb)
#pragma unroll
        for (int kb = 0; kb < DQK / 64; ++kb) {
          const char* rowp = K8s + kb * 4096 + (mb * 32 + r) * 64;
          const u32x4 c0 = *(const u32x4*)(rowp + 16 * ((2 * h) ^ rsw)), c1 = *(const u32x4*)(rowp + 16 * ((2 * h + 1) ^ rsw));
          i32x8 a8;
          a8[0] = (int)c0[0]; a8[1] = (int)c0[1]; a8[2] = (int)c0[2]; a8[3] = (int)c0[3];
          a8[4] = (int)c1[0]; a8[5] = (int)c1[1]; a8[6] = (int)c1[2]; a8[7] = (int)c1[3];
          s[mb] = __builtin_amdgcn_mfma_scale_f32_32x32x64_f8f6f4(a8, q8[kb], kb == 0 ? minit : s[mb], 0, 0, 0, 0x7F7F7F7F, 0, 0x7C7C7C7C);
        }
    } else {
      constexpr int GPM = NKS / 4, NG = 2 * GPM;
      bf16x8 fa[4], fb[4];
#define ATTN_KRD(F, g)                                                                                                   \
  _Pragma("unroll") for (int i = 0; i < 4; ++i) {                                                                      \
    const int c = 2 * ((((g) % GPM) * 4) + i) + h;                                                                      \
    F[i] = *(const bf16x8*)(&Ks[(c >> 3) * 4096 + (((g) / GPM) * 32 + r) * 64 + 8 * ((c ^ kswz) & 7)]);                \
  }
      ATTN_KRD(fa, 0)
#pragma unroll
      for (int g = 0; g < NG; ++g) {
        if (g + 1 < NG) { if (g & 1) { ATTN_KRD(fa, g + 1) } else { ATTN_KRD(fb, g + 1) } }
        __builtin_amdgcn_sched_barrier(0);
#pragma unroll
        for (int i = 0; i < 4; ++i) s[g / GPM] = mfma32((g & 1) ? fb[i] : fa[i], qf[(g % GPM) * 4 + i], s[g / GPM]);
        __builtin_amdgcn_sched_barrier(0);
      }
#undef ATTN_KRD
    }
    const bool band = WINDOW && j >= 4;
    const int pos0 = lo + (j - 4) * 64;
    float mx = -1e30f;
#pragma unroll
    for (int mb = 0; mb < 2; ++mb)
#pragma unroll
      for (int i = 0; i < 16; ++i) {
        if (WINDOW) {
          if (band) {
            const int dlt = pos0 + mb * 32 + crow(i, h) - tq;
            if (dlt > 128 || dlt < -128) s[mb][i] = -1e30f;
          }
        }
        mx = fmaxf(mx, s[mb][i]);
      }
    mx = fmaxf(mx, __shfl_xor(mx, 32));
    if constexpr (FP8) {
      if (__any(mx > PSHIFT + THR)) {
        const float delta = fmaxf(mx - PSHIFT, 0.f);
        const float alpha = __builtin_amdgcn_exp2f(-delta);
        m += delta;
        l *= alpha;
#pragma unroll
        for (int d = 0; d < NDB; ++d)
#pragma unroll
          for (int i = 0; i < 16; ++i) o[d][i] *= alpha;
#pragma unroll
        for (int mb = 0; mb < 2; ++mb)
#pragma unroll
          for (int i = 0; i < 16; ++i) s[mb][i] -= delta;
#pragma unroll
        for (int i = 0; i < 16; ++i) minit[i] = PSHIFT - m;
      }
    } else {
    mx *= p.scale_log2;
    if (__any(mx > m + THR)) {
      const float mn = fmaxf(m, mx);
      const float alpha = __builtin_amdgcn_exp2f(m - mn);
      m = mn;
      l *= alpha;
#pragma unroll
      for (int d = 0; d < NDB; ++d)
#pragma unroll
        for (int i = 0; i < 16; ++i) o[d][i] *= alpha;
    }
    }
    float ls = 0.f;
#pragma unroll
    for (int mb = 0; mb < 2; ++mb)
#pragma unroll
      for (int i = 0; i < 16; ++i) {
        const float ev = FP8 ? __builtin_amdgcn_exp2f(s[mb][i]) : __builtin_amdgcn_exp2f(__builtin_fmaf(s[mb][i], p.scale_log2, PSHIFT - m));
        s[mb][i] = ev;
        ls += ev;
      }
    l += ls;
    bf16x8 pf[2][2];
    if constexpr (FP8) {
#pragma unroll
      for (int mb = 0; mb < 2; ++mb)
#pragma unroll
        for (int q = 0; q < 4; ++q) {
          int w = p8[4 * mb + q];
          w = __builtin_amdgcn_cvt_pk_fp8_f32(s[mb][4 * q], s[mb][4 * q + 1], w, false);
          w = __builtin_amdgcn_cvt_pk_fp8_f32(s[mb][4 * q + 2], s[mb][4 * q + 3], w, true);
          p8[4 * mb + q] = w;
        }
    } else {
#pragma unroll
      for (int mb = 0; mb < 2; ++mb)
#pragma unroll
        for (int s2 = 0; s2 < 2; ++s2)
#pragma unroll
          for (int jj = 0; jj < 8; ++jj) pf[mb][s2][jj] = (bf16)s[mb][8 * s2 + jj];
    }
    if (VBUFS == 1) {
      asm volatile("s_waitcnt vmcnt(0)" ::: "memory");
      __syncthreads();
    }
    if constexpr (FP8) {
      const char* V8s = Vbase + (VBUFS == 2 ? (j & 1) * VBYTES : 0);
      const int rsw = (r >> 2) & 3;
#pragma unroll
      for (int d = 0; d < NDB; ++d) {
        const char* rowp = V8s + (d * 32 + r) * 64;
        const u32x4 c0 = *(const u32x4*)(rowp + 16 * ((2 * h) ^ rsw)), c1 = *(const u32x4*)(rowp + 16 * ((2 * h + 1) ^ rsw));
        i32x8 a8;
        a8[0] = (int)c0[0]; a8[1] = (int)c0[1]; a8[2] = (int)c0[2]; a8[3] = (int)c0[3];
        a8[4] = (int)c1[0]; a8[5] = (int)c1[1]; a8[6] = (int)c1[2]; a8[7] = (int)c1[3];
        o[d] = __builtin_amdgcn_mfma_scale_f32_32x32x64_f8f6f4(a8, p8, o[d], 0, 0, 0, 0x7F7F7F7F, 0, 0x7F7F7F7F);
      }
    } else {
      const unsigned vbase = (unsigned)(size_t)Vs;
      bf16x4 ta[8], tb[8];
#define ATTN_VADDR(d)                                                                                                   \
      const int row0_ = 4 * h + q4;                                                                                     \
      const int ch_ = (d) * 4 + 2 * g1 + (p4 >> 1);                                                                     \
      const int f0_ = (DV == 128) ? ((q4 << 2) | ((row0_ >> 2) & 3)) : (((row0_ >> 1) & 1) << 2);                       \
      const int f1_ = (DV == 128) ? ((q4 << 2) | (((row0_ + 8) >> 2) & 3)) : ((((row0_ + 8) >> 1) & 1) << 2);           \
      const unsigned a_lo_ = vbase + (unsigned)((row0_ * DV + 8 * (ch_ ^ f0_) + 4 * (p4 & 1)) * 2);                     \
      const unsigned a_hi_ = vbase + (unsigned)(((row0_ + 8) * DV + 8 * (ch_ ^ f1_) + 4 * (p4 & 1)) * 2);
#define ATTN_VRD(T, d)                                                                                                  \
      {                                                                                                                 \
        ATTN_VADDR(d)                                                                                                   \
        asm volatile(                                                                                                   \
            "ds_read_b64_tr_b16 %0, %8\n\t"                                                                             \
            "ds_read_b64_tr_b16 %1, %9\n\t"                                                                             \
            "ds_read_b64_tr_b16 %2, %8 offset:%10\n\t"                                                                  \
            "ds_read_b64_tr_b16 %3, %9 offset:%10\n\t"                                                                  \
            "ds_read_b64_tr_b16 %4, %8 offset:%11\n\t"                                                                  \
            "ds_read_b64_tr_b16 %5, %9 offset:%11\n\t"                                                                  \
            "ds_read_b64_tr_b16 %6, %8 offset:%12\n\t"                                                                  \
            "ds_read_b64_tr_b16 %7, %9 offset:%12"                                                                      \
            : "=&v"(T[0]), "=&v"(T[1]), "=&v"(T[2]), "=&v"(T[3]), "=&v"(T[4]), "=&v"(T[5]), "=&v"(T[6]), "=&v"(T[7])    \
            : "v"(a_lo_), "v"(a_hi_), "i"(16 * DV * 2), "i"(32 * DV * 2), "i"(48 * DV * 2)                              \
            : "memory");                                                                                                \
      }
#define ATTN_VWAIT(T, N)                                                                                                \
      asm volatile("s_waitcnt lgkmcnt(" #N ")"                                                                          \
                   : "+v"(T[0]), "+v"(T[1]), "+v"(T[2]), "+v"(T[3]), "+v"(T[4]), "+v"(T[5]), "+v"(T[6]), "+v"(T[7]) : : "memory");
#define ATTN_VMMA(T, d)                                                                                                 \
      o[d] = mfma32(__builtin_shufflevector(T[0], T[1], 0, 1, 2, 3, 4, 5, 6, 7), pf[0][0], o[d]);                       \
      o[d] = mfma32(__builtin_shufflevector(T[2], T[3], 0, 1, 2, 3, 4, 5, 6, 7), pf[0][1], o[d]);                       \
      o[d] = mfma32(__builtin_shufflevector(T[4], T[5], 0, 1, 2, 3, 4, 5, 6, 7), pf[1][0], o[d]);                       \
      o[d] = mfma32(__builtin_shufflevector(T[6], T[7], 0, 1, 2, 3, 4, 5, 6, 7), pf[1][1], o[d]);
      ATTN_VRD(ta, 0)
#pragma unroll
      for (int d = 0; d < NDB; ++d) {
        if (d + 1 < NDB) {
          if (d & 1) { ATTN_VRD(ta, d + 1) ATTN_VWAIT(tb, 8) ATTN_VMMA(tb, d) }
          else       { ATTN_VRD(tb, d + 1) ATTN_VWAIT(ta, 8) ATTN_VMMA(ta, d) }
        } else {
          if (d & 1) { ATTN_VWAIT(tb, 0) ATTN_VMMA(tb, d) }
          else       { ATTN_VWAIT(ta, 0) ATTN_VMMA(ta, d) }
        }
      }
#undef ATTN_VADDR
#undef ATTN_VRD
#undef ATTN_VWAIT
#undef ATTN_VMMA
    }
  }
  float lt = l + __shfl_xor(l, 32);
  if (p.sink) lt += __builtin_amdgcn_exp2f(p.sink[head] * LOG2E + PSHIFT - m);
  const float inv = 1.f / lt;
  if constexpr (FP8) {
    unsigned char* op8 = (unsigned char*)p.O + (size_t)(p.o_row0 + b * p.o_bs + tq) * DM + p.o_col0 + head * DV;
    const float inv8 = inv * O8_SCALE;
#pragma unroll
    for (int d = 0; d < NDB; ++d)
#pragma unroll
      for (int g = 0; g < 4; ++g) {
        int w = 0;
        w = __builtin_amdgcn_cvt_pk_fp8_f32(o[d][4 * g] * inv8, o[d][4 * g + 1] * inv8, w, false);
        w = __builtin_amdgcn_cvt_pk_fp8_f32(o[d][4 * g + 2] * inv8, o[d][4 * g + 3] * inv8, w, true);
        *(int*)(op8 + d * 32 + 8 * g + 4 * h) = w;
      }
    return;
  }
  bf16* op = p.O + (size_t)(p.o_row0 + b * p.o_bs + tq) * DM + p.o_col0 + head * DV;
#pragma unroll
  for (int d = 0; d < NDB; ++d)
#pragma unroll
    for (int g = 0; g < 4; ++g) {
      bf16x4 ov;
#pragma unroll
      for (int jj = 0; jj < 4; ++jj) ov[jj] = (bf16)(o[d][4 * g + jj] * inv);
      *(bf16x4*)(op + d * 32 + 8 * g + 4 * h) = ov;
    }
}

struct PairTab { int i[50]; int j[50]; };
constexpr PairTab make_pairs() {
  PairTab t{}; int c = 0;
  for (int i = 0; i < 16; ++i) for (int j = 0; j < 16; ++j) if ((i + 1) * (j + 1) <= 16) { t.i[c] = i; t.j[c] = j; ++c; }
  return t;
}
constexpr PairTab PAIRS = make_pairs();
DI float as_f(unsigned u) { return __builtin_bit_cast(float, u); }
DI unsigned as_u(float f) { return __builtin_bit_cast(unsigned, f); }

DI void ce_desc(float& a, float& b) { const float hi = fmaxf(a, b), lo = fminf(a, b); a = hi; b = lo; }
DI void sort16_desc(float (&v)[16]) {
#pragma unroll
  for (int k = 2; k <= 16; k <<= 1)
#pragma unroll
    for (int j = k >> 1; j > 0; j >>= 1)
#pragma unroll
      for (int i = 0; i < 16; ++i) {
        const int l = i ^ j;
        if (l > i) { if ((i & k) == 0) ce_desc(v[i], v[l]); else ce_desc(v[l], v[i]); }
      }
}
DI void bmerge16_desc(float (&v)[16]) {
#pragma unroll
  for (int j = 8; j > 0; j >>= 1)
#pragma unroll
    for (int i = 0; i < 16; ++i) { const int l = i ^ j; if (l > i) ce_desc(v[i], v[l]); }
}
DI void top16_merge(float (&a)[16], const float (&b)[16]) {
#pragma unroll
  for (int i = 0; i < 16; ++i) a[i] = fmaxf(a[i], b[15 - i]);
  bmerge16_desc(a);
}
DI void top16_merge_partner(float (&a)[16]) {
  float b[16];
#pragma unroll
  for (int i = 0; i < 16; ++i) b[i] = __shfl_xor(a[i], 32);
  top16_merge(a, b);
}

DI void peer_select_item(int tile, int hhalf, const bf16* __restrict__ QP, const bf16* __restrict__ SK,
                         int* __restrict__ IDX, float* __restrict__ GW, char* smem) {
  unsigned (*lidx)[64][9] = (unsigned (*)[64][9])smem;
  const int tid = threadIdx.x, lane = tid & 63, wave = tid >> 6;
  const int r = lane & 31, h = lane >> 5;
  const int tok = tile * 32 + r;
  const int head = hhalf * 4 + wave;
  const float NINF = -__builtin_inff();
  float top[2][16];
#pragma unroll
  for (int p = 0; p < 2; ++p) {
    const bf16* qp = QP + (size_t)tok * 2048 + (head * 2 + p) * 128 + 8 * h;
    const bf16* kp = SK + ((size_t)(head * 2 + p) * 128 + r) * 128 + 8 * h;
    f32x16 acc[4];
#pragma unroll
    for (int nb = 0; nb < 4; ++nb)
#pragma unroll
      for (int i = 0; i < 16; ++i) acc[nb][i] = 0.f;
#pragma unroll 2
    for (int ks = 0; ks < 8; ++ks) {
      const bf16x8 bq = *(const bf16x8*)(qp + ks * 16);
#pragma unroll
      for (int nb = 0; nb < 4; ++nb) {
        const bf16x8 a = *(const bf16x8*)(kp + (size_t)nb * 32 * 128 + ks * 16);
        acc[nb] = mfma32(a, bq, acc[nb]);
      }
    }
    float k0[16], k1[16], k2[16], k3[16];
#pragma unroll
    for (int i = 0; i < 16; ++i) {
      k0[i] = as_f((as_u(acc[0][i]) & 0xFFFFFF80u) | (unsigned)(0 * 32 + crow(i, h)));
      k1[i] = as_f((as_u(acc[1][i]) & 0xFFFFFF80u) | (unsigned)(1 * 32 + crow(i, h)));
      k2[i] = as_f((as_u(acc[2][i]) & 0xFFFFFF80u) | (unsigned)(2 * 32 + crow(i, h)));
      k3[i] = as_f((as_u(acc[3][i]) & 0xFFFFFF80u) | (unsigned)(3 * 32 + crow(i, h)));
    }
    sort16_desc(k0); sort16_desc(k1); top16_merge(k0, k1);
    sort16_desc(k2); sort16_desc(k3); top16_merge(k2, k3);
    top16_merge(k0, k2);
    top16_merge_partner(k0);
#pragma unroll
    for (int i = 0; i < 16; ++i) top[p][i] = k0[i];
  }
  float c0[16], c1[16];
  {
    constexpr int LE[8] = {16, 5, 3, 2, 1, 1, 1, 1}, LO[8] = {8, 4, 2, 2, 1, 1, 1, 1};
    int n1 = 0;
#pragma unroll
    for (int ii = 0; ii < 8; ++ii) {
      const float a = h ? top[0][2 * ii + 1] : top[0][2 * ii];
#pragma unroll
      for (int j = 0; j < LE[ii]; ++j) {
        const float sum = a + top[1][j];
        float key = as_f((as_u(sum) & 0xFFFFFF00u) | (unsigned)((2 * ii) * 16 + j) | ((unsigned)h << 4));
        if (j >= LO[ii]) key = h ? NINF : key;
        if (ii == 0) c0[j] = key; else c1[n1++] = key;
      }
    }
    c1[14] = NINF; c1[15] = NINF;
  }
  sort16_desc(c1);
  top16_merge(c0, c1);
  top16_merge_partner(c0);
  float ex[16], sum = 0.f;
#pragma unroll
  for (int k = 0; k < 16; ++k) { ex[k] = __expf(c0[k] - c0[0]); sum += ex[k]; }
  const float inv = 1.f / sum;
  unsigned* my = lidx[wave][lane];
#pragma unroll
  for (int q = 0; q < 4; ++q) {
    my[q] = (as_u(top[0][4 * q]) & 0x7Fu) | ((as_u(top[0][4 * q + 1]) & 0x7Fu) << 8) | ((as_u(top[0][4 * q + 2]) & 0x7Fu) << 16) | ((as_u(top[0][4 * q + 3]) & 0x7Fu) << 24);
    my[4 + q] = (as_u(top[1][4 * q]) & 0x7Fu) | ((as_u(top[1][4 * q + 1]) & 0x7Fu) << 8) | ((as_u(top[1][4 * q + 2]) & 0x7Fu) << 16) | ((as_u(top[1][4 * q + 3]) & 0x7Fu) << 24);
  }
#pragma unroll
  for (int k = 0; k < 16; ++k) {
    const unsigned code = as_u(c0[k]) & 0xFFu;
    const unsigned i = code >> 4, j = code & 15u;
    const unsigned e0 = (my[i >> 2] >> ((i & 3u) * 8u)) & 0x7Fu;
    const unsigned e1 = (my[4 + (j >> 2)] >> ((j & 3u) * 8u)) & 0x7Fu;
    if (h == 0) {
      IDX[(size_t)tok * 128 + head * 16 + k] = (int)(e0 * 128u + e1);
      GW[(size_t)tok * 128 + head * 16 + k] = ex[k] * inv;
    }
  }
}

typedef float f32x4v __attribute__((ext_vector_type(4)));
typedef float f32x2v __attribute__((ext_vector_type(2)));
typedef __bf16 bf16x32 __attribute__((ext_vector_type(32)));
constexpr float U_SCALE = 64.f, V_SCALE = 4.f;
constexpr int EROW = 768;
DI float gelu_exact(float x) { return 0.5f * x * (1.f + erff(x * 0.70710678118654752f)); }

template <bool NEXTNORM = false>
DI void peer_apply_item(int item, const bf16* __restrict__ H2, const int* __restrict__ IDX, const float* __restrict__ GW,
                        const unsigned char* __restrict__ U6, const unsigned char* __restrict__ V6,
                        float* __restrict__ x_lat, float* __restrict__ x_ctx, const float* __restrict__ modl, char* smem,
                        const float* __restrict__ gain_n = nullptr, const float* __restrict__ modl_n = nullptr, unsigned char* __restrict__ HN = nullptr) {
  bf16 (*hs)[DM] = (bf16 (*)[DM])smem;
  float (*cbuf)[128] = (float (*)[128])(smem + 4 * DM * 2);
  int tid = threadIdx.x;
  asm volatile("" : "+v"(tid));
  const int lane = tid & 63, wave = tid >> 6;
  const int token = item * 4 + wave;
  const int col16 = lane & 15, kq = lane >> 4;
  const int hh = lane >> 5, c32 = lane & 31;
  asm volatile("" ::: "memory");
  {
    const bf16* hp = H2 + (size_t)token * DM;
    *(u32x4*)(&hs[wave][8 * lane]) = *(const u32x4*)(hp + 8 * lane);
    *(u32x4*)(&hs[wave][512 + 8 * lane]) = *(const u32x4*)(hp + 512 + 8 * lane);
  }
  asm volatile("s_waitcnt lgkmcnt(0)" ::: "memory");
  __builtin_amdgcn_wave_barrier();
  const bf16* hbp = &hs[wave][64 * kq];
  const int id0 = IDX[(size_t)token * 128 + lane], id1 = IDX[(size_t)token * 128 + 64 + lane];
  const float gw0 = GW[(size_t)token * 128 + lane], gw1 = GW[(size_t)token * 128 + 64 + lane];
  {
    u32x4 wbuf[12];
    {
      const unsigned e = (unsigned)__shfl(id0, col16);
      const unsigned char* up = U6 + (e * (unsigned)EROW + 16u * (unsigned)kq);
#pragma unroll
      for (int S = 0; S < 4; ++S)
#pragma unroll
        for (int t = 0; t < 3; ++t) wbuf[3 * S + t] = *(const u32x4*)(up + 192 * S + 64 * t);
    }
    for (int g = 0; g < 8; ++g) {
      asm volatile("" ::: "memory");
      const int gn = g < 7 ? g + 1 : 7;
      const unsigned en = (unsigned)__shfl(gn < 4 ? id0 : id1, ((gn * 16) & 63) + col16);
      const unsigned char* upn = U6 + (en * (unsigned)EROW + 16u * (unsigned)kq);
      f32x4v c = {0.f, 0.f, 0.f, 0.f};
#pragma unroll
      for (int S = 0; S < 4; ++S) {
        u32x6 pk0, pk1;
        pk0[0] = wbuf[3 * S][0]; pk0[1] = wbuf[3 * S][1]; pk0[2] = wbuf[3 * S][2]; pk0[3] = wbuf[3 * S][3]; pk0[4] = wbuf[3 * S + 1][0]; pk0[5] = wbuf[3 * S + 1][1];
        pk1[0] = wbuf[3 * S + 1][2]; pk1[1] = wbuf[3 * S + 1][3]; pk1[2] = wbuf[3 * S + 2][0]; pk1[3] = wbuf[3 * S + 2][1]; pk1[4] = wbuf[3 * S + 2][2]; pk1[5] = wbuf[3 * S + 2][3];
        const bf16x32 f0 = __builtin_amdgcn_cvt_scalef32_pk32_bf16_fp6(pk0, 1.0f);
        const bf16x32 f1 = __builtin_amdgcn_cvt_scalef32_pk32_bf16_fp6(pk1, 1.0f);
        if (g < 7) {
#pragma unroll
          for (int t = 0; t < 3; ++t) wbuf[3 * S + t] = *(const u32x4*)(upn + 192 * S + 64 * t);
        }
        c = __builtin_amdgcn_mfma_f32_16x16x32_bf16(__builtin_shufflevector(f0, f0, 0, 1, 2, 3, 4, 5, 6, 7), *(const bf16x8*)(hbp + 256 * S + 0), c, 0, 0, 0);
        c = __builtin_amdgcn_mfma_f32_16x16x32_bf16(__builtin_shufflevector(f0, f0, 8, 9, 10, 11, 12, 13, 14, 15), *(const bf16x8*)(hbp + 256 * S + 8), c, 0, 0, 0);
        c = __builtin_amdgcn_mfma_f32_16x16x32_bf16(__builtin_shufflevector(f0, f0, 16, 17, 18, 19, 20, 21, 22, 23), *(const bf16x8*)(hbp + 256 * S + 16), c, 0, 0, 0);
        c = __builtin_amdgcn_mfma_f32_16x16x32_bf16(__builtin_shufflevector(f0, f0, 24, 25, 26, 27, 28, 29, 30, 31), *(const bf16x8*)(hbp + 256 * S + 24), c, 0, 0, 0);
        c = __builtin_amdgcn_mfma_f32_16x16x32_bf16(__builtin_shufflevector(f1, f1, 0, 1, 2, 3, 4, 5, 6, 7), *(const bf16x8*)(hbp + 256 * S + 32), c, 0, 0, 0);
        c = __builtin_amdgcn_mfma_f32_16x16x32_bf16(__builtin_shufflevector(f1, f1, 8, 9, 10, 11, 12, 13, 14, 15), *(const bf16x8*)(hbp + 256 * S + 40), c, 0, 0, 0);
        c = __builtin_amdgcn_mfma_f32_16x16x32_bf16(__builtin_shufflevector(f1, f1, 16, 17, 18, 19, 20, 21, 22, 23), *(const bf16x8*)(hbp + 256 * S + 48), c, 0, 0, 0);
        c = __builtin_amdgcn_mfma_f32_16x16x32_bf16(__builtin_shufflevector(f1, f1, 24, 25, 26, 27, 28, 29, 30, 31), *(const bf16x8*)(hbp + 256 * S + 56), c, 0, 0, 0);
        __builtin_amdgcn_sched_barrier(0);
      }
      *(f32x4v*)(&cbuf[wave][g * 16 + kq * 4]) = c;
    }
  }
  u32x2 vbuf[8][3];
  const unsigned voff = 8u * (unsigned)c32;
#pragma unroll
  for (int p = 0; p < 8; ++p) {
    const unsigned ea = (unsigned)__builtin_amdgcn_readlane(id0, 2 * p), eb = (unsigned)__builtin_amdgcn_readlane(id0, 2 * p + 1);
    const unsigned char* vp = V6 + ((hh ? eb : ea) * (unsigned)EROW + voff);
#pragma unroll
    for (int t = 0; t < 3; ++t) vbuf[p][t] = *(const u32x2*)(vp + 256 * t);
  }
  asm volatile("" ::: "memory");
  const float w0 = gelu_exact(cbuf[wave][lane] * (1.f / U_SCALE)) * gw0;
  const float w1 = gelu_exact(cbuf[wave][64 + lane] * (1.f / U_SCALE)) * gw1;
  f32x2v y[16];
#pragma unroll
  for (int i = 0; i < 16; ++i) y[i] = (f32x2v){0.f, 0.f};
  for (int G2 = 0; G2 < 8; ++G2) {
    const int wsel = (int)as_u(G2 < 4 ? w0 : w1);
    const int nsel = (G2 + 1) < 4 ? id0 : id1;
    const int lb = (16 * G2) & 63, lbn = (16 * (G2 + 1)) & 63;
#pragma unroll
    for (int p = 0; p < 8; ++p) {
      const float wa = as_f((unsigned)__builtin_amdgcn_readlane(wsel, lb + 2 * p));
      const float wb = as_f((unsigned)__builtin_amdgcn_readlane(wsel, lb + 2 * p + 1));
      const float ws = hh ? wb : wa;
      asm volatile("" : "+v"(vbuf[p][0]), "+v"(vbuf[p][1]), "+v"(vbuf[p][2]));
      u32x6 pk; pk[0] = vbuf[p][0][0]; pk[1] = vbuf[p][0][1]; pk[2] = vbuf[p][1][0]; pk[3] = vbuf[p][1][1]; pk[4] = vbuf[p][2][0]; pk[5] = vbuf[p][2][1];
      const f32x32v f = __builtin_amdgcn_cvt_scalef32_pk32_f32_fp6(pk, 1.0f);
      if (G2 < 7) {
        const unsigned ea = (unsigned)__builtin_amdgcn_readlane(nsel, lbn + 2 * p), eb = (unsigned)__builtin_amdgcn_readlane(nsel, lbn + 2 * p + 1);
        const unsigned char* vp = V6 + ((hh ? eb : ea) * (unsigned)EROW + voff);
#pragma unroll
        for (int t = 0; t < 3; ++t) vbuf[p][t] = *(const u32x2*)(vp + 256 * t);
      }
      const f32x2v ws2 = {ws, ws};
#pragma unroll
      for (int i = 0; i < 16; ++i) y[i] = __builtin_elementwise_fma((f32x2v){f[2 * i], f[2 * i + 1]}, ws2, y[i]);
      asm volatile("" : "+v"(y[0]), "+v"(y[1]), "+v"(y[2]), "+v"(y[3]), "+v"(y[4]), "+v"(y[5]), "+v"(y[6]), "+v"(y[7]),
                        "+v"(y[8]), "+v"(y[9]), "+v"(y[10]), "+v"(y[11]), "+v"(y[12]), "+v"(y[13]), "+v"(y[14]), "+v"(y[15]));
      __builtin_amdgcn_sched_barrier(0);
    }
  }
  float yo[16];
#pragma unroll
  for (int j = 0; j < 8; ++j) {
    const float lo0 = y[j][0] + __shfl_xor(y[j][0], 32), lo1 = y[j][1] + __shfl_xor(y[j][1], 32);
    const float hi0 = y[8 + j][0] + __shfl_xor(y[8 + j][0], 32), hi1 = y[8 + j][1] + __shfl_xor(y[8 + j][1], 32);
    yo[2 * j] = hh ? hi0 : lo0; yo[2 * j + 1] = hh ? hi1 : lo1;
  }
  float* xr; int b;
  if (token < NLAT) { xr = x_lat + (size_t)token * DM; b = token / SEQ; } else { xr = x_ctx + (size_t)(token - NLAT) * DM; b = 4; }
  const float* gate = modl + (size_t)b * 6144 + 5 * 1024;
  float xs[16];
#pragma unroll
  for (int q = 0; q < 4; ++q) {
    const int col = 32 * c32 + 16 * hh + 4 * q;
    float4 xv = *(float4*)(xr + col);
    const float4 gv = *(const float4*)(gate + col);
    xv.x += gv.x * yo[4 * q + 0] * (1.f / V_SCALE); xv.y += gv.y * yo[4 * q + 1] * (1.f / V_SCALE);
    xv.z += gv.z * yo[4 * q + 2] * (1.f / V_SCALE); xv.w += gv.w * yo[4 * q + 3] * (1.f / V_SCALE);
    *(float4*)(xr + col) = xv;
    xs[4 * q] = xv.x; xs[4 * q + 1] = xv.y; xs[4 * q + 2] = xv.z; xs[4 * q + 3] = xv.w;
  }
  if constexpr (NEXTNORM) {
    float ss = 0.f;
#pragma unroll
    for (int j = 0; j < 16; ++j) ss += xs[j] * xs[j];
    ss = wave_sum(ss);
    const float rs = rsqrtf(ss * (1.f / DM) + EPS);
    const float* shp = modl_n + (size_t)b * 6144;
    const float* scp = shp + 1024;
#pragma unroll
    for (int q = 0; q < 4; ++q) {
      const int col = 32 * c32 + 16 * hh + 4 * q;
      const float4 g = *(const float4*)(gain_n + col), sh = *(const float4*)(shp + col), sc = *(const float4*)(scp + col);
      const float y0 = xs[4 * q] * rs * g.x * (1.f + sc.x) + sh.x, y1 = xs[4 * q + 1] * rs * g.y * (1.f + sc.y) + sh.y;
      const float y2 = xs[4 * q + 2] * rs * g.z * (1.f + sc.z) + sh.z, y3 = xs[4 * q + 3] * rs * g.w * (1.f + sc.w) + sh.w;
      int w = 0;
      w = __builtin_amdgcn_cvt_pk_fp8_f32(y0, y1, w, false); w = __builtin_amdgcn_cvt_pk_fp8_f32(y2, y3, w, true);
      *(int*)(HN + (size_t)token * DM + col) = w;
    }
  }
}

DI void mla_post1_item(int item, bf16* __restrict__ P1, const float* __restrict__ qan, const float* __restrict__ kvan,
                       const float* __restrict__ krn, const float* __restrict__ cs, const float* __restrict__ sn,
                       bf16* __restrict__ KPE, unsigned char* __restrict__ P8) {
  const int lane = threadIdx.x & 63, wave = threadIdx.x >> 6;
  const int row = item * 4 + wave;
  bf16* pr = P1 + (size_t)row * 768;
  const bool act1 = lane < 24;
  const bf16x8 va = *(const bf16x8*)(pr + 8 * lane);
  bf16x8 vb;
#pragma unroll
  for (int j = 0; j < 8; ++j) vb[j] = (bf16)0.f;
  if (act1) vb = *(const bf16x8*)(pr + 512 + 8 * lane);
  float a[8], c[8];
  float sa = 0.f, sb = 0.f;
#pragma unroll
  for (int j = 0; j < 8; ++j) { a[j] = (float)va[j]; c[j] = (float)vb[j]; sa += a[j] * a[j]; sb += c[j] * c[j]; }
  const float ss_q = wave_sum(lane < 48 ? sa : 0.f);
  const float ss_kv = wave_sum((lane >= 48 ? sa : 0.f) + (lane < 16 ? sb : 0.f));
  const float ss_kr = wave_sum((lane >= 16 && lane < 24) ? sb : 0.f);
  {
    const float rs = lane < 48 ? rsqrtf(ss_q * (1.f / 384.f) + EPS) : rsqrtf(ss_kv * (1.f / 256.f) + EPS);
    const float* g = lane < 48 ? qan + 8 * lane : kvan + 8 * (lane - 48);
    const float4 g0 = *(const float4*)g, g1 = *(const float4*)(g + 4);
    const float y[8] = {a[0] * rs * g0.x, a[1] * rs * g0.y, a[2] * rs * g0.z, a[3] * rs * g0.w, a[4] * rs * g1.x, a[5] * rs * g1.y, a[6] * rs * g1.z, a[7] * rs * g1.w};
    *(u32x2g*)(P8 + (size_t)row * 640 + 8 * lane) = pack8_fp8(y);
  }
  if (lane < 16) {
    const float rs = rsqrtf(ss_kv * (1.f / 256.f) + EPS);
    const float* g = kvan + 128 + 8 * lane;
    const float4 g0 = *(const float4*)g, g1 = *(const float4*)(g + 4);
    const float y[8] = {c[0] * rs * g0.x, c[1] * rs * g0.y, c[2] * rs * g0.z, c[3] * rs * g0.w, c[4] * rs * g1.x, c[5] * rs * g1.y, c[6] * rs * g1.z, c[7] * rs * g1.w};
    *(u32x2g*)(P8 + (size_t)row * 640 + 512 + 8 * lane) = pack8_fp8(y);
  } else if (lane < 24) {
    const int c8 = lane - 16;
    const float rs = rsqrtf(ss_kr * (1.f / 64.f) + EPS);
    const float4 g0 = *(const float4*)(krn + 8 * c8), g1 = *(const float4*)(krn + 8 * c8 + 4);
    float y[8] = {c[0] * rs * g0.x, c[1] * rs * g0.y, c[2] * rs * g0.z, c[3] * rs * g0.w, c[4] * rs * g1.x, c[5] * rs * g1.y, c[6] * rs * g1.z, c[7] * rs * g1.w};
    int orow;
    if (row < NLAT) {
      const int b = row / SEQ, t = row % SEQ;
      const float4 cs4 = *(const float4*)(cs + t * 32 + c8 * 4), sn4 = *(const float4*)(sn + t * 32 + c8 * 4);
      float o0;
      o0 = y[0] * cs4.x - y[1] * sn4.x; y[1] = y[0] * sn4.x + y[1] * cs4.x; y[0] = o0;
      o0 = y[2] * cs4.y - y[3] * sn4.y; y[3] = y[2] * sn4.y + y[3] * cs4.y; y[2] = o0;
      o0 = y[4] * cs4.z - y[5] * sn4.z; y[5] = y[4] * sn4.z + y[5] * cs4.z; y[4] = o0;
      o0 = y[6] * cs4.w - y[7] * sn4.w; y[7] = y[6] * sn4.w + y[7] * cs4.w; y[6] = o0;
      orow = b * NKEY + NCX + t;
    } else {
      const int rc = row - NLAT;
      orow = (rc / NCX) * NKEY + (rc % NCX);
    }
    *(u32x2g*)((unsigned char*)KPE + (size_t)orow * 64 + 8 * c8) = pack8_fp8(y);
  }
}

DI void mla_qpost_item(int item, bf16* __restrict__ Q, const float* __restrict__ qnn, const float* __restrict__ qnr,
                       const float* __restrict__ cs, const float* __restrict__ sn) {
  const int lane = threadIdx.x & 63, wave = threadIdx.x >> 6;
  const int row = item * 4 + wave;
  const int t = row % SEQ;
  bf16* qr = Q + (size_t)row * 1536;
#pragma unroll
  for (int k = 0; k < 2; ++k) {
    const int head = (lane >> 4) + 4 * k, pos = lane & 15;
    bf16* qp = qr + head * 192 + pos * 8;
    const bf16x8 nv = *(const bf16x8*)qp;
    float v[8]; float ss = 0.f;
#pragma unroll
    for (int j = 0; j < 8; ++j) { v[j] = (float)nv[j]; ss += v[j] * v[j]; }
    ss += __shfl_xor(ss, 8); ss += __shfl_xor(ss, 4); ss += __shfl_xor(ss, 2); ss += __shfl_xor(ss, 1);
    const float rs = rsqrtf(ss * (1.f / 128.f) + EPS);
    const float4 g0 = *(const float4*)(qnn + pos * 8), g1 = *(const float4*)(qnn + pos * 8 + 4);
    bf16x8 ov;
    ov[0] = (bf16)(v[0] * rs * g0.x); ov[1] = (bf16)(v[1] * rs * g0.y); ov[2] = (bf16)(v[2] * rs * g0.z); ov[3] = (bf16)(v[3] * rs * g0.w);
    ov[4] = (bf16)(v[4] * rs * g1.x); ov[5] = (bf16)(v[5] * rs * g1.y); ov[6] = (bf16)(v[6] * rs * g1.z); ov[7] = (bf16)(v[7] * rs * g1.w);
    *(bf16x8*)qp = ov;
  }
  {
    const int head = lane >> 3, c8 = lane & 7;
    bf16* qp = qr + head * 192 + 128 + c8 * 8;
    const bf16x8 pv = *(const bf16x8*)qp;
    float y[8]; float ss = 0.f;
#pragma unroll
    for (int j = 0; j < 8; ++j) { y[j] = (float)pv[j]; ss += y[j] * y[j]; }
    ss += __shfl_xor(ss, 4); ss += __shfl_xor(ss, 2); ss += __shfl_xor(ss, 1);
    const float rs = rsqrtf(ss * (1.f / 64.f) + EPS);
    const float4 g0 = *(const float4*)(qnr + c8 * 8), g1 = *(const float4*)(qnr + c8 * 8 + 4);
    y[0] *= rs * g0.x; y[1] *= rs * g0.y; y[2] *= rs * g0.z; y[3] *= rs * g0.w; y[4] *= rs * g1.x; y[5] *= rs * g1.y; y[6] *= rs * g1.z; y[7] *= rs * g1.w;
    const float4 cs4 = *(const float4*)(cs + t * 32 + c8 * 4), sn4 = *(const float4*)(sn + t * 32 + c8 * 4);
    float o0;
    o0 = y[0] * cs4.x - y[1] * sn4.x; y[1] = y[0] * sn4.x + y[1] * cs4.x; y[0] = o0;
    o0 = y[2] * cs4.y - y[3] * sn4.y; y[3] = y[2] * sn4.y + y[3] * cs4.y; y[2] = o0;
    o0 = y[4] * cs4.z - y[5] * sn4.z; y[5] = y[4] * sn4.z + y[5] * cs4.z; y[4] = o0;
    o0 = y[6] * cs4.w - y[7] * sn4.w; y[7] = y[6] * sn4.w + y[7] * cs4.w; y[6] = o0;
    bf16x8 ov;
#pragma unroll
    for (int j = 0; j < 8; ++j) ov[j] = (bf16)y[j];
    *(bf16x8*)qp = ov;
  }
}

DI void mla_kpost_item(int item, bf16* __restrict__ KV, const float* __restrict__ knn) {
  const int lane = threadIdx.x & 63, wave = threadIdx.x >> 6;
  const int row = item * 4 + wave;
#pragma unroll
  for (int k = 0; k < 2; ++k) {
    const int head = (lane >> 4) + 4 * k, pos = lane & 15;
    bf16* kp = KV + (size_t)row * 2048 + head * 256 + pos * 8;
    const bf16x8 nv = *(const bf16x8*)kp;
    float v[8]; float ss = 0.f;
#pragma unroll
    for (int j = 0; j < 8; ++j) { v[j] = (float)nv[j]; ss += v[j] * v[j]; }
    ss += __shfl_xor(ss, 8); ss += __shfl_xor(ss, 4); ss += __shfl_xor(ss, 2); ss += __shfl_xor(ss, 1);
    const float rs = rsqrtf(ss * (1.f / 128.f) + EPS);
    const float4 g0 = *(const float4*)(knn + pos * 8), g1 = *(const float4*)(knn + pos * 8 + 4);
    bf16x8 ov;
    ov[0] = (bf16)(v[0] * rs * g0.x); ov[1] = (bf16)(v[1] * rs * g0.y); ov[2] = (bf16)(v[2] * rs * g0.z); ov[3] = (bf16)(v[3] * rs * g0.w);
    ov[4] = (bf16)(v[4] * rs * g1.x); ov[5] = (bf16)(v[5] * rs * g1.y); ov[6] = (bf16)(v[6] * rs * g1.z); ov[7] = (bf16)(v[7] * rs * g1.w);
    *(bf16x8*)kp = ov;
  }
}

struct MegaParams {
  const float *x, *c, *ctx, *c_ctx, *mod_w, *mod_b, *mix_norm, *ffn_norm, *even_w_in, *even_w_out, *a_q_norm, *a_k_norm, *b_q_norm,
      *b_k_norm, *b_sink, *mla_w_in, *mla_q_a_norm, *mla_kv_a_norm, *mla_w_uq, *mla_w_ukv, *mla_q_nope_norm, *mla_q_rope_norm,
      *mla_k_nope_norm, *mla_k_rope_norm, *mla_w_out, *peer_w_query, *peer_sub_keys, *peer_u, *peer_v;
  float* out;
  unsigned* bar;
  float *MOD, *RCS, *RSN, *CTXS;
  bf16 *W_EIN, *W_EOUT, *W_PQ, *W_MIN, *W_UQ, *W_UKV, *W_MOUT, *SKB, *HA, *HB;
  unsigned char *U6, *V6;
  int* IDX;
  float* GW;
  char* R;
};

DI unsigned long long uptr64(const LAS unsigned long long* slot) {
  const unsigned long long v = *slot;
  const unsigned lo = __builtin_amdgcn_readfirstlane((unsigned)v), hi = __builtin_amdgcn_readfirstlane((unsigned)(v >> 32));
  return ((unsigned long long)hi << 32) | lo;
}
template <class T> DI T* as_global(T*, unsigned long long v) { return (T*)(__attribute__((address_space(1))) T*)v; }
#define LP(f) as_global((decltype(sp.f))nullptr, uptr64((const LAS unsigned long long*)&sp.f))

#define rP0 ((bf16*)Rb)
#define rQA ((bf16*)(Rb + (size_t)NTOK * 1536 * 2))
#define rQB (rQA + (size_t)NB * 8 * SEQ * 64)
#define rCQA (rQB + (size_t)NB * 8 * SEQ * 64)
#define rCQB (rCQA + (size_t)NB * 8 * NCX * 64)
#define rKA (rCQB + (size_t)NB * 8 * NCX * 64)
#define rVA (rKA + (size_t)NB * 2 * NKEY * 64)
#define rKB (rVA + (size_t)NB * 2 * NKEY * 64)
#define rVB (rKB + (size_t)NB * 2 * NKEY * 64)
#define rQP ((bf16*)Rb)
#define rKPE ((bf16*)Rb)
#define rQRAW (rKPE + (size_t)NB * NKEY * 64)
#define rKVRAW ((bf16*)((char*)rQRAW + (size_t)NLAT * 1536))
#define rK8 ((unsigned char*)rQRAW + (size_t)NLAT * 1536)
#define rV8T (rK8 + (size_t)NB * NKEY * 1024)

__global__ __launch_bounds__(256, 2) void mega_kernel(MegaParams kp) {
  __shared__ __attribute__((aligned(16))) char lds_all[SMEM_BYTES + 16 + ((sizeof(MegaParams) + 15) / 16) * 16];
  char* const smem = lds_all;
  uint4& xb_words = *(uint4*)(lds_all + SMEM_BYTES);
  MegaParams& sp = *(MegaParams*)(lds_all + SMEM_BYTES + 16);
  if (threadIdx.x == 0) { xb_words = make_uint4(0u, 0u, 0u, 0u); sp = kp; }
  __syncthreads();
  XcdBarrier bar = xcd_barrier_post(LP(bar), (volatile LAS unsigned*)&xb_words);
  const int G = gridDim.x, bid = blockIdx.x;

  {
    const float *c = LP(c), *c_ctx = LP(c_ctx), *mod_w = LP(mod_w), *mod_b = LP(mod_b); float* MOD = LP(MOD);
    for (int item = bid; item < 192; item += G) mod_item(item, c, c_ctx, mod_w, mod_b, MOD, smem);
  }
  rope_phase(LP(RCS), LP(RSN));
  transpose_phase<false, true>(LP(even_w_in), LP(W_EIN), 1024, 1536, 1536, smem);
  transpose_phase<false, true>(LP(even_w_out), LP(W_EOUT), 1024, 1024, 1024, smem);
  transpose_phase(LP(peer_w_query), LP(W_PQ), 1024, 2048, 2048, smem);
  transpose_phase(LP(peer_w_query) + (size_t)1024 * 2048, LP(W_PQ) + (size_t)2048 * 1024, 1024, 2048, 2048, smem);
  transpose_phase<false, true>(LP(mla_w_in), LP(W_MIN), 1024, 704, 768, smem);
  transpose_phase<true, true>(LP(mla_w_uq), LP(W_UQ), 384, 1536, 1536, smem);
  transpose_phase<false, true>(LP(mla_w_ukv), LP(W_UKV), 256, 2048, 2048, smem);
  transpose_phase<false, true>(LP(mla_w_out), LP(W_MOUT), 1024, 1024, 1024, smem);
  convert_phase((const float4*)LP(peer_sub_keys), (bf16x4*)LP(SKB), (size_t)2 * 16 * 128 * 128 / 4);
  convert_fp6_phase<false>(LP(peer_u), LP(U6), (size_t)2 * 16384 * 32, U_SCALE);
  convert_fp6_phase<true>(LP(peer_v), LP(V6), (size_t)2 * 16384 * 32, V_SCALE);
  xcd_barrier(bar);

  {
    const float *x = LP(x), *ctx = LP(ctx), *g = LP(mix_norm), *M = LP(MOD); bf16* H = LP(HA);
    for (int it = bid; it < NTOK / 4; it += G) norm_mod_item<true>(it, x, ctx, g, M, 0, H);
  }
  xcd_barrier(bar);
  {
    char* const Rb = LP(R);
    GemmEpi e{}; e.n0g = LP(a_q_norm); e.n1g = LP(a_k_norm); e.n2g = LP(b_q_norm); e.n3g = LP(b_k_norm); e.cs = LP(RCS); e.sn = LP(RSN);
    e.QA = rQA; e.QB = rQB; e.CQA = rCQA; e.CQB = rCQB; e.KA = rKA; e.VA = rVA; e.KB = rKB; e.VB = rVB;
    e.V8T = (unsigned char*)rQA + ((size_t)96 << 20);
    gemm_phase<EPI_QKV0, true>(LP(HA), 512, LP(W_EIN), 512, e, NTOK, 1536, smem);
  }
  xcd_barrier(bar);
  {
    char* const Rb = LP(R);
    bf16* const HBp = LP(HB);
    const float* const sinkp = LP(b_sink);
    const int xcd = bid & 7, nj = G >> 3;
    const int b = xcd >> 1, hkv = xcd & 1;
    for (int t = bid >> 3; t < 528; t += nj) {
      AttnParams a{};
      const bool isC = t >= 512;
      const bool isB = isC ? (t >= 520) : (t >= 256);
      a.q_ts = 64; a.k_ts = 64; a.v_ts = 64; a.G = 4; a.scale_log2 = 0.125f * LOG2E;
#define R8(X) ((const bf16*)((const unsigned char*)rQA + ((X) - rQA)))
      a.K = isB ? R8(rKB) : R8(rKA); a.V = nullptr;
      a.V8 = (const unsigned char*)rQA + ((size_t)96 << 20) + (isB ? (size_t)NB * 2 * (NKEY / 64) * 64 * 64 : 0);
      a.v8_bs = (long)2 * (NKEY / 64) * 64 * 64; a.v8_hs = (long)(NKEY / 64) * 64 * 64;
      a.k_bs = (long)2 * NKEY * 64; a.k_hs = (long)NKEY * 64; a.v_bs = a.k_bs; a.v_hs = a.k_hs;
      a.O = HBp; a.o_col0 = isB ? 512 : 0; a.sink = isB ? sinkp : nullptr;
      int qblk, head;
      if (!isC) {
        const int li = t & 255;
        qblk = li & 63; head = hkv * 4 + (li >> 6);
        a.Q = isB ? R8(rQB) : R8(rQA); a.q_bs = (long)8 * SEQ * 64; a.q_hs = (long)SEQ * 64;
        a.o_row0 = 0; a.o_bs = SEQ; a.nkeys = NKEY;
      } else {
        const int li = (t - 512) & 7;
        qblk = li & 1; head = hkv * 4 + (li >> 1);
        a.Q = isB ? R8(rCQB) : R8(rCQA); a.q_bs = (long)8 * NCX * 64; a.q_hs = (long)NCX * 64;
        a.o_row0 = NLAT; a.o_bs = NCX; a.nkeys = NCX;
      }
      if (isB && !isC) attn_item<64, 64, 64, 2, true, true>(a, qblk, head, b, smem);
      else attn_item<64, 64, 64, 2, false, true>(a, qblk, head, b, smem);
#undef R8
    }
  }
  xcd_barrier(bar);
  {
    GemmEpi e{}; e.out_lat = LP(out); e.res_lat = LP(x); e.out_ctx = LP(CTXS); e.res_ctx = LP(ctx); e.modl = LP(MOD); e.gchunk = 2;
    gemm_phase<EPI_RESID, true>(LP(HB), 512, LP(W_EOUT), 512, e, NTOK, 1024, smem);
  }
  xcd_barrier(bar);
  {
    const float *x = LP(out), *ctx = LP(CTXS), *g = LP(ffn_norm), *M = LP(MOD); bf16* H = LP(HA);
    for (int it = bid; it < NTOK / 4; it += G) norm_mod_item(it, x, ctx, g, M, 3, H);
  }
  xcd_barrier(bar);
  {
    char* const Rb = LP(R);
    GemmEpi e{}; e.Cb = rQP; e.ldc = 2048;
    gemm_phase<EPI_BF16>(LP(HA), 1024, LP(W_PQ), 1024, e, NTOK, 2048, smem);
  }
  xcd_barrier(bar);
  {
    char* const Rb = LP(R);
    const bf16* QPp = rQP; const bf16* SK = LP(SKB); int* IDX = LP(IDX); float* GW = LP(GW);
    for (int item = bid; item < (NTOK / 32) * 2; item += G) peer_select_item(item >> 1, item & 1, QPp, SK, IDX, GW, smem);
  }
  xcd_barrier(bar);
  {
    const bf16* H = LP(HA); const int* IDX = LP(IDX); const float* GW = LP(GW); const unsigned char *U8 = LP(U6), *V8 = LP(V6);
    float *xo = LP(out), *xc = LP(CTXS); const float* M = LP(MOD);
    const float* gn = LP(mix_norm) + 1024; const float* Mn = LP(MOD) + 5 * 6144; unsigned char* HN = (unsigned char*)LP(HB);
    for (int item = bid; item < NTOK / 4; item += G) peer_apply_item<true>(item, H, IDX, GW, U8, V8, xo, xc, M, smem, gn, Mn, HN);
  }
  xcd_barrier(bar);

  {
    GemmEpi e{}; e.Cb = LP(HA); e.ldc = 768;
    gemm_phase<EPI_BF16, true>(LP(HB), 512, LP(W_MIN), 512, e, NTOK, 768, smem);
  }
  xcd_barrier(bar);
  {
    char* const Rb = LP(R);
    bf16* P1 = LP(HA); const float *qa = LP(mla_q_a_norm), *kva = LP(mla_kv_a_norm), *krn = LP(mla_k_rope_norm), *cs = LP(RCS), *sn = LP(RSN);
    bf16* KPEp = rKPE;
    unsigned char* P8 = (unsigned char*)Rb + ((size_t)200 << 20);
    for (int it = bid; it < NTOK / 4; it += G) mla_post1_item(it, P1, qa, kva, krn, cs, sn, KPEp, P8);
  }
  xcd_barrier(bar);
  {
    char* const Rb = LP(R);
    GemmEpi e{}; e.C8 = (unsigned char*)rQRAW; e.ldc = 1536; e.n0g = LP(mla_q_nope_norm); e.n1g = LP(mla_q_rope_norm); e.cs = LP(RCS); e.sn = LP(RSN);
    const bf16* P8 = (const bf16*)((unsigned char*)Rb + ((size_t)200 << 20));
    gemm_phase<EPI_MLAQ, true>(P8, 320, LP(W_UQ), 192, e, NLAT, 1536, smem);
    GemmEpi e2{}; e2.C8 = rK8; e2.V8T = rV8T; e2.ldc = 2048; e2.n0g = LP(mla_k_nope_norm);
    gemm_phase<EPI_MLAKV, true>(P8 + 192, 320, LP(W_UKV), 128, e2, NTOK, 2048, smem);
  }
  xcd_barrier(bar);
  {
    char* const Rb = LP(R);
    AttnParams a{}; a.Q = rQRAW; a.q_bs = (long)SEQ * 1536; a.q_hs = 128; a.q_ts = 1536; a.q2_off = 1024; a.q2_hs = 64;
    a.K = (const bf16*)rK8; a.k_bs = (long)NKEY * 1024; a.k_hs = 128; a.k_ts = 1024;
    a.K2 = rKPE; a.k2_bs = (long)NKEY * 64; a.k2_ts = 64;
    a.V = nullptr; a.V8 = rV8T; a.v8_bs = (long)8 * (NKEY / 64) * 128 * 64; a.v8_hs = (long)(NKEY / 64) * 128 * 64;
    a.O = LP(HA); a.o_row0 = 0; a.o_bs = SEQ; a.o_col0 = 0; a.sink = nullptr; a.nkeys = NKEY; a.G = 1; a.window = 0;
    a.scale_log2 = 0.07216878364870322f * LOG2E;
    const int xcd = bid & 7, nj = G >> 3;
    for (int t = bid >> 3; t < 256; t += nj) {
      const int bh = (t >> 6) * 8 + xcd;
      attn_item<192, 128, 128, 2, false, true>(a, t & 63, bh & 7, bh >> 3, smem);
    }
  }
  xcd_barrier(bar);
  {
    GemmEpi e{}; e.out_lat = LP(out); e.res_lat = LP(out); e.out_ctx = LP(CTXS); e.res_ctx = LP(CTXS); e.modl = LP(MOD) + 5 * 6144; e.gchunk = 2;
    gemm_phase<EPI_RESID, true>(LP(HA), 512, LP(W_MOUT), 512, e, NLAT, 1024, smem);
  }
  xcd_barrier(bar);
  {
    const float *x = LP(out), *ctx = LP(CTXS), *g = LP(ffn_norm) + 1024, *M = LP(MOD) + 5 * 6144; bf16* H = LP(HB);
    for (int it = bid; it < NLAT / 4; it += G) norm_mod_item(it, x, ctx, g, M, 3, H);
  }
  xcd_barrier(bar);
  {
    char* const Rb = LP(R);
    GemmEpi e{}; e.Cb = rQP; e.ldc = 2048;
    gemm_phase<EPI_BF16>(LP(HB), 1024, LP(W_PQ) + (size_t)2048 * 1024, 1024, e, NLAT, 2048, smem);
  }
  xcd_barrier(bar);
  {
    char* const Rb = LP(R);
    const bf16* QPp = rQP; const bf16* SK = LP(SKB) + (size_t)16 * 128 * 128; int* IDX = LP(IDX); float* GW = LP(GW);
    for (int item = bid; item < (NLAT / 32) * 2; item += G) peer_select_item(item >> 1, item & 1, QPp, SK, IDX, GW, smem);
  }
  xcd_barrier(bar);
  {
    const bf16* H = LP(HB); const int* IDX = LP(IDX); const float* GW = LP(GW);
    const unsigned char *U8 = LP(U6) + (size_t)16384 * EROW, *V8 = LP(V6) + (size_t)16384 * EROW;
    float *xo = LP(out), *xc = LP(CTXS); const float* M = LP(MOD) + 5 * 6144;
    for (int item = bid; item < NLAT / 4; item += G) peer_apply_item(item, H, IDX, GW, U8, V8, xo, xc, M, smem);
  }
}

static inline size_t align_up(size_t v, size_t a) { return (v + a - 1) / a * a; }

extern "C" void kernel_launch(void* const* d_in, const int* in_sizes, int n_in,
                              void* d_out, int out_size, void* d_ws, size_t ws_size,
                              hipStream_t stream) {
  MegaParams p{};
  const float** fp = (const float**)&p;
  for (int i = 0; i < 29; ++i) fp[i] = (const float*)d_in[i];
  p.out = (float*)d_out;
  char* w = (char*)d_ws;
  size_t off = 0;
  auto take = [&](size_t bytes) { char* q = w + off; off = align_up(off + bytes, 256); return q; };
  p.bar = (unsigned*)take(XCD_BAR_WORDS * 4);
  p.MOD = (float*)take(2 * 5 * 6144 * 4);
  p.RCS = (float*)take((size_t)SEQ * 32 * 4);
  p.RSN = (float*)take((size_t)SEQ * 32 * 4);
  p.CTXS = (float*)take((size_t)NCTXT * DM * 4);
  p.W_EIN = (bf16*)take((size_t)1536 * 1024 * 2);
  p.W_EOUT = (bf16*)take((size_t)1024 * 1024 * 2);
  p.W_PQ = (bf16*)take((size_t)2 * 2048 * 1024 * 2);
  p.W_MIN = (bf16*)take((size_t)768 * 1024 * 2);
  p.W_UQ = (bf16*)take((size_t)1536 * 384 * 2);
  p.W_UKV = (bf16*)take((size_t)2048 * 256 * 2);
  p.W_MOUT = (bf16*)take((size_t)1024 * 1024 * 2);
  p.SKB = (bf16*)take((size_t)2 * 16 * 128 * 128 * 2);
  p.HA = (bf16*)take((size_t)NTOK * DM * 2);
  p.HB = (bf16*)take((size_t)NTOK * DM * 2);
  p.U6 = (unsigned char*)take((size_t)2 * 16384 * EROW);
  p.V6 = (unsigned char*)take((size_t)2 * 16384 * EROW);
  p.IDX = (int*)take((size_t)NTOK * 128 * 4);
  p.GW = (float*)take((size_t)NTOK * 128 * 4);
  p.R = take((size_t)250 * 1024 * 1024);

  static int grid = 0;
  if (!grid) {
    int dev = 0, cus = 0, per_cu = 0;
    hipGetDevice(&dev);
    hipDeviceGetAttribute(&cus, hipDeviceAttributeMultiprocessorCount, dev);
    hipOccupancyMaxActiveBlocksPerMultiprocessor(&per_cu, mega_kernel, 256, 0);
    if (per_cu > 2) per_cu = 2;
    if (per_cu < 1) per_cu = 1;
    grid = cus * per_cu;
  }
  hipMemsetAsync(p.bar, 0, XCD_BAR_WORDS * 4, stream);
  mega_kernel<<<grid, 256, 0, stream>>>(p);
}
```

```cpp
#include <hip/hip_runtime.h>
#include <stdint.h>

typedef __bf16 bf16;
typedef __bf16 bf16x8 __attribute__((ext_vector_type(8)));
typedef __bf16 bf16x4 __attribute__((ext_vector_type(4)));
typedef __bf16 bf16x2 __attribute__((ext_vector_type(2)));
typedef float f32x16 __attribute__((ext_vector_type(16)));
typedef unsigned u32x4 __attribute__((ext_vector_type(4)));
typedef unsigned u32x2g __attribute__((ext_vector_type(2)));
typedef int i32x8 __attribute__((ext_vector_type(8)));
#define LAS __attribute__((address_space(3)))
#define DI __device__ __forceinline__

constexpr int DM = 1024, NB = 4, SEQ = 8192, NCX = 256;
constexpr int NLAT = NB * SEQ, NCTXT = NB * NCX, NTOK = NLAT + NCTXT, NKEY = SEQ + NCX;
constexpr float EPS = 1e-6f;
constexpr float LOG2E = 1.4426950408889634f;

DI int crow(int i, int h) { return (i & 3) + 8 * (i >> 2) + 4 * h; }
DI const unsigned char* uni_ptr(const void* p) {
  const unsigned long long v = (unsigned long long)p;
  const unsigned lo = (unsigned)__builtin_amdgcn_readfirstlane((int)(unsigned)v), hi = (unsigned)__builtin_amdgcn_readfirstlane((int)(unsigned)(v >> 32));
  return (const unsigned char*)(((unsigned long long)hi << 32) | lo);
}
DI f32x16 mfma32(bf16x8 a, bf16x8 b, f32x16 c) { return __builtin_amdgcn_mfma_f32_32x32x16_bf16(a, b, c, 0, 0, 0); }
DI float silu(float v) { return v / (1.f + __expf(-v)); }
DI u32x2g pack8_fp8(const float (&v)[8]) {
  int w0 = 0, w1 = 0;
  w0 = __builtin_amdgcn_cvt_pk_fp8_f32(v[0], v[1], w0, false); w0 = __builtin_amdgcn_cvt_pk_fp8_f32(v[2], v[3], w0, true);
  w1 = __builtin_amdgcn_cvt_pk_fp8_f32(v[4], v[5], w1, false); w1 = __builtin_amdgcn_cvt_pk_fp8_f32(v[6], v[7], w1, true);
  u32x2g r; r[0] = (unsigned)w0; r[1] = (unsigned)w1; return r;
}


#define XB_TMO      128
#define XB_XCNT(j)  (256  + 64 * (j))
#define XB_XSUB(j)  (1280 + 64 * (j))
#define XB_XGEN(j)  (2304 + 64 * (j))
#define XB_TOP      3328
#define XB_TOPGEN   3392
#define XCD_BAR_WORDS 3456
#define XB_SPIN_CAP (1u << 18)

__device__ __forceinline__ unsigned xb_ld(unsigned* p)              { return __hip_atomic_load(p, __ATOMIC_RELAXED, __HIP_MEMORY_SCOPE_AGENT); }
__device__ __forceinline__ unsigned xb_add(unsigned* p, unsigned v) { return __hip_atomic_fetch_add(p, v, __ATOMIC_RELAXED, __HIP_MEMORY_SCOPE_AGENT); }
__device__ __forceinline__ unsigned xb_xcc_id() { return (unsigned)__builtin_amdgcn_s_getreg((3 << 11) | 20) & 0xFu; }
#define XB_SPIN(cond, bar) do { unsigned _sp = 0; while (cond) { __builtin_amdgcn_s_sleep(1); \
    if ((++_sp & 255u) == 0u) { if (xb_ld(&(bar)[XB_TMO])) break; if (_sp > XB_SPIN_CAP) { atomicAdd(&(bar)[XB_TMO], 1u); break; } } } } while (0)

struct XcdBarrier { unsigned* bar; unsigned x; volatile LAS unsigned* st; };

__device__ __forceinline__ XcdBarrier xcd_barrier_post(unsigned* bar, volatile LAS unsigned* st) {
    XcdBarrier b; b.bar = bar; b.x = xb_xcc_id(); b.st = st;
    if (threadIdx.x == 0) (void)xb_add(&bar[XB_XCNT(b.x)], 1u);
    return b;
}
__device__ __forceinline__ void xcd_barrier_complete(unsigned* bar, unsigned x, unsigned& nloc, unsigned& nx) {
    const unsigned G = gridDim.x * gridDim.y * gridDim.z;
    unsigned sum, cnt, mine, sp = 0u;
    for (;;) {
        sum = 0u; cnt = 0u; mine = 0u;
#pragma unroll
        for (unsigned j = 0; j < 16; ++j) { const unsigned c = xb_ld(&bar[XB_XCNT(j)]); sum += c; cnt += (c > 0u) ? 1u : 0u; mine = (j == x) ? c : mine; }
        if (sum == G) break;
        __builtin_amdgcn_s_sleep(1);
        if ((++sp & 255u) == 0u) { if (xb_ld(&bar[XB_TMO])) break; if (sp > XB_SPIN_CAP) { atomicAdd(&bar[XB_TMO], 1u); break; } }
    }
    nloc = mine > 0u ? mine : 1u; nx = cnt > 0u ? cnt : 1u;
}
__device__ __forceinline__ void xcd_barrier(const XcdBarrier& b) {
    asm volatile("s_waitcnt vmcnt(0)" ::: "memory");
    __syncthreads();
    if (threadIdx.x == 0) {
        unsigned* bar = b.bar;
        __builtin_amdgcn_s_waitcnt(0);
        unsigned nloc = b.st[0], nx = b.st[1];
        if (nloc == 0u) { xcd_barrier_complete(bar, b.x, nloc, nx); b.st[0] = nloc; b.st[1] = nx; }
        const unsigned old = xb_add(&bar[XB_XSUB(b.x)], 1u);
        const unsigned gen = old / nloc;
        if (old + 1u == (gen + 1u) * nloc) {
            __builtin_amdgcn_fence(__ATOMIC_RELEASE, "agent");
            asm volatile("s_waitcnt vmcnt(0)" ::: "memory");
            const unsigned og = xb_add(&bar[XB_TOP], 1u);
            const unsigned tg = og / nx;
            if (og + 1u == (tg + 1u) * nx) xb_add(&bar[XB_TOPGEN], 1u);
            else XB_SPIN(xb_ld(&bar[XB_TOPGEN]) == tg, bar);
            __builtin_amdgcn_fence(__ATOMIC_ACQUIRE, "agent");
            xb_add(&bar[XB_XGEN(b.x)], 1u);
            asm volatile("s_waitcnt vmcnt(0)" ::: "memory");
        } else {
            XB_SPIN(xb_ld(&bar[XB_XGEN(b.x)]) == gen, bar);
            __builtin_amdgcn_fence(__ATOMIC_ACQUIRE, "agent");
            asm volatile("s_waitcnt vmcnt(0)" ::: "memory");
        }
    }
    __syncthreads();
}

constexpr int SMEM_BYTES = 73728;

DI void mod_item(int item, const float* __restrict__ c, const float* __restrict__ c_ctx, const float* __restrict__ mod_w,
                 const float* __restrict__ mod_b, float* __restrict__ mod, char* smem) {
  float (*sv)[1024] = (float (*)[1024])smem;
  float (*part)[5][32] = (float (*)[5][32])(smem + 5 * 1024 * 4);
  const int tid = threadIdx.x, l = item / 192, bx = item % 192;
  for (int i = tid; i < 5 * 1024; i += 256) {
    const int b = i >> 10, k = i & 1023;
    const float v = b < 4 ? c[b * 1024 + k] : c_ctx[k];
    sv[b][k] = silu(v);
  }
  __syncthreads();
  const int nn = tid & 31, kg = tid >> 5;
  const int n = bx * 32 + nn;
  const float* w = mod_w + (size_t)l * 1024 * 6144 + n;
  float a0 = 0, a1 = 0, a2 = 0, a3 = 0, a4 = 0;
#pragma unroll 8
  for (int k = kg * 128; k < kg * 128 + 128; ++k) {
    const float wv = w[(size_t)k * 6144];
    a0 += sv[0][k] * wv; a1 += sv[1][k] * wv; a2 += sv[2][k] * wv; a3 += sv[3][k] * wv; a4 += sv[4][k] * wv;
  }
  part[kg][0][nn] = a0; part[kg][1][nn] = a1; part[kg][2][nn] = a2; part[kg][3][nn] = a3; part[kg][4][nn] = a4;
  __syncthreads();
  if (tid < 5 * 32) {
    const int b = tid >> 5, j = tid & 31;
    float sacc = 0.f;
#pragma unroll
    for (int g = 0; g < 8; ++g) sacc += part[g][b][j];
    mod[((size_t)l * 5 + b) * 6144 + bx * 32 + j] = sacc + mod_b[(size_t)l * 6144 + bx * 32 + j];
  }
  __syncthreads();
}

DI void rope_phase(float* __restrict__ cs, float* __restrict__ sn) {
  for (int idx = blockIdx.x * 256 + threadIdx.x; idx < SEQ * 32; idx += gridDim.x * 256) {
    const int t = idx >> 5, i = idx & 31;
    const int row = t >> 6, col = t & 63;
    const int fi = i & 15;
    const float inv = powf(10000.f, -(float)(2 * fi) / 32.f);
    const float ang = (i < 16 ? (float)row : (float)col) * inv;
    cs[idx] = cosf(ang);
    sn[idx] = sinf(ang);
  }
}

constexpr float W8_SCALE = 32.f;
constexpr float O8_SCALE = 32.f;
template <bool QPERM, bool F8>
DI void transpose_item(int item, const float* __restrict__ W, bf16* __restrict__ Wt, int K, int N, int Npad, char* smem) {
  float (*tile)[33] = (float (*)[33])smem;
  const int tid = threadIdx.x;
  const int ntn = Npad / 32;
  const int n0 = (item % ntn) * 32, k0 = (item / ntn) * 128;
  {
    const int c4 = tid & 7, rr = tid >> 3;
    const int np = n0 + 4 * c4;
    const int n = QPERM ? (np < 1024 ? (np >> 7) * 192 + (np & 127) : ((np - 1024) >> 6) * 192 + 128 + ((np - 1024) & 63)) : np;
#pragma unroll
    for (int ps = 0; ps < 4; ++ps) {
      const int k = k0 + 32 * ps + rr;
      float4 v = make_float4(0.f, 0.f, 0.f, 0.f);
      if (np < N) v = *(const float4*)(W + (size_t)k * N + n);
      tile[32 * ps + rr][4 * c4 + 0] = v.x; tile[32 * ps + rr][4 * c4 + 1] = v.y; tile[32 * ps + rr][4 * c4 + 2] = v.z; tile[32 * ps + rr][4 * c4 + 3] = v.w;
    }
  }
  __syncthreads();
  {
    const int seg = tid & 7, nl = tid >> 3;
    float v[16];
#pragma unroll
    for (int j = 0; j < 16; ++j) v[j] = tile[16 * seg + j][nl];
    if (F8) {
      u32x4 o;
#pragma unroll
      for (int q = 0; q < 4; ++q) {
        int w = 0;
        w = __builtin_amdgcn_cvt_pk_fp8_f32(v[4 * q] * W8_SCALE, v[4 * q + 1] * W8_SCALE, w, false);
        w = __builtin_amdgcn_cvt_pk_fp8_f32(v[4 * q + 2] * W8_SCALE, v[4 * q + 3] * W8_SCALE, w, true);
        o[q] = (unsigned)w;
      }
      *(u32x4*)((unsigned char*)Wt + (size_t)(n0 + nl) * K + k0 + 16 * seg) = o;
    } else {
      bf16x8 o0, o1;
#pragma unroll
      for (int j = 0; j < 8; ++j) { o0[j] = (bf16)v[j]; o1[j] = (bf16)v[8 + j]; }
      bf16* d = Wt + (size_t)(n0 + nl) * K + k0 + 16 * seg;
      *(bf16x8*)d = o0; *(bf16x8*)(d + 8) = o1;
    }
  }
  __syncthreads();
}
template <bool QPERM = false, bool F8 = false>
DI void transpose_phase(const float* __restrict__ W, bf16* __restrict__ Wt, int K, int N, int Npad, char* smem) {
  const int nitems = (Npad / 32) * (K / 128);
  for (int item = blockIdx.x; item < nitems; item += gridDim.x) transpose_item<QPERM, F8>(item, W, Wt, K, N, Npad, smem);
}

DI void convert_phase(const float4* __restrict__ src, bf16x4* __restrict__ dst, size_t n4) {
  for (size_t i = blockIdx.x * (size_t)256 + threadIdx.x; i < n4; i += (size_t)gridDim.x * 256) {
    const float4 v = src[i];
    bf16x4 o; o[0] = (bf16)v.x; o[1] = (bf16)v.y; o[2] = (bf16)v.z; o[3] = (bf16)v.w;
    dst[i] = o;
  }
}


DI void convert_fp8_phase(const float4* __restrict__ src, unsigned* __restrict__ dst, size_t n4, float scale) {
  for (size_t i = blockIdx.x * (size_t)256 + threadIdx.x; i < n4; i += (size_t)gridDim.x * 256) {
    const float4 v = src[i];
    int w = 0;
    w = __builtin_amdgcn_cvt_pk_fp8_f32(v.x * scale, v.y * scale, w, false);
    w = __builtin_amdgcn_cvt_pk_fp8_f32(v.z * scale, v.w * scale, w, true);
    dst[i] = (unsigned)w;
  }
}

typedef float f32x16v __attribute__((ext_vector_type(16)));
typedef float f32x32v __attribute__((ext_vector_type(32)));
typedef unsigned u32x6 __attribute__((ext_vector_type(6)));
typedef unsigned u32x2 __attribute__((ext_vector_type(2)));
template <bool VLAYOUT>
DI void convert_fp6_phase(const float* __restrict__ src, unsigned char* __restrict__ dst, size_t nblk, float scale, char* smem) {
  const int lane = threadIdx.x & 63, wave_u = __builtin_amdgcn_readfirstlane(threadIdx.x >> 6);
  char* wb = smem + wave_u * 8192;
  const size_t nchunks = nblk >> 6, wid = blockIdx.x * (size_t)4 + wave_u, nw = (size_t)gridDim.x * 4;
  const int f = (lane >> 1) & 7;
  for (size_t ch = wid; ch < nchunks; ch += nw) {
    const unsigned char* g = (const unsigned char*)(src + ch * (64 * 32));
#pragma unroll
    for (int k = 0; k < 8; ++k) {
      const int row = 8 * k + (lane >> 3);
      const int piece = (lane & 7) ^ ((row >> 1) & 7);
      __builtin_amdgcn_global_load_lds((const unsigned*)(g + row * 128 + 16 * piece), (LAS unsigned*)(wb + k * 1024), 16, 0, 0);
    }
    asm volatile("s_waitcnt vmcnt(0)" ::: "memory");
    float4 v[8];
#pragma unroll
    for (int q = 0; q < 8; ++q) v[q] = *(const float4*)(wb + lane * 128 + 16 * (q ^ f));
    asm volatile("s_waitcnt lgkmcnt(0)" ::: "memory");
    const size_t i = ch * 64 + lane;
    f32x16v a, b;
#pragma unroll
    for (int q = 0; q < 8; ++q) { a[2 * q] = v[q].x * scale; b[2 * q] = v[q].y * scale; a[2 * q + 1] = v[q].z * scale; b[2 * q + 1] = v[q].w * scale; }
    const u32x6 p = __builtin_amdgcn_cvt_scalef32_2xpk16_fp6_f32(a, b, 1.0f);
    u32x2 t0, t1, t2; t0[0] = p[0]; t0[1] = p[1]; t1[0] = p[2]; t1[1] = p[3]; t2[0] = p[4]; t2[1] = p[5];
    unsigned char* row = dst + (i >> 5) * 768;
    const int q = (int)(i & 31);
    if (VLAYOUT) {
      *(u32x2*)(row + 8 * q) = t0; *(u32x2*)(row + 256 + 8 * q) = t1; *(u32x2*)(row + 512 + 8 * q) = t2;
    } else {
      const int st = q >> 2, g2 = q & 3;
      const int u0 = 3 * st, u1 = 3 * st + 1, u2 = 3 * st + 2;
      *(u32x2*)(row + 128 * (u0 >> 2) + 32 * g2 + 16 * ((u0 >> 1) & 1) + 8 * (u0 & 1)) = t0;
      *(u32x2*)(row + 128 * (u1 >> 2) + 32 * g2 + 16 * ((u1 >> 1) & 1) + 8 * (u1 & 1)) = t1;
      *(u32x2*)(row + 128 * (u2 >> 2) + 32 * g2 + 16 * ((u2 >> 1) & 1) + 8 * (u2 & 1)) = t2;
    }
  }
}

DI float wave_sum(float v) {
#pragma unroll
  for (int o = 32; o > 0; o >>= 1) v += __shfl_xor(v, o);
  return v;
}
template <int MODE = 0>
DI void norm_mod_item(int item, const float* __restrict__ src_lat, const float* __restrict__ src_ctx, const float* __restrict__ gain,
                      const float* __restrict__ modl, int chunk, bf16* __restrict__ H, unsigned char* __restrict__ H8 = nullptr) {
  const int lane = threadIdx.x & 63, wave = threadIdx.x >> 6;
  const int row = item * 4 + wave;
  const int b = row < NLAT ? row / SEQ : 4;
  float4 v[4];
  if (src_ctx == nullptr) {
    const bf16x4* src16 = (const bf16x4*)((const bf16*)(const void*)src_lat + (size_t)row * DM);
#pragma unroll
    for (int k = 0; k < 4; ++k) {
      const bf16x4 rb = src16[lane + 64 * k];
      v[k].x = (float)rb[0]; v[k].y = (float)rb[1]; v[k].z = (float)rb[2]; v[k].w = (float)rb[3];
    }
  } else {
    const float* src = row < NLAT ? src_lat + (size_t)row * DM : src_ctx + (size_t)(row - NLAT) * DM;
#pragma unroll
    for (int k = 0; k < 4; ++k) v[k] = ((const float4*)src)[lane + 64 * k];
  }
  float ss = 0.f;
#pragma unroll
  for (int k = 0; k < 4; ++k) ss += v[k].x * v[k].x + v[k].y * v[k].y + v[k].z * v[k].z + v[k].w * v[k].w;
  ss = wave_sum(ss);
  const float rs = rsqrtf(ss * (1.f / DM) + EPS);
  const float4* gp = (const float4*)gain;
  const float4* shp = (const float4*)(modl + (size_t)b * 6144 + chunk * 1024);
  const float4* scp = (const float4*)(modl + (size_t)b * 6144 + (chunk + 1) * 1024);
#pragma unroll
  for (int k = 0; k < 4; ++k) {
    const float4 g = gp[lane + 64 * k], sh = shp[lane + 64 * k], sc = scp[lane + 64 * k];
    const float y0 = v[k].x * rs * g.x * (1.f + sc.x) + sh.x, y1 = v[k].y * rs * g.y * (1.f + sc.y) + sh.y;
    const float y2 = v[k].z * rs * g.z * (1.f + sc.z) + sh.z, y3 = v[k].w * rs * g.w * (1.f + sc.w) + sh.w;
    if (MODE != 0) {
      int w = 0;
      w = __builtin_amdgcn_cvt_pk_fp8_f32(y0, y1, w, false); w = __builtin_amdgcn_cvt_pk_fp8_f32(y2, y3, w, true);
      ((unsigned*)((MODE == 1 ? (unsigned char*)H : H8) + (size_t)row * DM))[lane + 64 * k] = (unsigned)w;
    }
    if (MODE != 1) {
      bf16x4 o;
      o[0] = (bf16)y0; o[1] = (bf16)y1; o[2] = (bf16)y2; o[3] = (bf16)y3;
      ((bf16x4*)(H + (size_t)row * DM))[lane + 64 * k] = o;
    }
  }
}

template <int CTRL>
DI float dpp_mov_f(float v) {
  return __builtin_bit_cast(float, __builtin_amdgcn_update_dpp(0, __builtin_bit_cast(int, v), CTRL, 0xF, 0xF, true));
}
DI void ffn_norm_item(int item, const bf16* __restrict__ RES, const float* __restrict__ gain, const float* __restrict__ modl, int chunk,
                      unsigned char* __restrict__ H8, unsigned char* __restrict__ H6) {
  const int lane = threadIdx.x & 63, wave = threadIdx.x >> 6;
  const int row = item * 4 + wave;
  const int b = row < NLAT ? row / SEQ : 4;
  const bf16* src = RES + (size_t)row * DM + 16 * lane;
  const bf16x8 r0 = *(const bf16x8*)src, r1 = *(const bf16x8*)(src + 8);
  float v[16];
#pragma unroll
  for (int j = 0; j < 8; ++j) { v[j] = (float)r0[j]; v[8 + j] = (float)r1[j]; }
  float ss = 0.f;
#pragma unroll
  for (int j = 0; j < 16; ++j) ss += v[j] * v[j];
  ss = wave_sum(ss);
  const float rs = rsqrtf(ss * (1.f / DM) + EPS);
  const float* gp = gain + 16 * lane;
  const float* shp = modl + (size_t)b * 6144 + chunk * 1024 + 16 * lane;
  const float* scp = shp + 1024;
  float y[16];
#pragma unroll
  for (int q = 0; q < 4; ++q) {
    const float4 g = *(const float4*)(gp + 4 * q), sh = *(const float4*)(shp + 4 * q), sc = *(const float4*)(scp + 4 * q);
    y[4 * q] = v[4 * q] * rs * g.x * (1.f + sc.x) + sh.x; y[4 * q + 1] = v[4 * q + 1] * rs * g.y * (1.f + sc.y) + sh.y;
    y[4 * q + 2] = v[4 * q + 2] * rs * g.z * (1.f + sc.z) + sh.z; y[4 * q + 3] = v[4 * q + 3] * rs * g.w * (1.f + sc.w) + sh.w;
  }
  {
    u32x4 w8;
#pragma unroll
    for (int q = 0; q < 4; ++q) {
      int w = 0;
      w = __builtin_amdgcn_cvt_pk_fp8_f32(y[4 * q], y[4 * q + 1], w, false); w = __builtin_amdgcn_cvt_pk_fp8_f32(y[4 * q + 2], y[4 * q + 3], w, true);
      w8[q] = (unsigned)w;
    }
    *(u32x4*)(H8 + (size_t)row * DM + 16 * lane) = w8;
  }
  {
    const bool odd = lane & 1;
    f32x16v a, bb;
#pragma unroll
    for (int j = 0; j < 16; j += 2) {
      const float z0 = dpp_mov_f<0xB1>(y[j]), z1 = dpp_mov_f<0xB1>(y[j + 1]);
      const float lo0 = odd ? z0 : y[j], lo1 = odd ? z1 : y[j + 1], hi0 = odd ? y[j] : z0, hi1 = odd ? y[j + 1] : z1;
      a[j >> 1] = lo0; bb[j >> 1] = lo1; a[8 + (j >> 1)] = hi0; bb[8 + (j >> 1)] = hi1;
    }
    const u32x6 p = __builtin_amdgcn_cvt_scalef32_2xpk16_fp6_f32(a, bb, 1.0f);
    u32x2 t0, t1, t2; t0[0] = p[0]; t0[1] = p[1]; t1[0] = p[2]; t1[1] = p[3]; t2[0] = p[4]; t2[1] = p[5];
    unsigned char* d = H6 + (size_t)row * 768 + 24 * (lane >> 1);
    if (!odd) { *(u32x2*)d = t0; *(u32x2*)(d + 8) = t1; *(u32x2*)(d + 16) = t2; }
  }
}

constexpr int GBM = 128, GBN = 128, GBK = 64, GLD = 72;
enum { EPI_BF16 = 0, EPI_RESID = 1, EPI_QKV0 = 2, EPI_MLAQ = 3, EPI_MLAKV = 4, EPI_TOPK = 5 };
DI float as_f(unsigned u) { return __builtin_bit_cast(float, u); }
DI unsigned as_u(float f) { return __builtin_bit_cast(unsigned, f); }

DI void ce_desc(float& a, float& b) { const float hi = fmaxf(a, b), lo = fminf(a, b); a = hi; b = lo; }
DI void sort16_desc(float (&v)[16]) {
#define CE(a, b) ce_desc(v[a], v[b]);
  CE(0,13) CE(1,12) CE(2,15) CE(3,14) CE(4,8) CE(5,6) CE(7,11) CE(9,10)
  CE(0,5) CE(1,7) CE(2,9) CE(3,4) CE(6,13) CE(8,14) CE(10,15) CE(11,12)
  CE(0,1) CE(2,3) CE(4,5) CE(6,8) CE(7,9) CE(10,11) CE(12,13) CE(14,15)
  CE(0,2) CE(1,3) CE(4,10) CE(5,11) CE(6,7) CE(8,9) CE(12,14) CE(13,15)
  CE(1,2) CE(3,12) CE(4,6) CE(5,7) CE(8,10) CE(9,11) CE(13,14)
  CE(1,4) CE(2,6) CE(5,8) CE(7,10) CE(9,13) CE(11,14)
  CE(2,4) CE(3,6) CE(9,12) CE(11,13)
  CE(3,5) CE(6,8) CE(7,9) CE(10,12)
  CE(3,4) CE(5,6) CE(7,8) CE(9,10) CE(11,12)
  CE(6,7) CE(8,9)
#undef CE
}
DI void bmerge16_desc(float (&v)[16]) {
#pragma unroll
  for (int j = 8; j > 0; j >>= 1)
#pragma unroll
    for (int i = 0; i < 16; ++i) { const int l = i ^ j; if (l > i) ce_desc(v[i], v[l]); }
}
DI void top16_merge(float (&a)[16], const float (&b)[16]) {
#pragma unroll
  for (int i = 0; i < 16; ++i) a[i] = fmaxf(a[i], b[15 - i]);
  bmerge16_desc(a);
}
DI void top16_merge_partner(float (&a)[16]) {
  float b[16];
#pragma unroll
  for (int i = 0; i < 16; ++i) b[i] = __shfl_xor(a[i], 32);
  top16_merge(a, b);
}


struct GemmEpi {
  bf16* Cb; int ldc; int rowmap;
  const float* res_lat; const float* res_ctx; bf16* RES; int res16; const float* modl; int gchunk;
  const float *n0g, *n1g, *n2g, *n3g, *cs, *sn;
  bf16 *QA, *QB, *CQA, *CQB, *KA, *VA, *KB, *VB;
  unsigned char* C8;
  const bf16* SK; float* TOP;
  unsigned char* V8T;
};


template <int DVH>
DI void store_vT_fp8(const float* Cs, int CLD, int m0, unsigned char* __restrict__ VT, int HV, int hv0) {
  int b, T0;
  if (m0 < NLAT) { b = m0 / SEQ; T0 = (NCX + (m0 % SEQ)) >> 6; } else { const int rc = m0 - NLAT; b = rc / NCX; T0 = (rc % NCX) >> 6; }
#pragma unroll 2
  for (int k = 0; k < 8; ++k) {
    const int u = (int)threadIdx.x + 256 * k;
    const int c = u & 7, d = (u >> 3) & 127, tile2 = u >> 10;
    const int kb = 32 * ((c >> 1) & 1) + 16 * (c & 1) + 4 * (c >> 2);
    float v[8];
#pragma unroll
    for (int e = 0; e < 8; ++e) v[e] = Cs[(tile2 * 64 + kb + 8 * (e >> 2) + (e & 3)) * CLD + d];
    const int head = hv0 + (DVH == 64 ? (d >> 6) : 0), dd = DVH == 64 ? (d & 63) : d;
    *(u32x2g*)(VT + ((((size_t)b * HV + head) * (NKEY / 64) + (T0 + tile2)) * DVH + dd) * 64 + 8 * c) = pack8_fp8(v);
  }
}

template <int EPI, bool F8 = false>
DI void gemm_tile(const bf16* __restrict__ A, int lda, const bf16* __restrict__ Bt, int K, const GemmEpi& e, int m0, int n0, char* smem) {
  const int tid = threadIdx.x, lane = tid & 63, wave = tid >> 6, wm = wave >> 1, wn = wave & 1;
  const int wave_u = __builtin_amdgcn_readfirstlane(wave);
  const int r = lane & 31, h = lane >> 5;
  const int drow = 8 * wave_u + (lane >> 3);
  const int dcol = ((lane & 7) ^ ((((wave_u & 1) << 2) | (lane >> 4)) & 7)) * 8;
  const char* Au = (const char*)(A + (size_t)m0 * lda);
  const char* Bu = (const char*)(Bt + (size_t)n0 * K);
  unsigned aoff[4], boff[4];
#pragma unroll
  for (int i = 0; i < 4; ++i) {
    aoff[i] = (unsigned)((drow + 32 * i) * lda + dcol) * 2u;
    boff[i] = (unsigned)((drow + 32 * i) * K + dcol) * 2u;
  }
  const unsigned lds0 = (unsigned)(size_t)(LAS char*)smem + (unsigned)wave_u * 1024u;
  f32x16 acc[2][2];
#pragma unroll
  for (int i = 0; i < 2; ++i)
#pragma unroll
    for (int j = 0; j < 2; ++j)
#pragma unroll
      for (int q = 0; q < 16; ++q) acc[i][j][q] = 0.f;
  const int nt = K / GBK;
  auto issue = [&](int t, int buf) {
#pragma unroll
    for (int i = 0; i < 4; ++i) {
      const unsigned la = (unsigned)__builtin_amdgcn_readfirstlane((int)(lds0 + buf * 32768 + i * 4096));
      asm volatile("s_mov_b32 m0, %2\n\ts_nop 0\n\tglobal_load_lds_dwordx4 %0, %1"
                   :: "v"(aoff[i]), "s"(Au + (size_t)t * (GBK * 2)), "s"(la) : "memory", "m0");
      asm volatile("s_mov_b32 m0, %2\n\ts_nop 0\n\tglobal_load_lds_dwordx4 %0, %1"
                   :: "v"(boff[i]), "s"(Bu + (size_t)t * (GBK * 2)), "s"(la + 16384u) : "memory", "m0");
    }
  };
  const int kswz = (r >> 1) & 7;
  issue(0, 0);
  for (int t = 0; t < nt; ++t) {
    asm volatile("s_waitcnt vmcnt(0)" ::: "memory");
    __syncthreads();
    if (t + 1 < nt) issue(t + 1, (t + 1) & 1);
    const bf16* as = (const bf16*)(smem + (t & 1) * 32768) + (wm * 64 + r) * 64;
    const bf16* bs = (const bf16*)(smem + (t & 1) * 32768 + 16384) + (wn * 64 + r) * 64;
    if constexpr (F8) {
#pragma unroll
      for (int ks = 0; ks < 2; ++ks) {
        const int s0 = 8 * (((4 * ks + 2 * h) ^ kswz) & 7), s1 = 8 * (((4 * ks + 2 * h + 1) ^ kswz) & 7);
        i32x8 a8[2], b8[2];
#pragma unroll
        for (int i = 0; i < 2; ++i) {
          const u32x4 x0 = *(const u32x4*)(as + i * 32 * 64 + s0), x1 = *(const u32x4*)(as + i * 32 * 64 + s1);
          const u32x4 y0 = *(const u32x4*)(bs + i * 32 * 64 + s0), y1 = *(const u32x4*)(bs + i * 32 * 64 + s1);
          a8[i][0] = (int)x0[0]; a8[i][1] = (int)x0[1]; a8[i][2] = (int)x0[2]; a8[i][3] = (int)x0[3];
          a8[i][4] = (int)x1[0]; a8[i][5] = (int)x1[1]; a8[i][6] = (int)x1[2]; a8[i][7] = (int)x1[3];
          b8[i][0] = (int)y0[0]; b8[i][1] = (int)y0[1]; b8[i][2] = (int)y0[2]; b8[i][3] = (int)y0[3];
          b8[i][4] = (int)y1[0]; b8[i][5] = (int)y1[1]; b8[i][6] = (int)y1[2]; b8[i][7] = (int)y1[3];
        }
#pragma unroll
        for (int i = 0; i < 2; ++i)
#pragma unroll
          for (int jn = 0; jn < 2; ++jn)
            acc[i][jn] = __builtin_amdgcn_mfma_scale_f32_32x32x64_f8f6f4(a8[i], b8[jn], acc[i][jn], 0, 0, 0, 0x7F7F7F7F, 0, EPI == EPI_RESID ? 0x75757575 : 0x7A7A7A7A);
      }
    } else
#pragma unroll
    for (int ks = 0; ks < 4; ++ks) {
      const int so = 8 * (((2 * ks + h) ^ kswz) & 7);
      const bf16x8 a0 = *(const bf16x8*)(as + so), a1 = *(const bf16x8*)(as + 32 * 64 + so);
      const bf16x8 b0 = *(const bf16x8*)(bs + so), b1 = *(const bf16x8*)(bs + 32 * 64 + so);
      acc[0][0] = mfma32(a0, b0, acc[0][0]);
      acc[0][1] = mfma32(a0, b1, acc[0][1]);
      acc[1][0] = mfma32(a1, b0, acc[1][0]);
      acc[1][1] = mfma32(a1, b1, acc[1][1]);
    }
  }
  static_assert(W8_SCALE == 32.f && O8_SCALE == 32.f, "the MX block scales above encode 2^-5 and 2^-10");
  __syncthreads();
  if constexpr (EPI == EPI_TOPK) {
    constexpr int CLD = 136;
    bf16* Cs = (bf16*)smem;
#pragma unroll
    for (int mi = 0; mi < 2; ++mi)
#pragma unroll
      for (int ni = 0; ni < 2; ++ni)
#pragma unroll
        for (int i = 0; i < 16; ++i) Cs[(wm * 64 + mi * 32 + crow(i, h)) * CLD + wn * 64 + ni * 32 + r] = (bf16)acc[mi][ni][i];
    const int hp = n0 >> 7;
    char* sks = smem + 128 * CLD * 2;
    {
      const unsigned char* skg = (const unsigned char*)(e.SK + (size_t)hp * 128 * 128);
#pragma unroll
      for (int i = 0; i < 8; ++i) {
        const int I = wave_u + 4 * i, row = 4 * I + (lane >> 4);
        const int piece = (lane & 15) ^ (row & 15);
        __builtin_amdgcn_global_load_lds((const unsigned*)(skg + row * 256 + 16 * piece), (LAS unsigned*)(sks + I * 1024), 16, 0, 0);
      }
    }
    asm volatile("s_waitcnt vmcnt(0)" ::: "memory");
    __syncthreads();
    const bf16* qs = Cs + (wave * 32 + r) * CLD + 8 * h;
    f32x16 sc[4];
#pragma unroll
    for (int nb = 0; nb < 4; ++nb)
#pragma unroll
      for (int i = 0; i < 16; ++i) sc[nb][i] = 0.f;
#pragma unroll 2
    for (int ks = 0; ks < 8; ++ks) {
      const bf16x8 bq = *(const bf16x8*)(qs + ks * 16);
#pragma unroll
      for (int nb = 0; nb < 4; ++nb) {
        const int krow = nb * 32 + r;
        const bf16x8 a = *(const bf16x8*)(sks + krow * 256 + 16 * ((2 * ks + h) ^ (krow & 15)));
        sc[nb] = mfma32(a, bq, sc[nb]);
      }
    }
    float k0[16], k1[16], k2[16], k3[16];
#pragma unroll
    for (int i = 0; i < 16; ++i) {
      k0[i] = as_f((as_u(sc[0][i]) & 0xFFFFFF80u) | (unsigned)(0 * 32 + crow(i, h)));
      k1[i] = as_f((as_u(sc[1][i]) & 0xFFFFFF80u) | (unsigned)(1 * 32 + crow(i, h)));
      k2[i] = as_f((as_u(sc[2][i]) & 0xFFFFFF80u) | (unsigned)(2 * 32 + crow(i, h)));
      k3[i] = as_f((as_u(sc[3][i]) & 0xFFFFFF80u) | (unsigned)(3 * 32 + crow(i, h)));
    }
    sort16_desc(k0); sort16_desc(k1); top16_merge(k0, k1);
    sort16_desc(k2); sort16_desc(k3); top16_merge(k2, k3);
    top16_merge(k0, k2);
    top16_merge_partner(k0);
    float* tp = e.TOP + ((size_t)(m0 + wave * 32 + r) * 16 + hp) * 16 + 8 * h;
    float4 o0, o1;
    o0.x = h ? k0[8] : k0[0]; o0.y = h ? k0[9] : k0[1]; o0.z = h ? k0[10] : k0[2]; o0.w = h ? k0[11] : k0[3];
    o1.x = h ? k0[12] : k0[4]; o1.y = h ? k0[13] : k0[5]; o1.z = h ? k0[14] : k0[6]; o1.w = h ? k0[15] : k0[7];
    *(float4*)tp = o0; *(float4*)(tp + 4) = o1;
  } else if constexpr (EPI == EPI_BF16) {
    constexpr int CLD = 136;
    bf16* Cs = (bf16*)smem;
#pragma unroll
    for (int mi = 0; mi < 2; ++mi)
#pragma unroll
      for (int ni = 0; ni < 2; ++ni)
#pragma unroll
        for (int i = 0; i < 16; ++i) Cs[(wm * 64 + mi * 32 + crow(i, h)) * CLD + wn * 64 + ni * 32 + r] = (bf16)acc[mi][ni][i];
    __syncthreads();
    const int ch = tid & 15, r0 = tid >> 4;
#pragma unroll
    for (int k = 0; k < 8; ++k) {
      const int lrow = r0 + 16 * k, row = m0 + lrow;
      int orow = row;
      if (e.rowmap) orow = row < NLAT ? (row / SEQ) * NKEY + NCX + (row % SEQ) : ((row - NLAT) / NCX) * NKEY + ((row - NLAT) % NCX);
      *(u32x4*)(e.Cb + (size_t)orow * e.ldc + n0 + ch * 8) = *(const u32x4*)(Cs + lrow * CLD + ch * 8);
    }
  } else if constexpr (EPI == EPI_QKV0 || EPI == EPI_MLAQ || EPI == EPI_MLAKV) {
    constexpr int CLD = 132;
    float* Cs = (float*)smem;
#pragma unroll
    for (int mi = 0; mi < 2; ++mi)
#pragma unroll
      for (int ni = 0; ni < 2; ++ni)
#pragma unroll
        for (int i = 0; i < 16; ++i) Cs[(wm * 64 + mi * 32 + crow(i, h)) * CLD + wn * 64 + ni * 32 + r] = acc[mi][ni][i];
    __syncthreads();
    const int ch = tid & 15, r0 = tid >> 4, c8 = ch & 7;
    bool vtile = false;
    if constexpr (EPI == EPI_QKV0) {
      if (n0 == 640 || n0 == 1408) {
        store_vT_fp8<64>(Cs, CLD, m0, e.V8T + (n0 == 1408 ? (size_t)NB * 2 * (NKEY / 64) * 64 * 64 : 0), 2, 0);
        vtile = true;
      }
    } else if constexpr (EPI == EPI_MLAKV) {
      if ((n0 >> 7) & 1) { store_vT_fp8<128>(Cs, CLD, m0, e.V8T, 8, n0 >> 8); vtile = true; }
    }
    if (!vtile)
#pragma unroll 2
    for (int k = 0; k < 8; ++k) {
      const int lrow = r0 + 16 * k, row = m0 + lrow;
      const float4 va = *(const float4*)(Cs + lrow * CLD + ch * 8), vb = *(const float4*)(Cs + lrow * CLD + ch * 8 + 4);
      float v[8] = {va.x, va.y, va.z, va.w, vb.x, vb.y, vb.z, vb.w};
      float ss = 0.f;
#pragma unroll
      for (int j = 0; j < 8; ++j) ss += v[j] * v[j];
      const float ss8 = ss + __shfl_xor(ss, 4) + 0.f;
      float s8 = ss8; s8 += __shfl_xor(s8, 2); s8 += __shfl_xor(s8, 1);
      const float s16 = s8 + __shfl_xor(s8, 8);
      if constexpr (EPI == EPI_QKV0) {
        const bool lat = row < NLAT;
        int b, t;
        if (lat) { b = row / SEQ; t = row % SEQ; } else { const int rc = row - NLAT; b = rc / NCX; t = rc % NCX; }
        const int key = lat ? NCX + t : t;
        const int slot = (n0 >> 6) + (ch >> 3);
        const int isB = slot >= 12 ? 1 : 0, sp = slot - 12 * isB;
        const bool isq = sp < 8, isv = sp >= 10;
        {
          const float rs = rsqrtf(s8 * (1.f / 64.f) + EPS) * (isq ? LOG2E : 1.f);
          const float* gq = isB ? e.n2g : e.n0g;
          const float* gk = isB ? e.n3g : e.n1g;
          const float* g = (isq ? gq : gk) + c8 * 8;
          const float4 g0 = *(const float4*)g, g1 = *(const float4*)(g + 4);
          float w[8] = {v[0] * rs * g0.x, v[1] * rs * g0.y, v[2] * rs * g0.z, v[3] * rs * g0.w, v[4] * rs * g1.x, v[5] * rs * g1.y, v[6] * rs * g1.z, v[7] * rs * g1.w};
          if (lat) {
            const float4 cs4 = *(const float4*)(e.cs + t * 32 + c8 * 4), sn4 = *(const float4*)(e.sn + t * 32 + c8 * 4);
            float o0;
            o0 = w[0] * cs4.x - w[1] * sn4.x; w[1] = w[0] * sn4.x + w[1] * cs4.x; w[0] = o0;
            o0 = w[2] * cs4.y - w[3] * sn4.y; w[3] = w[2] * sn4.y + w[3] * cs4.y; w[2] = o0;
            o0 = w[4] * cs4.z - w[5] * sn4.z; w[5] = w[4] * sn4.z + w[5] * cs4.z; w[4] = o0;
            o0 = w[6] * cs4.w - w[7] * sn4.w; w[7] = w[6] * sn4.w + w[7] * cs4.w; w[6] = o0;
          }
#pragma unroll
          for (int j = 0; j < 8; ++j) v[j] = isv ? v[j] : w[j];
        }
        bf16x8 ov;
#pragma unroll
        for (int j = 0; j < 8; ++j) ov[j] = (bf16)v[j];
        constexpr size_t SZQ = (size_t)NB * 8 * SEQ * 64, SZC = (size_t)NB * 8 * NCX * 64, SZK = (size_t)NB * 2 * NKEY * 64;
        const size_t offq = lat ? (size_t)isB * SZQ + ((size_t)(b * 8 + sp) * SEQ + t) * 64
                                : 2 * SZQ + (size_t)isB * SZC + ((size_t)(b * 8 + sp) * NCX + t) * 64;
        const int hk = (sp - 8) & 1;
        const size_t offk = 2 * SZQ + 2 * SZC + (size_t)(2 * isB + (isv ? 1 : 0)) * SZK + ((size_t)(b * 2 + hk) * NKEY + key) * 64;
        const size_t off = isq ? offq : offk;
        if (isv) *(bf16x8*)(e.QA + off + c8 * 8) = ov;
        else *(u32x2g*)((unsigned char*)e.QA + off + c8 * 8) = pack8_fp8(v);
      } else if constexpr (EPI == EPI_MLAQ) {
        constexpr float QSC = 0.07216878364870322f * LOG2E * 8.f;
        if (n0 < 1024) {
          const float rs = rsqrtf(s16 * (1.f / 128.f) + EPS) * QSC;
          const float4 g0 = *(const float4*)(e.n0g + ch * 8), g1 = *(const float4*)(e.n0g + ch * 8 + 4);
          v[0] *= rs * g0.x; v[1] *= rs * g0.y; v[2] *= rs * g0.z; v[3] *= rs * g0.w;
          v[4] *= rs * g1.x; v[5] *= rs * g1.y; v[6] *= rs * g1.z; v[7] *= rs * g1.w;
        } else {
          const int t = row % SEQ;
          const float rs = rsqrtf(s8 * (1.f / 64.f) + EPS) * QSC;
          const float4 g0 = *(const float4*)(e.n1g + c8 * 8), g1 = *(const float4*)(e.n1g + c8 * 8 + 4);
          v[0] *= rs * g0.x; v[1] *= rs * g0.y; v[2] *= rs * g0.z; v[3] *= rs * g0.w;
          v[4] *= rs * g1.x; v[5] *= rs * g1.y; v[6] *= rs * g1.z; v[7] *= rs * g1.w;
          const float4 cs4 = *(const float4*)(e.cs + t * 32 + c8 * 4), sn4 = *(const float4*)(e.sn + t * 32 + c8 * 4);
          float o0;
          o0 = v[0] * cs4.x - v[1] * sn4.x; v[1] = v[0] * sn4.x + v[1] * cs4.x; v[0] = o0;
          o0 = v[2] * cs4.y - v[3] * sn4.y; v[3] = v[2] * sn4.y + v[3] * cs4.y; v[2] = o0;
          o0 = v[4] * cs4.z - v[5] * sn4.z; v[5] = v[4] * sn4.z + v[5] * cs4.z; v[4] = o0;
          o0 = v[6] * cs4.w - v[7] * sn4.w; v[7] = v[6] * sn4.w + v[7] * cs4.w; v[6] = o0;
        }
        *(u32x2g*)(e.C8 + (size_t)row * e.ldc + n0 + ch * 8) = pack8_fp8(v);
      } else {
        if (((n0 >> 7) & 1) == 0) {
          const float rs = rsqrtf(s16 * (1.f / 128.f) + EPS);
          const float4 g0 = *(const float4*)(e.n0g + ch * 8), g1 = *(const float4*)(e.n0g + ch * 8 + 4);
          v[0] *= rs * g0.x; v[1] *= rs * g0.y; v[2] *= rs * g0.z; v[3] *= rs * g0.w;
          v[4] *= rs * g1.x; v[5] *= rs * g1.y; v[6] *= rs * g1.z; v[7] *= rs * g1.w;
        }
        const int orow = row < NLAT ? (row / SEQ) * NKEY + NCX + (row % SEQ) : ((row - NLAT) / NCX) * NKEY + ((row - NLAT) % NCX);
        if (((n0 >> 7) & 1) == 0) {
          *(u32x2g*)(e.C8 + (size_t)orow * 1024 + (n0 >> 8) * 128 + ch * 8) = pack8_fp8(v);
        } else {
          bf16x8 ov;
#pragma unroll
          for (int j = 0; j < 8; ++j) ov[j] = (bf16)v[j];
          *(bf16x8*)(e.Cb + (size_t)orow * e.ldc + n0 + ch * 8) = ov;
        }
      }
    }
  } else {
    constexpr int CLD = 132;
    float* Cs = (float*)smem;
#pragma unroll
    for (int mi = 0; mi < 2; ++mi)
#pragma unroll
      for (int ni = 0; ni < 2; ++ni)
#pragma unroll
        for (int i = 0; i < 16; ++i) Cs[(wm * 64 + mi * 32 + crow(i, h)) * CLD + wn * 64 + ni * 32 + r] = acc[mi][ni][i];
    __syncthreads();
    const int ch = tid & 31, r0 = tid >> 5;
    const bool lat = m0 < NLAT;
    const int b = lat ? m0 / SEQ : 4;
    const float4 g = *(const float4*)(e.modl + (size_t)b * 6144 + e.gchunk * 1024 + n0 + ch * 4);
    bf16* outp = e.RES + (size_t)m0 * DM;
    const float* resp = e.res16 ? (const float*)outp : (lat ? e.res_lat + (size_t)m0 * DM : e.res_ctx + (size_t)(m0 - NLAT) * DM);
#pragma unroll
    for (int k = 0; k < 16; ++k) {
      const int lrow = r0 + 8 * k;
      const float4 c = *(const float4*)(Cs + lrow * CLD + ch * 4);
      float4 x;
      if (e.res16) {
        const bf16x4 rb = *(const bf16x4*)(outp + (size_t)lrow * DM + n0 + ch * 4);
        x.x = (float)rb[0]; x.y = (float)rb[1]; x.z = (float)rb[2]; x.w = (float)rb[3];
      } else {
        x = *(const float4*)(resp + (size_t)lrow * DM + n0 + ch * 4);
      }
      x.x += g.x * c.x; x.y += g.y * c.y; x.z += g.z * c.z; x.w += g.w * c.w;
      bf16x4 ob; ob[0] = (bf16)x.x; ob[1] = (bf16)x.y; ob[2] = (bf16)x.z; ob[3] = (bf16)x.w;
      *(bf16x4*)(outp + (size_t)lrow * DM + n0 + ch * 4) = ob;
    }
  }
  __syncthreads();
}
template <int EPI, bool F8 = false>
DI void gemm_phase(const bf16* __restrict__ A, int lda, const bf16* __restrict__ Bt, int K, const GemmEpi& e, int M, int N, char* smem) {
  const int ntn = N / GBN, ntm = M / GBM;
  const int G = gridDim.x;
  if ((G & 7) == 0 && (ntm & 7) == 0) {
    const int xcd = blockIdx.x & 7, nj = G >> 3, pm = ntm >> 3, nloc = pm * ntn;
    for (int u = blockIdx.x >> 3; u < nloc; u += nj) gemm_tile<EPI, F8>(A, lda, Bt, K, e, (xcd * pm + u / ntn) * GBM, (u % ntn) * GBN, smem);
  } else {
    const int nitems = ntm * ntn;
    for (int item = blockIdx.x; item < nitems; item += G) gemm_tile<EPI, F8>(A, lda, Bt, K, e, (item / ntn) * GBM, (item % ntn) * GBN, smem);
  }
}

struct Post0 {
  const bf16* P;
  const float *aqn, *akn, *bqn, *bkn, *cs, *sn;
  bf16 *QA, *QB, *CQA, *CQB, *KA, *VA, *KB, *VB;
};
DI void qkv_post0_item(int item, const Post0& p) {
  const int lane = threadIdx.x & 63, wave = threadIdx.x >> 6;
  const int row = item * 4 + wave;
  const bool lat = row < NLAT;
  int b, t;
  if (lat) { b = row / SEQ; t = row % SEQ; } else { const int rc = row - NLAT; b = rc / NCX; t = rc % NCX; }
  const int key = lat ? NCX + t : t;
  const int c8 = lane & 7;
  float4 cs4 = {1.f, 1.f, 1.f, 1.f}, sn4 = {0.f, 0.f, 0.f, 0.f};
  if (lat) { cs4 = *(const float4*)(p.cs + t * 32 + c8 * 4); sn4 = *(const float4*)(p.sn + t * 32 + c8 * 4); }
#pragma unroll
  for (int k = 0; k < 3; ++k) {
    const int c = lane + 64 * k, slot = c >> 3;
    const bf16x8 pv = *(const bf16x8*)(p.P + (size_t)row * 1536 + c * 8);
    float v[8];
#pragma unroll
    for (int j = 0; j < 8; ++j) v[j] = (float)pv[j];
    const bool isv = (slot == 10 || slot == 11 || slot == 22 || slot == 23);
    float ss = 0.f;
#pragma unroll
    for (int j = 0; j < 8; ++j) ss += v[j] * v[j];
    ss += __shfl_xor(ss, 4); ss += __shfl_xor(ss, 2); ss += __shfl_xor(ss, 1);
    if (!isv) {
      const float rs = rsqrtf(ss * (1.f / 64.f) + EPS);
      const float* g = (slot < 8 ? p.aqn : slot < 10 ? p.akn : slot < 20 ? p.bqn : p.bkn) + c8 * 8;
      const float4 g0 = *(const float4*)g, g1 = *(const float4*)(g + 4);
      v[0] *= rs * g0.x; v[1] *= rs * g0.y; v[2] *= rs * g0.z; v[3] *= rs * g0.w;
      v[4] *= rs * g1.x; v[5] *= rs * g1.y; v[6] *= rs * g1.z; v[7] *= rs * g1.w;
      if (lat) {
        float o0;
        o0 = v[0] * cs4.x - v[1] * sn4.x; v[1] = v[0] * sn4.x + v[1] * cs4.x; v[0] = o0;
        o0 = v[2] * cs4.y - v[3] * sn4.y; v[3] = v[2] * sn4.y + v[3] * cs4.y; v[2] = o0;
        o0 = v[4] * cs4.z - v[5] * sn4.z; v[5] = v[4] * sn4.z + v[5] * cs4.z; v[4] = o0;
        o0 = v[6] * cs4.w - v[7] * sn4.w; v[7] = v[6] * sn4.w + v[7] * cs4.w; v[6] = o0;
      }
    }
    bf16x8 ov;
#pragma unroll
    for (int j = 0; j < 8; ++j) ov[j] = (bf16)v[j];
    bf16* dst;
    if (slot < 8) dst = lat ? p.QA + ((size_t)(b * 8 + slot) * SEQ + t) * 64 : p.CQA + ((size_t)(b * 8 + slot) * NCX + t) * 64;
    else if (slot < 10) dst = p.KA + ((size_t)(b * 2 + slot - 8) * NKEY + key) * 64;
    else if (slot < 12) dst = p.VA + ((size_t)(b * 2 + slot - 10) * NKEY + key) * 64;
    else if (slot < 20) dst = lat ? p.QB + ((size_t)(b * 8 + slot - 12) * SEQ + t) * 64 : p.CQB + ((size_t)(b * 8 + slot - 12) * NCX + t) * 64;
    else if (slot < 22) dst = p.KB + ((size_t)(b * 2 + slot - 20) * NKEY + key) * 64;
    else dst = p.VB + ((size_t)(b * 2 + slot - 22) * NKEY + key) * 64;
    *(bf16x8*)(dst + c8 * 8) = ov;
  }
}

struct AttnParams {
  const bf16* Q; long q_bs, q_hs; int q_ts; int q2_off, q2_hs;
  const bf16* K; long k_bs, k_hs; int k_ts;
  const bf16* K2; long k2_bs; int k2_ts;
  const bf16* V; long v_bs, v_hs; int v_ts;
  const unsigned char* V8; long v8_bs, v8_hs;
  bf16* O; int o_row0, o_bs, o_col0;
  const float* sink;
  int nkeys;
  int G;
  int window;
  float scale_log2;
};

template <int DQK, int DV, int DSPLIT, int VBUFS, bool WINDOW, bool FP8 = false>
DI void attn_item(const AttnParams& p, int qblk, int head, int b, char* smem) {
  constexpr int KCH = DQK / 8, VCH = DV / 8;
  constexpr int KPW = KCH / 4, VPW = VCH / 4;
  constexpr int KBYTES = FP8 ? 64 * DQK : 64 * DQK * 2, VBYTES = FP8 ? DV * 64 : 64 * DV * 2;
  constexpr float PSHIFT = FP8 ? 5.f : 0.f, THR = FP8 ? 3.f : 8.f;
  constexpr int NKS = DQK / 16, NDB = DV / 32;
  char* Kbase = smem;
  char* Vbase = smem + 2 * KBYTES;
  const int tid = threadIdx.x, lane = tid & 63, wave = tid >> 6;
  const int wave_u = __builtin_amdgcn_readfirstlane(wave);
  const int r = lane & 31, h = lane >> 5;
  const int q0 = qblk * 128;
  const int hkv = head / p.G;
  const int tq = q0 + wave * 32 + r;

  bf16x8 qf[FP8 ? 1 : NKS];
  i32x8 q8[FP8 ? DQK / 64 : 1];
  if constexpr (!FP8) {
    const bf16* qp = p.Q + (size_t)b * p.q_bs + (size_t)head * p.q_hs + (size_t)tq * p.q_ts + 8 * h;
    const bf16* qp2 = p.Q + (size_t)b * p.q_bs + (size_t)tq * p.q_ts + p.q2_off + head * p.q2_hs + 8 * h;
#pragma unroll
    for (int ks = 0; ks < NKS; ++ks) qf[ks] = (DSPLIT == DQK || ks * 16 < DSPLIT) ? *(const bf16x8*)(qp + ks * 16) : *(const bf16x8*)(qp2 + (ks * 16 - DSPLIT));
  } else {
    const unsigned char* q8p = (const unsigned char*)p.Q + (size_t)b * p.q_bs + (size_t)tq * p.q_ts;
#pragma unroll
    for (int kb = 0; kb < DQK / 64; ++kb) {
      const unsigned char* src = (kb * 64 < DSPLIT) ? q8p + head * p.q_hs + kb * 64 + 32 * h : q8p + p.q2_off + head * p.q2_hs + (kb * 64 - DSPLIT) + 32 * h;
      const u32x4 lo4 = *(const u32x4*)src, hi4 = *(const u32x4*)(src + 16);
      q8[kb][0] = (int)lo4[0]; q8[kb][1] = (int)lo4[1]; q8[kb][2] = (int)lo4[2]; q8[kb][3] = (int)lo4[3];
      q8[kb][4] = (int)hi4[0]; q8[kb][5] = (int)hi4[1]; q8[kb][6] = (int)hi4[2]; q8[kb][7] = (int)hi4[3];
    }
  }
  int ntiles, lo = 0;
  if (WINDOW) {
    lo = q0 - 128 < 0 ? 0 : q0 - 128;
    const int hi = q0 + 256 > SEQ ? SEQ : q0 + 256;
    ntiles = 4 + (hi - lo) / 64;
  } else {
    ntiles = p.nkeys / 64;
  }
  const bf16* Kb = p.K + (size_t)b * p.k_bs + (size_t)hkv * p.k_hs;
  const bf16* K2b = (DSPLIT < DQK) ? p.K2 + (size_t)b * p.k2_bs : nullptr;
  const bf16* Vb = p.V + (size_t)b * p.v_bs + (size_t)hkv * p.v_hs;

  auto key0_of = [&](int j) -> int { return WINDOW ? (j < 4 ? j * 64 : NCX + lo + (j - 4) * 64) : j * 64; };
  const int krow_l = 8 * wave_u + (lane >> 3);
  const int kcol_l = (lane & 7) ^ ((((wave_u & 1) << 2) | (lane >> 4)) & 7);
  auto issue_k = [&](int j, int buf) {
    const int k0 = key0_of(j);
    if constexpr (FP8) {
      const int row = 16 * wave_u + (lane >> 2);
      const int chunk = (lane & 3) ^ ((lane >> 4) & 3);
#pragma unroll
      for (int g = 0; g < DQK / 64; ++g) {
        const unsigned char* ub = (g * 64 < DSPLIT)
            ? (const unsigned char*)p.K + (size_t)b * p.k_bs + (size_t)hkv * p.k_hs + (size_t)k0 * p.k_ts + g * 64
            : (const unsigned char*)p.K2 + (size_t)b * p.k2_bs + (size_t)k0 * p.k2_ts + (g * 64 - DSPLIT);
        const unsigned vo = (unsigned)(row * (int)((g * 64 < DSPLIT) ? p.k_ts : p.k2_ts) + 16 * chunk);
        const unsigned la = (unsigned)__builtin_amdgcn_readfirstlane((int)(unsigned)(size_t)(LAS char*)(Kbase + buf * KBYTES + g * 4096 + wave_u * 1024));
        asm volatile("s_mov_b32 m0, %2\n\ts_nop 0\n\tglobal_load_lds_dwordx4 %0, %1" :: "v"(vo), "s"(uni_ptr(ub)), "s"(la) : "memory", "m0");
      }
      return;
    }
#pragma unroll
    for (int i = 0; i < KPW; ++i) {
      const int g = i >> 1, row = krow_l + 32 * (i & 1);
      const bf16* src;
      if (DSPLIT == DQK || g * 64 < DSPLIT) src = Kb + (size_t)(k0 + row) * p.k_ts + (8 * g + kcol_l) * 8;
      else src = K2b + (size_t)(k0 + row) * p.k2_ts + ((8 * g + kcol_l) * 8 - DSPLIT);
      __builtin_amdgcn_global_load_lds((const unsigned*)src, (LAS unsigned*)(Kbase + buf * KBYTES + g * 8192 + (wave_u + 4 * (i & 1)) * 1024), 16, 0, 0);
    }
  };
  const int vrow_l = (DV == 128) ? 4 * wave_u + (lane >> 4) : 8 * wave_u + (lane >> 3);
  const int vcol_l = (DV == 128) ? ((lane & 15) ^ (((lane >> 4) << 2) | (wave_u & 3))) : ((lane & 7) ^ (((lane >> 4) & 1) << 2));
  auto issue_v = [&](int j, int buf) {
    const int k0 = key0_of(j);
    if constexpr (FP8) {
      const unsigned char* vsrc = p.V8 + (size_t)b * p.v8_bs + (size_t)hkv * p.v8_hs + (size_t)(k0 >> 6) * (DV * 64);
      const int chunk = (lane & 3) ^ ((lane >> 4) & 3);
#pragma unroll
      for (int i = 0; i < DV / 64; ++i) {
        const int I = wave_u + 4 * i, row = 16 * I + (lane >> 2);
        const unsigned vo = (unsigned)(row * 64 + 16 * chunk);
        const unsigned la = (unsigned)__builtin_amdgcn_readfirstlane((int)(unsigned)(size_t)(LAS char*)(Vbase + buf * VBYTES + I * 1024));
        asm volatile("s_mov_b32 m0, %2\n\ts_nop 0\n\tglobal_load_lds_dwordx4 %0, %1" :: "v"(vo), "s"(uni_ptr(vsrc)), "s"(la) : "memory", "m0");
      }
      return;
    }
#pragma unroll
    for (int i = 0; i < VPW; ++i) {
      const int row = vrow_l + ((DV == 128) ? 16 : 32) * i;
      const bf16* src = Vb + (size_t)(k0 + row) * p.v_ts + vcol_l * 8;
      __builtin_amdgcn_global_load_lds((const unsigned*)src, (LAS unsigned*)(Vbase + buf * VBYTES + (wave_u + 4 * i) * 1024), 16, 0, 0);
    }
  };

  f32x16 o[NDB];
#pragma unroll
  for (int d = 0; d < NDB; ++d)
#pragma unroll
    for (int i = 0; i < 16; ++i) o[d][i] = 0.f;
  constexpr float M0 = -1000.f;
  float m = FP8 ? M0 : -1e30f, l = 0.f;
  constexpr bool LSUM = FP8;
  constexpr bool P8DIRECT = LSUM;
  float poff = 0.f;
  if constexpr (P8DIRECT) {
    unsigned cal = 0; const float c15 = 1.5f;
    asm volatile("v_cvt_pk_u8_f32 %0, %1, 0, %0" : "+v"(cal) : "v"(c15));
    poff = (cal == 1u ? 0.5f : 0.f) - 0.46f;
  }
  const float PBASE = P8DIRECT ? 8.f * (PSHIFT + 7.f) + poff : PSHIFT;
  constexpr float PMUL = P8DIRECT ? 8.f : 1.f;
  f32x16 minit;
#pragma unroll
  for (int i = 0; i < 16; ++i) minit[i] = PBASE - PMUL * M0;
  typedef float lacc_t __attribute__((ext_vector_type(4)));
  lacc_t lacc = {0.f, 0.f, 0.f, 0.f};
  i32x8 ones8;
  {
    const int aval = ((lane & 15) == ((lane >> 4) & 1)) ? 0x38383838 : 0;
#pragma unroll
    for (int i = 0; i < 8; ++i) ones8[i] = aval;
  }
  if (LSUM && DQK == 64) asm volatile("" : "+v"(ones8));
  const int i16 = lane & 15, q4 = i16 >> 2, p4 = i16 & 3, g1 = (lane >> 4) & 1;
  const int kswz = (r >> 1) & 7;

  i32x8 p8;
#pragma unroll
  for (int i = 0; i < 8; ++i) p8[i] = 0;
  __syncthreads();
  issue_k(0, 0);
  if (VBUFS == 2) issue_v(0, 0);
  for (int j = 0; j < ntiles; ++j) {
    asm volatile("s_waitcnt vmcnt(0)" ::: "memory");
    __syncthreads();
    if (VBUFS == 1) issue_v(j, 0);
    if (j + 1 < ntiles) { issue_k(j + 1, (j + 1) & 1); if (VBUFS == 2) issue_v(j + 1, (j + 1) & 1); }
    const bf16* Ks = (const bf16*)(Kbase + (j & 1) * KBYTES);
    const bf16* Vs = (const bf16*)(Vbase + (VBUFS == 2 ? (j & 1) * VBYTES : 0));

    f32x16 s[2];
    if constexpr (!FP8) {
#pragma unroll
      for (int mb = 0; mb < 2; ++mb)
#pragma unroll
        for (int i = 0; i < 16; ++i) s[mb][i] = 0.f;
    }
    if constexpr (FP8) {
      const char* K8s = Kbase + (j & 1) * KBYTES;
      const int rsw = (r >> 2) & 3;
#pragma unroll
      for (int mb = 0; mb < 2; ++mb)
#pragma unroll
        for (int kb = 0; kb < DQK / 64; ++kb) {
          const char* rowp = K8s + kb * 4096 + (mb * 32 + r) * 64;
          const u32x4 c0 = *(const u32x4*)(rowp + 16 * ((2 * h) ^ rsw)), c1 = *(const u32x4*)(rowp + 16 * ((2 * h + 1) ^ rsw));
          i32x8 a8;
          a8[0] = (int)c0[0]; a8[1] = (int)c0[1]; a8[2] = (int)c0[2]; a8[3] = (int)c0[3];
          a8[4] = (int)c1[0]; a8[5] = (int)c1[1]; a8[6] = (int)c1[2]; a8[7] = (int)c1[3];
          s[mb] = __builtin_amdgcn_mfma_scale_f32_32x32x64_f8f6f4(a8, q8[kb], kb == 0 ? minit : s[mb], 0, 0, 0, 0x7F7F7F7F, 0, P8DIRECT ? 0x7F7F7F7F : 0x7C7C7C7C);
        }
    } else {
      constexpr int GPM = NKS / 4, NG = 2 * GPM;
      bf16x8 fa[4], fb[4];
#define ATTN_KRD(F, g)                                                                                                   \
  _Pragma("unroll") for (int i = 0; i < 4; ++i) {                                                                      \
    const int c = 2 * ((((g) % GPM) * 4) + i) + h;                                                                      \
    F[i] = *(const bf16x8*)(&Ks[(c >> 3) * 4096 + (((g) / GPM) * 32 + r) * 64 + 8 * ((c ^ kswz) & 7)]);                \
  }
      ATTN_KRD(fa, 0)
#pragma unroll
      for (int g = 0; g < NG; ++g) {
        if (g + 1 < NG) { if (g & 1) { ATTN_KRD(fa, g + 1) } else { ATTN_KRD(fb, g + 1) } }
        __builtin_amdgcn_sched_barrier(0);
#pragma unroll
        for (int i = 0; i < 4; ++i) s[g / GPM] = mfma32((g & 1) ? fb[i] : fa[i], qf[(g % GPM) * 4 + i], s[g / GPM]);
        __builtin_amdgcn_sched_barrier(0);
      }
#undef ATTN_KRD
    }
    const int pos0 = lo + (j - 4) * 64;
    const int tq0 = __builtin_amdgcn_readfirstlane(q0 + wave * 32);
    const bool band = WINDOW && j >= 4 && (pos0 + 63 - tq0 > 128 || pos0 - (tq0 + 31) < -128);
    float mx = -1e30f;
#pragma unroll
    for (int mb = 0; mb < 2; ++mb)
#pragma unroll
      for (int i = 0; i < 16; ++i) {
        if (WINDOW) {
          if (band) {
            const int dlt = pos0 + mb * 32 + crow(i, h) - tq;
            if (dlt > 128 || dlt < -128) s[mb][i] = -1e30f;
          }
        }
        mx = fmaxf(mx, s[mb][i]);
      }
    if constexpr (FP8) {
      float xa = mx, xb = mx;
      asm volatile("s_nop 1\n\tv_permlane32_swap_b32 %0, %1\n\ts_nop 1" : "+v"(xa), "+v"(xb));
      mx = fmaxf(xa, xb);
    } else {
      mx = fmaxf(mx, __shfl_xor(mx, 32));
    }
    if constexpr (FP8) {
      if (__builtin_expect(__any(mx > PBASE + PMUL * THR), 0)) {
        const float dacc = fmaxf(mx - PBASE, 0.f);
        const float delta = dacc * (1.f / PMUL);
        const float alpha = __builtin_amdgcn_exp2f(-delta);
        m += delta;
        l *= alpha;
        if (LSUM) {
          lacc[0] *= alpha;
          lacc[1] *= __shfl(alpha, (lane & 15) + 16);
        }
#pragma unroll
        for (int d = 0; d < NDB; ++d)
#pragma unroll
          for (int i = 0; i < 16; ++i) o[d][i] *= alpha;
#pragma unroll
        for (int mb = 0; mb < 2; ++mb)
#pragma unroll
          for (int i = 0; i < 16; ++i) s[mb][i] -= dacc;
        {
          const float nv = PBASE - PMUL * m;
#pragma unroll
          for (int i = 0; i < 16; ++i) { float e = minit[i]; asm volatile("v_mov_b32 %0, %1" : "+v"(e) : "v"(nv)); minit[i] = e; }
        }
      }
    } else {
    mx *= p.scale_log2;
    if (__any(mx > m + THR)) {
      const float mn = fmaxf(m, mx);
      const float alpha = __builtin_amdgcn_exp2f(m - mn);
      m = mn;
      l *= alpha;
#pragma unroll
      for (int d = 0; d < NDB; ++d)
#pragma unroll
        for (int i = 0; i < 16; ++i) o[d][i] *= alpha;
    }
    }
    float ls = 0.f;
    if constexpr (!P8DIRECT) {
#pragma unroll
    for (int mb = 0; mb < 2; ++mb)
#pragma unroll
      for (int i = 0; i < 16; ++i) {
        const float ev = FP8 ? __builtin_amdgcn_exp2f(s[mb][i]) : __builtin_amdgcn_exp2f(__builtin_fmaf(s[mb][i], p.scale_log2, PSHIFT - m));
        s[mb][i] = ev;
        if (!LSUM) ls += ev;
      }
    }
    l += ls;
    bf16x8 pf[2][2];
    if constexpr (FP8) {
#pragma unroll
      for (int mb = 0; mb < 2; ++mb)
#pragma unroll
        for (int q = 0; q < 4; ++q) {
          int w = p8[4 * mb + q];
          if constexpr (P8DIRECT) {
            asm("v_cvt_pk_u8_f32 %0, %1, 0, %0" : "+v"(w) : "v"(s[mb][4 * q]));
            asm("v_cvt_pk_u8_f32 %0, %1, 1, %0" : "+v"(w) : "v"(s[mb][4 * q + 1]));
            asm("v_cvt_pk_u8_f32 %0, %1, 2, %0" : "+v"(w) : "v"(s[mb][4 * q + 2]));
            asm("v_cvt_pk_u8_f32 %0, %1, 3, %0" : "+v"(w) : "v"(s[mb][4 * q + 3]));
          } else {
            w = __builtin_amdgcn_cvt_pk_fp8_f32(s[mb][4 * q], s[mb][4 * q + 1], w, false);
            w = __builtin_amdgcn_cvt_pk_fp8_f32(s[mb][4 * q + 2], s[mb][4 * q + 3], w, true);
          }
          p8[4 * mb + q] = w;
        }
    } else {
#pragma unroll
      for (int mb = 0; mb < 2; ++mb)
#pragma unroll
        for (int s2 = 0; s2 < 2; ++s2)
#pragma unroll
          for (int jj = 0; jj < 8; ++jj) pf[mb][s2][jj] = (bf16)s[mb][8 * s2 + jj];
    }
    if (VBUFS == 1) {
      asm volatile("s_waitcnt vmcnt(0)" ::: "memory");
      __syncthreads();
    }
    if constexpr (FP8) {
      const char* V8s = Vbase + (VBUFS == 2 ? (j & 1) * VBYTES : 0);
      const int rsw = (r >> 2) & 3;
#pragma unroll
      for (int d = 0; d < NDB; ++d) {
        const char* rowp = V8s + (d * 32 + r) * 64;
        const u32x4 c0 = *(const u32x4*)(rowp + 16 * ((2 * h) ^ rsw)), c1 = *(const u32x4*)(rowp + 16 * ((2 * h + 1) ^ rsw));
        i32x8 a8;
        a8[0] = (int)c0[0]; a8[1] = (int)c0[1]; a8[2] = (int)c0[2]; a8[3] = (int)c0[3];
        a8[4] = (int)c1[0]; a8[5] = (int)c1[1]; a8[6] = (int)c1[2]; a8[7] = (int)c1[3];
        o[d] = __builtin_amdgcn_mfma_scale_f32_32x32x64_f8f6f4(a8, p8, o[d], 0, 0, 0, 0x7F7F7F7F, 0, 0x7F7F7F7F);
      }
      if (LSUM) lacc = __builtin_amdgcn_mfma_scale_f32_16x16x128_f8f6f4(ones8, p8, lacc, 0, 0, 0, 0x7F7F7F7F, 0, 0x7F7F7F7F);
    } else {
      const unsigned vbase = (unsigned)(size_t)Vs;
      bf16x4 ta[8], tb[8];
#define ATTN_VADDR(d)                                                                                                   \
      const int row0_ = 4 * h + q4;                                                                                     \
      const int ch_ = (d) * 4 + 2 * g1 + (p4 >> 1);                                                                     \
      const int f0_ = (DV == 128) ? ((q4 << 2) | ((row0_ >> 2) & 3)) : (((row0_ >> 1) & 1) << 2);                       \
      const int f1_ = (DV == 128) ? ((q4 << 2) | (((row0_ + 8) >> 2) & 3)) : ((((row0_ + 8) >> 1) & 1) << 2);           \
      const unsigned a_lo_ = vbase + (unsigned)((row0_ * DV + 8 * (ch_ ^ f0_) + 4 * (p4 & 1)) * 2);                     \
      const unsigned a_hi_ = vbase + (unsigned)(((row0_ + 8) * DV + 8 * (ch_ ^ f1_) + 4 * (p4 & 1)) * 2);
#define ATTN_VRD(T, d)                                                                                                  \
      {                                                                                                                 \
        ATTN_VADDR(d)                                                                                                   \
        asm volatile(                                                                                                   \
            "ds_read_b64_tr_b16 %0, %8\n\t"                                                                             \
            "ds_read_b64_tr_b16 %1, %9\n\t"                                                                             \
            "ds_read_b64_tr_b16 %2, %8 offset:%10\n\t"                                                                  \
            "ds_read_b64_tr_b16 %3, %9 offset:%10\n\t"                                                                  \
            "ds_read_b64_tr_b16 %4, %8 offset:%11\n\t"                                                                  \
            "ds_read_b64_tr_b16 %5, %9 offset:%11\n\t"                                                                  \
            "ds_read_b64_tr_b16 %6, %8 offset:%12\n\t"                                                                  \
            "ds_read_b64_tr_b16 %7, %9 offset:%12"                                                                      \
            : "=&v"(T[0]), "=&v"(T[1]), "=&v"(T[2]), "=&v"(T[3]), "=&v"(T[4]), "=&v"(T[5]), "=&v"(T[6]), "=&v"(T[7])    \
            : "v"(a_lo_), "v"(a_hi_), "i"(16 * DV * 2), "i"(32 * DV * 2), "i"(48 * DV * 2)                              \
            : "memory");                                                                                                \
      }
#define ATTN_VWAIT(T, N)                                                                                                \
      asm volatile("s_waitcnt lgkmcnt(" #N ")"                                                                          \
                   : "+v"(T[0]), "+v"(T[1]), "+v"(T[2]), "+v"(T[3]), "+v"(T[4]), "+v"(T[5]), "+v"(T[6]), "+v"(T[7]) : : "memory");
#define ATTN_VMMA(T, d)                                                                                                 \
      o[d] = mfma32(__builtin_shufflevector(T[0], T[1], 0, 1, 2, 3, 4, 5, 6, 7), pf[0][0], o[d]);                       \
      o[d] = mfma32(__builtin_shufflevector(T[2], T[3], 0, 1, 2, 3, 4, 5, 6, 7), pf[0][1], o[d]);                       \
      o[d] = mfma32(__builtin_shufflevector(T[4], T[5], 0, 1, 2, 3, 4, 5, 6, 7), pf[1][0], o[d]);                       \
      o[d] = mfma32(__builtin_shufflevector(T[6], T[7], 0, 1, 2, 3, 4, 5, 6, 7), pf[1][1], o[d]);
      ATTN_VRD(ta, 0)
#pragma unroll
      for (int d = 0; d < NDB; ++d) {
        if (d + 1 < NDB) {
          if (d & 1) { ATTN_VRD(ta, d + 1) ATTN_VWAIT(tb, 8) ATTN_VMMA(tb, d) }
          else       { ATTN_VRD(tb, d + 1) ATTN_VWAIT(ta, 8) ATTN_VMMA(ta, d) }
        } else {
          if (d & 1) { ATTN_VWAIT(tb, 0) ATTN_VMMA(tb, d) }
          else       { ATTN_VWAIT(ta, 0) ATTN_VMMA(ta, d) }
        }
      }
#undef ATTN_VADDR
#undef ATTN_VRD
#undef ATTN_VWAIT
#undef ATTN_VMMA
    }
  }
  float lt;
  if constexpr (LSUM) {
    const float l0 = __shfl(lacc[0], lane & 15), l1 = __shfl(lacc[1], lane & 15);
    lt = (lane & 16) ? l1 : l0;
  } else {
    lt = l + __shfl_xor(l, 32);
  }
  if (p.sink) lt += __builtin_amdgcn_exp2f(p.sink[head] * LOG2E + PSHIFT - m);
  const float inv = 1.f / lt;
  if constexpr (FP8) {
    unsigned char* op8 = (unsigned char*)p.O + (size_t)(p.o_row0 + b * p.o_bs + tq) * DM + p.o_col0 + head * DV;
    const float inv8 = inv * O8_SCALE;
#pragma unroll
    for (int d = 0; d < NDB; ++d)
#pragma unroll
      for (int g = 0; g < 4; ++g) {
        int w = 0;
        w = __builtin_amdgcn_cvt_pk_fp8_f32(o[d][4 * g] * inv8, o[d][4 * g + 1] * inv8, w, false);
        w = __builtin_amdgcn_cvt_pk_fp8_f32(o[d][4 * g + 2] * inv8, o[d][4 * g + 3] * inv8, w, true);
        *(int*)(op8 + d * 32 + 8 * g + 4 * h) = w;
      }
    return;
  }
  bf16* op = p.O + (size_t)(p.o_row0 + b * p.o_bs + tq) * DM + p.o_col0 + head * DV;
#pragma unroll
  for (int d = 0; d < NDB; ++d)
#pragma unroll
    for (int g = 0; g < 4; ++g) {
      bf16x4 ov;
#pragma unroll
      for (int jj = 0; jj < 4; ++jj) ov[jj] = (bf16)(o[d][4 * g + jj] * inv);
      *(bf16x4*)(op + d * 32 + 8 * g + 4 * h) = ov;
    }
}

struct PairTab { int i[50]; int j[50]; };
constexpr PairTab make_pairs() {
  PairTab t{}; int c = 0;
  for (int i = 0; i < 16; ++i) for (int j = 0; j < 16; ++j) if ((i + 1) * (j + 1) <= 16) { t.i[c] = i; t.j[c] = j; ++c; }
  return t;
}
constexpr PairTab PAIRS = make_pairs();
DI void peer_select_item(int tile, int hhalf, const float* __restrict__ TOP,
                         int* __restrict__ IDX, float* __restrict__ GW, char* smem) {
  unsigned (*lidx)[64][9] = (unsigned (*)[64][9])smem;
  const int tid = threadIdx.x, lane = tid & 63, wave = tid >> 6;
  const int r = lane & 31, h = lane >> 5;
  const int tok = tile * 32 + r;
  const int head = hhalf * 4 + wave;
  const float NINF = -__builtin_inff();
  float top[2][16];
#pragma unroll
  for (int p = 0; p < 2; ++p) {
    const float4* tp = (const float4*)(TOP + ((size_t)tok * 16 + head * 2 + p) * 16);
#pragma unroll
    for (int q = 0; q < 4; ++q) { const float4 t = tp[q]; top[p][4 * q] = t.x; top[p][4 * q + 1] = t.y; top[p][4 * q + 2] = t.z; top[p][4 * q + 3] = t.w; }
  }
  float c0[16], c1[16];
  {
    constexpr int LE[8] = {16, 5, 3, 2, 1, 1, 1, 1}, LO[8] = {8, 4, 2, 2, 1, 1, 1, 1};
    int n1 = 0;
#pragma unroll
    for (int ii = 0; ii < 8; ++ii) {
      const float a = h ? top[0][2 * ii + 1] : top[0][2 * ii];
#pragma unroll
      for (int j = 0; j < LE[ii]; ++j) {
        const float sum = a + top[1][j];
        float key = as_f((as_u(sum) & 0xFFFFFF00u) | (unsigned)((2 * ii) * 16 + j) | ((unsigned)h << 4));
        if (j >= LO[ii]) key = h ? NINF : key;
        if (ii == 0) c0[j] = key; else c1[n1++] = key;
      }
    }
    c1[14] = NINF; c1[15] = NINF;
  }
  sort16_desc(c1);
  top16_merge(c0, c1);
  top16_merge_partner(c0);
  float ex[16], sum = 0.f;
#pragma unroll
  for (int k = 0; k < 16; ++k) { ex[k] = __expf(c0[k] - c0[0]); sum += ex[k]; }
  const float inv = 1.f / sum;
  unsigned* my = lidx[wave][lane];
#pragma unroll
  for (int q = 0; q < 4; ++q) {
    my[q] = (as_u(top[0][4 * q]) & 0x7Fu) | ((as_u(top[0][4 * q + 1]) & 0x7Fu) << 8) | ((as_u(top[0][4 * q + 2]) & 0x7Fu) << 16) | ((as_u(top[0][4 * q + 3]) & 0x7Fu) << 24);
    my[4 + q] = (as_u(top[1][4 * q]) & 0x7Fu) | ((as_u(top[1][4 * q + 1]) & 0x7Fu) << 8) | ((as_u(top[1][4 * q + 2]) & 0x7Fu) << 16) | ((as_u(top[1][4 * q + 3]) & 0x7Fu) << 24);
  }
#pragma unroll
  for (int k = 0; k < 16; ++k) {
    const unsigned code = as_u(c0[k]) & 0xFFu;
    const unsigned i = code >> 4, j = code & 15u;
    const unsigned e0 = (my[i >> 2] >> ((i & 3u) * 8u)) & 0x7Fu;
    const unsigned e1 = (my[4 + (j >> 2)] >> ((j & 3u) * 8u)) & 0x7Fu;
    if (h == 0) {
      IDX[(size_t)tok * 128 + head * 16 + k] = (int)(e0 * 128u + e1);
      GW[(size_t)tok * 128 + head * 16 + k] = ex[k] * inv;
    }
  }
}

typedef float f32x4v __attribute__((ext_vector_type(4)));
typedef float f32x2v __attribute__((ext_vector_type(2)));
typedef __bf16 bf16x32 __attribute__((ext_vector_type(32)));
constexpr float U_SCALE = 64.f, V_SCALE = 4.f;
constexpr int EROW = 768;
DI float gelu_exact(float x) { return 0.5f * x * (1.f + erff(x * 0.70710678118654752f)); }

DI void peer_u_item(int item, const bf16* __restrict__ H2, const int* __restrict__ IDX, float* GW, const unsigned char* __restrict__ U6, char* smem) {
  unsigned char (*h6)[768] = (unsigned char (*)[768])smem;
  float (*cbuf)[128] = (float (*)[128])(smem + 4 * 768);
  int tid = threadIdx.x;
  asm volatile("" : "+v"(tid));
  const int lane = tid & 63, wave = tid >> 6;
  const int token = item * 4 + wave;
  const int col16 = lane & 15, kq = lane >> 4;
  asm volatile("" ::: "memory");
  {
    const unsigned char* hp6 = (const unsigned char*)(const void*)H2 + (size_t)token * 768;
    if (lane < 48) *(u32x4*)(&h6[wave][16 * lane]) = *(const u32x4*)(hp6 + 16 * lane);
  }
  asm volatile("s_waitcnt lgkmcnt(0)" ::: "memory");
  __builtin_amdgcn_wave_barrier();
  const int id0 = IDX[(size_t)token * 128 + lane], id1 = IDX[(size_t)token * 128 + 64 + lane];
  const float gw0 = GW[(size_t)token * 128 + lane], gw1 = GW[(size_t)token * 128 + 64 + lane];
  {
    const int wave_u = __builtin_amdgcn_readfirstlane(wave);
    char* ub = smem + 5120 + wave_u * 13824;
    const int rho = lane >> 3;
    const unsigned pc = 16u * (unsigned)((lane & 7) ^ rho);
    auto issue_group = [&](int g) {
      const int sel = g < 4 ? id0 : id1, lb = (16 * g) & 63;
      const unsigned elo = (unsigned)__shfl(sel, lb + rho), ehi = (unsigned)__shfl(sel, lb + 8 + rho);
      const unsigned vlo = elo * (unsigned)EROW + pc, vhi = ehi * (unsigned)EROW + pc;
      const unsigned ubl = (unsigned)__builtin_amdgcn_readfirstlane((int)(unsigned)(size_t)(LAS char*)ub);
#pragma unroll
      for (int line = 0; line < 6; ++line) {
        asm volatile("s_mov_b32 m0, %2\n\ts_nop 0\n\tglobal_load_lds_dwordx4 %0, %1"
                     :: "v"(vlo + 128u * line), "s"(U6), "s"(ubl + (2 * line) * 1152u) : "memory", "m0");
        asm volatile("s_mov_b32 m0, %2\n\ts_nop 0\n\tglobal_load_lds_dwordx4 %0, %1"
                     :: "v"(vhi + 128u * line), "s"(U6), "s"(ubl + (2 * line + 1) * 1152u) : "memory", "m0");
      }
    };
    issue_group(0);
    i32x8 hb[8];
#pragma unroll
    for (int st = 0; st < 8; ++st) {
      const unsigned char* hp6 = &h6[wave][24 * (4 * st + kq)];
      const u32x2 t0 = *(const u32x2*)hp6, t1 = *(const u32x2*)(hp6 + 8), t2 = *(const u32x2*)(hp6 + 16);
      hb[st][0] = (int)t0[0]; hb[st][1] = (int)t0[1]; hb[st][2] = (int)t1[0]; hb[st][3] = (int)t1[1]; hb[st][4] = (int)t2[0]; hb[st][5] = (int)t2[1];
      hb[st][6] = 0; hb[st][7] = 0;
    }
    const char* rb = ub + (col16 >> 3) * 1152 + (col16 & 7) * 128;
    const int rsw = col16 & 7;
    for (int g = 0; g < 8; ++g) {
      asm volatile("s_waitcnt vmcnt(0)" ::: "memory");
      u32x4 wbuf[12];
#pragma unroll
      for (int jj = 0; jj < 12; ++jj) wbuf[jj] = *(const u32x4*)(rb + (jj >> 1) * 2304 + 16 * ((2 * kq + (jj & 1)) ^ rsw));
      asm volatile("s_waitcnt lgkmcnt(0)" ::: "memory");
      if (g < 7) issue_group(g + 1);
      f32x4v ca = {0.f, 0.f, 0.f, 0.f}, cb = {0.f, 0.f, 0.f, 0.f};
#pragma unroll
      for (int S = 0; S < 4; ++S) {
        i32x8 a0, a1;
        a0[0] = (int)wbuf[3 * S][0]; a0[1] = (int)wbuf[3 * S][1]; a0[2] = (int)wbuf[3 * S][2]; a0[3] = (int)wbuf[3 * S][3];
        a0[4] = (int)wbuf[3 * S + 1][0]; a0[5] = (int)wbuf[3 * S + 1][1]; a0[6] = 0; a0[7] = 0;
        a1[0] = (int)wbuf[3 * S + 1][2]; a1[1] = (int)wbuf[3 * S + 1][3]; a1[2] = (int)wbuf[3 * S + 2][0]; a1[3] = (int)wbuf[3 * S + 2][1];
        a1[4] = (int)wbuf[3 * S + 2][2]; a1[5] = (int)wbuf[3 * S + 2][3]; a1[6] = 0; a1[7] = 0;
        ca = __builtin_amdgcn_mfma_scale_f32_16x16x128_f8f6f4(a0, hb[2 * S], ca, 2, 2, 0, 0x7F7F7F7F, 0, 0x7F7F7F7F);
        cb = __builtin_amdgcn_mfma_scale_f32_16x16x128_f8f6f4(a1, hb[2 * S + 1], cb, 2, 2, 0, 0x7F7F7F7F, 0, 0x7F7F7F7F);
      }
      *(f32x4v*)(&cbuf[wave][g * 16 + kq * 4]) = ca + cb;
    }
  }
  asm volatile("" ::: "memory");
  GW[(size_t)token * 128 + lane] = gelu_exact(cbuf[wave][lane] * (1.f / U_SCALE)) * gw0;
  GW[(size_t)token * 128 + 64 + lane] = gelu_exact(cbuf[wave][64 + lane] * (1.f / U_SCALE)) * gw1;
}

template <bool OUTF32>
DI void peer_v_item(int item, const int* __restrict__ IDX, const float* __restrict__ GW, const unsigned char* __restrict__ V6,
                    bf16* __restrict__ RES, float* __restrict__ out32, const float* __restrict__ modl) {
  int tid = threadIdx.x;
  asm volatile("" : "+v"(tid));
  const int lane = tid & 63, wave = tid >> 6;
  const int token = item * 4 + wave;
  const int hh = lane >> 5, c32 = lane & 31;
  const int id0 = IDX[(size_t)token * 128 + lane], id1 = IDX[(size_t)token * 128 + 64 + lane];
  const float w0 = GW[(size_t)token * 128 + lane], w1 = GW[(size_t)token * 128 + 64 + lane];
  u32x2 vbuf[8][3];
  const unsigned voff = 8u * (unsigned)c32;
  unsigned hhmask = hh ? 0xFFFFFFFFu : 0u;
  asm volatile("" : "+v"(hhmask));
#pragma unroll
  for (int p = 0; p < 8; ++p) {
    const unsigned ea = (unsigned)__builtin_amdgcn_readlane(id0, 2 * p), eb = (unsigned)__builtin_amdgcn_readlane(id0, 2 * p + 1);
    const unsigned oa = ea * (unsigned)EROW, od = eb * (unsigned)EROW - oa;
    const unsigned char* vp = V6 + ((od & hhmask) + oa + voff);
#pragma unroll
    for (int t = 0; t < 3; ++t) vbuf[p][t] = *(const u32x2*)(vp + 256 * t);
  }
  f32x2v y[16];
#pragma unroll
  for (int i = 0; i < 16; ++i) y[i] = (f32x2v){0.f, 0.f};
  for (int G2 = 0; G2 < 8; ++G2) {
    const int wsel = (int)as_u(G2 < 4 ? w0 : w1);
    const int nsel = (G2 + 1) < 4 ? id0 : id1;
    const int lb = (16 * G2) & 63, lbn = (16 * (G2 + 1)) & 63;
#pragma unroll
    for (int p = 0; p < 8; ++p) {
      const unsigned wa = (unsigned)__builtin_amdgcn_readlane(wsel, lb + 2 * p);
      const unsigned wd = wa ^ (unsigned)__builtin_amdgcn_readlane(wsel, lb + 2 * p + 1);
      const float ws = as_f(wa ^ (wd & hhmask));
      asm volatile("" : "+v"(vbuf[p][0]), "+v"(vbuf[p][1]), "+v"(vbuf[p][2]));
      u32x6 pk; pk[0] = vbuf[p][0][0]; pk[1] = vbuf[p][0][1]; pk[2] = vbuf[p][1][0]; pk[3] = vbuf[p][1][1]; pk[4] = vbuf[p][2][0]; pk[5] = vbuf[p][2][1];
      const f32x32v f = __builtin_amdgcn_cvt_scalef32_pk32_f32_fp6(pk, 1.0f);
      if (G2 < 7) {
        const unsigned ea = (unsigned)__builtin_amdgcn_readlane(nsel, lbn + 2 * p), eb = (unsigned)__builtin_amdgcn_readlane(nsel, lbn + 2 * p + 1);
        const unsigned oa = ea * (unsigned)EROW, od = eb * (unsigned)EROW - oa;
        const unsigned char* vp = V6 + ((od & hhmask) + oa + voff);
#pragma unroll
        for (int t = 0; t < 3; ++t) vbuf[p][t] = *(const u32x2*)(vp + 256 * t);
      }
      const f32x2v ws2 = {ws, ws};
#pragma unroll
      for (int i = 0; i < 16; ++i) y[i] = __builtin_elementwise_fma((f32x2v){f[2 * i], f[2 * i + 1]}, ws2, y[i]);
      asm volatile("" : "+v"(y[0]), "+v"(y[1]), "+v"(y[2]), "+v"(y[3]), "+v"(y[4]), "+v"(y[5]), "+v"(y[6]), "+v"(y[7]),
                        "+v"(y[8]), "+v"(y[9]), "+v"(y[10]), "+v"(y[11]), "+v"(y[12]), "+v"(y[13]), "+v"(y[14]), "+v"(y[15]));
      __builtin_amdgcn_sched_barrier(0);
    }
  }
  float yo[16];
#pragma unroll
  for (int j = 0; j < 8; ++j) {
    const float lo0 = y[j][0] + __shfl_xor(y[j][0], 32), lo1 = y[j][1] + __shfl_xor(y[j][1], 32);
    const float hi0 = y[8 + j][0] + __shfl_xor(y[8 + j][0], 32), hi1 = y[8 + j][1] + __shfl_xor(y[8 + j][1], 32);
    yo[2 * j] = hh ? hi0 : lo0; yo[2 * j + 1] = hh ? hi1 : lo1;
  }
  const int b = token < NLAT ? token / SEQ : 4;
  bf16* rr = RES + (size_t)token * DM;
  const float* gate = modl + (size_t)b * 6144 + 5 * 1024;
#pragma unroll
  for (int q = 0; q < 4; ++q) {
    const int col = 32 * c32 + 16 * hh + 4 * q;
    const bf16x4 rb = *(const bf16x4*)(rr + col);
    float4 xv; xv.x = (float)rb[0]; xv.y = (float)rb[1]; xv.z = (float)rb[2]; xv.w = (float)rb[3];
    const float4 gv = *(const float4*)(gate + col);
    xv.x += gv.x * yo[4 * q + 0] * (1.f / V_SCALE); xv.y += gv.y * yo[4 * q + 1] * (1.f / V_SCALE);
    xv.z += gv.z * yo[4 * q + 2] * (1.f / V_SCALE); xv.w += gv.w * yo[4 * q + 3] * (1.f / V_SCALE);
    if constexpr (OUTF32) {
      *(float4*)(out32 + (size_t)token * DM + col) = xv;
    } else {
      bf16x4 ob; ob[0] = (bf16)xv.x; ob[1] = (bf16)xv.y; ob[2] = (bf16)xv.z; ob[3] = (bf16)xv.w;
      *(bf16x4*)(rr + col) = ob;
    }
  }
}

DI void mla_post1_item(int item, bf16* __restrict__ P1, const float* __restrict__ qan, const float* __restrict__ kvan,
                       const float* __restrict__ krn, const float* __restrict__ cs, const float* __restrict__ sn,
                       bf16* __restrict__ KPE, unsigned char* __restrict__ P8) {
  const int lane = threadIdx.x & 63, wave = threadIdx.x >> 6;
  const int row = item * 4 + wave;
  bf16* pr = P1 + (size_t)row * 768;
  const bool act1 = lane < 24;
  const bf16x8 va = *(const bf16x8*)(pr + 8 * lane);
  bf16x8 vb;
#pragma unroll
  for (int j = 0; j < 8; ++j) vb[j] = (bf16)0.f;
  if (act1) vb = *(const bf16x8*)(pr + 512 + 8 * lane);
  float a[8], c[8];
  float sa = 0.f, sb = 0.f;
#pragma unroll
  for (int j = 0; j < 8; ++j) { a[j] = (float)va[j]; c[j] = (float)vb[j]; sa += a[j] * a[j]; sb += c[j] * c[j]; }
  const float ss_q = wave_sum(lane < 48 ? sa : 0.f);
  const float ss_kv = wave_sum((lane >= 48 ? sa : 0.f) + (lane < 16 ? sb : 0.f));
  const float ss_kr = wave_sum((lane >= 16 && lane < 24) ? sb : 0.f);
  {
    const float rs = lane < 48 ? rsqrtf(ss_q * (1.f / 384.f) + EPS) : rsqrtf(ss_kv * (1.f / 256.f) + EPS);
    const float* g = lane < 48 ? qan + 8 * lane : kvan + 8 * (lane - 48);
    const float4 g0 = *(const float4*)g, g1 = *(const float4*)(g + 4);
    const float y[8] = {a[0] * rs * g0.x, a[1] * rs * g0.y, a[2] * rs * g0.z, a[3] * rs * g0.w, a[4] * rs * g1.x, a[5] * rs * g1.y, a[6] * rs * g1.z, a[7] * rs * g1.w};
    *(u32x2g*)(P8 + (size_t)row * 640 + 8 * lane) = pack8_fp8(y);
  }
  if (lane < 16) {
    const float rs = rsqrtf(ss_kv * (1.f / 256.f) + EPS);
    const float* g = kvan + 128 + 8 * lane;
    const float4 g0 = *(const float4*)g, g1 = *(const float4*)(g + 4);
    const float y[8] = {c[0] * rs * g0.x, c[1] * rs * g0.y, c[2] * rs * g0.z, c[3] * rs * g0.w, c[4] * rs * g1.x, c[5] * rs * g1.y, c[6] * rs * g1.z, c[7] * rs * g1.w};
    *(u32x2g*)(P8 + (size_t)row * 640 + 512 + 8 * lane) = pack8_fp8(y);
  } else if (lane < 24) {
    const int c8 = lane - 16;
    const float rs = rsqrtf(ss_kr * (1.f / 64.f) + EPS);
    const float4 g0 = *(const float4*)(krn + 8 * c8), g1 = *(const float4*)(krn + 8 * c8 + 4);
    float y[8] = {c[0] * rs * g0.x, c[1] * rs * g0.y, c[2] * rs * g0.z, c[3] * rs * g0.w, c[4] * rs * g1.x, c[5] * rs * g1.y, c[6] * rs * g1.z, c[7] * rs * g1.w};
    int orow;
    if (row < NLAT) {
      const int b = row / SEQ, t = row % SEQ;
      const float4 cs4 = *(const float4*)(cs + t * 32 + c8 * 4), sn4 = *(const float4*)(sn + t * 32 + c8 * 4);
      float o0;
      o0 = y[0] * cs4.x - y[1] * sn4.x; y[1] = y[0] * sn4.x + y[1] * cs4.x; y[0] = o0;
      o0 = y[2] * cs4.y - y[3] * sn4.y; y[3] = y[2] * sn4.y + y[3] * cs4.y; y[2] = o0;
      o0 = y[4] * cs4.z - y[5] * sn4.z; y[5] = y[4] * sn4.z + y[5] * cs4.z; y[4] = o0;
      o0 = y[6] * cs4.w - y[7] * sn4.w; y[7] = y[6] * sn4.w + y[7] * cs4.w; y[6] = o0;
      orow = b * NKEY + NCX + t;
    } else {
      const int rc = row - NLAT;
      orow = (rc / NCX) * NKEY + (rc % NCX);
    }
    *(u32x2g*)((unsigned char*)KPE + (size_t)orow * 64 + 8 * c8) = pack8_fp8(y);
  }
}

DI void mla_qpost_item(int item, bf16* __restrict__ Q, const float* __restrict__ qnn, const float* __restrict__ qnr,
                       const float* __restrict__ cs, const float* __restrict__ sn) {
  const int lane = threadIdx.x & 63, wave = threadIdx.x >> 6;
  const int row = item * 4 + wave;
  const int t = row % SEQ;
  bf16* qr = Q + (size_t)row * 1536;
#pragma unroll
  for (int k = 0; k < 2; ++k) {
    const int head = (lane >> 4) + 4 * k, pos = lane & 15;
    bf16* qp = qr + head * 192 + pos * 8;
    const bf16x8 nv = *(const bf16x8*)qp;
    float v[8]; float ss = 0.f;
#pragma unroll
    for (int j = 0; j < 8; ++j) { v[j] = (float)nv[j]; ss += v[j] * v[j]; }
    ss += __shfl_xor(ss, 8); ss += __shfl_xor(ss, 4); ss += __shfl_xor(ss, 2); ss += __shfl_xor(ss, 1);
    const float rs = rsqrtf(ss * (1.f / 128.f) + EPS);
    const float4 g0 = *(const float4*)(qnn + pos * 8), g1 = *(const float4*)(qnn + pos * 8 + 4);
    bf16x8 ov;
    ov[0] = (bf16)(v[0] * rs * g0.x); ov[1] = (bf16)(v[1] * rs * g0.y); ov[2] = (bf16)(v[2] * rs * g0.z); ov[3] = (bf16)(v[3] * rs * g0.w);
    ov[4] = (bf16)(v[4] * rs * g1.x); ov[5] = (bf16)(v[5] * rs * g1.y); ov[6] = (bf16)(v[6] * rs * g1.z); ov[7] = (bf16)(v[7] * rs * g1.w);
    *(bf16x8*)qp = ov;
  }
  {
    const int head = lane >> 3, c8 = lane & 7;
    bf16* qp = qr + head * 192 + 128 + c8 * 8;
    const bf16x8 pv = *(const bf16x8*)qp;
    float y[8]; float ss = 0.f;
#pragma unroll
    for (int j = 0; j < 8; ++j) { y[j] = (float)pv[j]; ss += y[j] * y[j]; }
    ss += __shfl_xor(ss, 4); ss += __shfl_xor(ss, 2); ss += __shfl_xor(ss, 1);
    const float rs = rsqrtf(ss * (1.f / 64.f) + EPS);
    const float4 g0 = *(const float4*)(qnr + c8 * 8), g1 = *(const float4*)(qnr + c8 * 8 + 4);
    y[0] *= rs * g0.x; y[1] *= rs * g0.y; y[2] *= rs * g0.z; y[3] *= rs * g0.w; y[4] *= rs * g1.x; y[5] *= rs * g1.y; y[6] *= rs * g1.z; y[7] *= rs * g1.w;
    const float4 cs4 = *(const float4*)(cs + t * 32 + c8 * 4), sn4 = *(const float4*)(sn + t * 32 + c8 * 4);
    float o0;
    o0 = y[0] * cs4.x - y[1] * sn4.x; y[1] = y[0] * sn4.x + y[1] * cs4.x; y[0] = o0;
    o0 = y[2] * cs4.y - y[3] * sn4.y; y[3] = y[2] * sn4.y + y[3] * cs4.y; y[2] = o0;
    o0 = y[4] * cs4.z - y[5] * sn4.z; y[5] = y[4] * sn4.z + y[5] * cs4.z; y[4] = o0;
    o0 = y[6] * cs4.w - y[7] * sn4.w; y[7] = y[6] * sn4.w + y[7] * cs4.w; y[6] = o0;
    bf16x8 ov;
#pragma unroll
    for (int j = 0; j < 8; ++j) ov[j] = (bf16)y[j];
    *(bf16x8*)qp = ov;
  }
}

DI void mla_kpost_item(int item, bf16* __restrict__ KV, const float* __restrict__ knn) {
  const int lane = threadIdx.x & 63, wave = threadIdx.x >> 6;
  const int row = item * 4 + wave;
#pragma unroll
  for (int k = 0; k < 2; ++k) {
    const int head = (lane >> 4) + 4 * k, pos = lane & 15;
    bf16* kp = KV + (size_t)row * 2048 + head * 256 + pos * 8;
    const bf16x8 nv = *(const bf16x8*)kp;
    float v[8]; float ss = 0.f;
#pragma unroll
    for (int j = 0; j < 8; ++j) { v[j] = (float)nv[j]; ss += v[j] * v[j]; }
    ss += __shfl_xor(ss, 8); ss += __shfl_xor(ss, 4); ss += __shfl_xor(ss, 2); ss += __shfl_xor(ss, 1);
    const float rs = rsqrtf(ss * (1.f / 128.f) + EPS);
    const float4 g0 = *(const float4*)(knn + pos * 8), g1 = *(const float4*)(knn + pos * 8 + 4);
    bf16x8 ov;
    ov[0] = (bf16)(v[0] * rs * g0.x); ov[1] = (bf16)(v[1] * rs * g0.y); ov[2] = (bf16)(v[2] * rs * g0.z); ov[3] = (bf16)(v[3] * rs * g0.w);
    ov[4] = (bf16)(v[4] * rs * g1.x); ov[5] = (bf16)(v[5] * rs * g1.y); ov[6] = (bf16)(v[6] * rs * g1.z); ov[7] = (bf16)(v[7] * rs * g1.w);
    *(bf16x8*)kp = ov;
  }
}

struct MegaParams {
  const float *x, *c, *ctx, *c_ctx, *mod_w, *mod_b, *mix_norm, *ffn_norm, *even_w_in, *even_w_out, *a_q_norm, *a_k_norm, *b_q_norm,
      *b_k_norm, *b_sink, *mla_w_in, *mla_q_a_norm, *mla_kv_a_norm, *mla_w_uq, *mla_w_ukv, *mla_q_nope_norm, *mla_q_rope_norm,
      *mla_k_nope_norm, *mla_k_rope_norm, *mla_w_out, *peer_w_query, *peer_sub_keys, *peer_u, *peer_v;
  float* out;
  unsigned* bar;
  float *MOD, *RCS, *RSN, *CTXS;
  bf16* RES;
  bf16 *W_EIN, *W_EOUT, *W_PQ, *W_MIN, *W_UQ, *W_UKV, *W_MOUT, *SKB, *HA, *HB;
  unsigned char *U6, *V6;
  int* IDX;
  float* GW;
  char* R;
};

DI unsigned long long uptr64(const LAS unsigned long long* slot) {
  const unsigned long long v = *slot;
  const unsigned lo = __builtin_amdgcn_readfirstlane((unsigned)v), hi = __builtin_amdgcn_readfirstlane((unsigned)(v >> 32));
  return ((unsigned long long)hi << 32) | lo;
}
template <class T> DI T* as_global(T*, unsigned long long v) { return (T*)(__attribute__((address_space(1))) T*)v; }
#define LP(f) as_global((decltype(sp.f))nullptr, uptr64((const LAS unsigned long long*)&sp.f))

#define rP0 ((bf16*)Rb)
#define rQA ((bf16*)Rb)
#define rQB (rQA + (size_t)NB * 8 * SEQ * 64)
#define rCQA (rQB + (size_t)NB * 8 * SEQ * 64)
#define rCQB (rCQA + (size_t)NB * 8 * NCX * 64)
#define rKA (rCQB + (size_t)NB * 8 * NCX * 64)
#define rVA (rKA + (size_t)NB * 2 * NKEY * 64)
#define rKB (rVA + (size_t)NB * 2 * NKEY * 64)
#define rVB (rKB + (size_t)NB * 2 * NKEY * 64)
#define rH8 ((unsigned char*)Rb + ((size_t)136 << 20))
#define rQP ((bf16*)Rb)
#define rKPE ((bf16*)Rb)
#define rQRAW (rKPE + (size_t)NB * NKEY * 64)
#define rKVRAW ((bf16*)((char*)rQRAW + (size_t)NLAT * 1536))
#define rK8 ((unsigned char*)rQRAW + (size_t)NLAT * 1536)
#define rV8T (rK8 + (size_t)NB * NKEY * 1024)

__global__ __launch_bounds__(256, 2) void mega_kernel(MegaParams kp) {
  __shared__ __attribute__((aligned(16))) char lds_all[SMEM_BYTES + 16 + ((sizeof(MegaParams) + 15) / 16) * 16];
  char* const smem = lds_all;
  uint4& xb_words = *(uint4*)(lds_all + SMEM_BYTES);
  MegaParams& sp = *(MegaParams*)(lds_all + SMEM_BYTES + 16);
  if (threadIdx.x == 0) { xb_words = make_uint4(0u, 0u, 0u, 0u); sp = kp; }
  __syncthreads();
  XcdBarrier bar = xcd_barrier_post(LP(bar), (volatile LAS unsigned*)&xb_words);
  const int G = gridDim.x, bid = blockIdx.x;

  {
    const float *c = LP(c), *c_ctx = LP(c_ctx), *mod_w = LP(mod_w), *mod_b = LP(mod_b); float* MOD = LP(MOD);
    for (int item = bid; item < 384; item += G) mod_item(item, c, c_ctx, mod_w, mod_b, MOD, smem);
  }
  rope_phase(LP(RCS), LP(RSN));
  transpose_phase<false, true>(LP(even_w_in), LP(W_EIN), 1024, 1536, 1536, smem);
  transpose_phase<false, true>(LP(even_w_out), LP(W_EOUT), 1024, 1024, 1024, smem);
  transpose_phase<false, true>(LP(peer_w_query), LP(W_PQ), 1024, 2048, 2048, smem);
  transpose_phase<false, true>(LP(peer_w_query) + (size_t)1024 * 2048, LP(W_PQ) + (size_t)2048 * 1024, 1024, 2048, 2048, smem);
  transpose_phase<false, true>(LP(mla_w_in), LP(W_MIN), 1024, 704, 768, smem);
  transpose_phase<true, true>(LP(mla_w_uq), LP(W_UQ), 384, 1536, 1536, smem);
  transpose_phase<false, true>(LP(mla_w_ukv), LP(W_UKV), 256, 2048, 2048, smem);
  transpose_phase<false, true>(LP(mla_w_out), LP(W_MOUT), 1024, 1024, 1024, smem);
  convert_phase((const float4*)LP(peer_sub_keys), (bf16x4*)LP(SKB), (size_t)2 * 16 * 128 * 128 / 4);
  __syncthreads();
  convert_fp6_phase<false>(LP(peer_u), LP(U6), (size_t)2 * 16384 * 32, U_SCALE, smem);
  convert_fp6_phase<true>(LP(peer_v), LP(V6), (size_t)2 * 16384 * 32, V_SCALE, smem);
  xcd_barrier(bar);

  {
    const float *x = LP(x), *ctx = LP(ctx), *g = LP(mix_norm), *M = LP(MOD); bf16* H = LP(HA);
    for (int it = bid; it < NTOK / 4; it += G) norm_mod_item<1>(it, x, ctx, g, M, 0, H);
  }
  xcd_barrier(bar);
  {
    char* const Rb = LP(R);
    GemmEpi e{}; e.n0g = LP(a_q_norm); e.n1g = LP(a_k_norm); e.n2g = LP(b_q_norm); e.n3g = LP(b_k_norm); e.cs = LP(RCS); e.sn = LP(RSN);
    e.QA = rQA; e.QB = rQB; e.CQA = rCQA; e.CQB = rCQB; e.KA = rKA; e.VA = rVA; e.KB = rKB; e.VB = rVB;
    e.V8T = (unsigned char*)rQA + ((size_t)96 << 20);
    gemm_phase<EPI_QKV0, true>(LP(HA), 512, LP(W_EIN), 512, e, NTOK, 1536, smem);
  }
  xcd_barrier(bar);
  {
    char* const Rb = LP(R);
    bf16* const HBp = LP(HB);
    const float* const sinkp = LP(b_sink);
    const int xcd = bid & 7, nj = G >> 3;
    const int b = xcd >> 1, hkv = xcd & 1;
    for (int t = bid >> 3; t < 528; t += nj) {
      AttnParams a{};
      const bool isC = t >= 512;
      const bool isB = isC ? (t >= 520) : (t >= 256);
      a.q_ts = 64; a.k_ts = 64; a.v_ts = 64; a.G = 4; a.scale_log2 = 0.125f * LOG2E;
#define R8(X) ((const bf16*)((const unsigned char*)rQA + ((X) - rQA)))
      a.K = isB ? R8(rKB) : R8(rKA); a.V = nullptr;
      a.V8 = (const unsigned char*)rQA + ((size_t)96 << 20) + (isB ? (size_t)NB * 2 * (NKEY / 64) * 64 * 64 : 0);
      a.v8_bs = (long)2 * (NKEY / 64) * 64 * 64; a.v8_hs = (long)(NKEY / 64) * 64 * 64;
      a.k_bs = (long)2 * NKEY * 64; a.k_hs = (long)NKEY * 64; a.v_bs = a.k_bs; a.v_hs = a.k_hs;
      a.O = HBp; a.o_col0 = isB ? 512 : 0; a.sink = isB ? sinkp : nullptr;
      int qblk, head;
      if (!isC) {
        const int li = t & 255;
        qblk = li & 63; head = hkv * 4 + (li >> 6);
        a.Q = isB ? R8(rQB) : R8(rQA); a.q_bs = (long)8 * SEQ * 64; a.q_hs = (long)SEQ * 64;
        a.o_row0 = 0; a.o_bs = SEQ; a.nkeys = NKEY;
      } else {
        const int li = (t - 512) & 7;
        qblk = li & 1; head = hkv * 4 + (li >> 1);
        a.Q = isB ? R8(rCQB) : R8(rCQA); a.q_bs = (long)8 * NCX * 64; a.q_hs = (long)NCX * 64;
        a.o_row0 = NLAT; a.o_bs = NCX; a.nkeys = NCX;
      }
      if (isB && !isC) attn_item<64, 64, 64, 2, true, true>(a, qblk, head, b, smem);
      else attn_item<64, 64, 64, 2, false, true>(a, qblk, head, b, smem);
#undef R8
    }
  }
  xcd_barrier(bar);
  {
    GemmEpi e{}; e.RES = LP(RES); e.res16 = 0; e.res_lat = LP(x); e.res_ctx = LP(ctx); e.modl = LP(MOD); e.gchunk = 2;
    gemm_phase<EPI_RESID, true>(LP(HB), 512, LP(W_EOUT), 512, e, NTOK, 1024, smem);
  }
  xcd_barrier(bar);
  {
    const bf16* RESp = LP(RES); const float *g = LP(ffn_norm), *M = LP(MOD); unsigned char* H6 = (unsigned char*)LP(HA);
    char* const Rb = LP(R);
    for (int it = bid; it < NTOK / 4; it += G) ffn_norm_item(it, RESp, g, M, 3, rH8, H6);
  }
  xcd_barrier(bar);
  {
    char* const Rb = LP(R);
    GemmEpi e{}; e.SK = LP(SKB); e.TOP = (float*)Rb;
    gemm_phase<EPI_TOPK, true>((const bf16*)rH8, 512, LP(W_PQ), 512, e, NTOK, 2048, smem);
  }
  xcd_barrier(bar);
  {
    char* const Rb = LP(R);
    const float* TOPp = (const float*)Rb; int* IDX = LP(IDX); float* GW = LP(GW);
    for (int item = bid; item < (NTOK / 32) * 2; item += G) peer_select_item(item >> 1, item & 1, TOPp, IDX, GW, smem);
  }
  xcd_barrier(bar);
  {
    const bf16* H = LP(HA); const int* IDX = LP(IDX); const float* GW = LP(GW); const unsigned char *U8 = LP(U6), *V8 = LP(V6);
    bf16* RESp = LP(RES); const float* M = LP(MOD);
    for (int item = bid; item < NTOK / 4; item += G) peer_u_item(item, H, IDX, (float*)GW, U8, smem);
  }
  xcd_barrier(bar);
  {
    const int* IDX = LP(IDX); const float* GW = LP(GW); const unsigned char* V8 = LP(V6); bf16* RESp = LP(RES); const float* M = LP(MOD);
    for (int item = bid; item < NTOK / 4; item += G) peer_v_item<false>(item, IDX, GW, V8, RESp, nullptr, M);
  }
  xcd_barrier(bar);

  {
    const float *x = (const float*)(const void*)LP(RES), *ctx = nullptr, *g = LP(mix_norm) + 1024, *M = LP(MOD) + 5 * 6144; bf16* H = LP(HA);
    for (int it = bid; it < NTOK / 4; it += G) norm_mod_item<1>(it, x, ctx, g, M, 0, H);
  }
  xcd_barrier(bar);
  {
    GemmEpi e{}; e.Cb = LP(HB); e.ldc = 768;
    gemm_phase<EPI_BF16, true>(LP(HA), 512, LP(W_MIN), 512, e, NTOK, 768, smem);
  }
  xcd_barrier(bar);
  {
    char* const Rb = LP(R);
    bf16* P1 = LP(HB); const float *qa = LP(mla_q_a_norm), *kva = LP(mla_kv_a_norm), *krn = LP(mla_k_rope_norm), *cs = LP(RCS), *sn = LP(RSN);
    bf16* KPEp = rKPE;
    unsigned char* P8 = (unsigned char*)LP(HA) + ((size_t)40 << 20);
    for (int it = bid; it < NTOK / 4; it += G) mla_post1_item(it, P1, qa, kva, krn, cs, sn, KPEp, P8);
  }
  xcd_barrier(bar);
  {
    char* const Rb = LP(R);
    GemmEpi e{}; e.C8 = (unsigned char*)rQRAW; e.ldc = 1536; e.n0g = LP(mla_q_nope_norm); e.n1g = LP(mla_q_rope_norm); e.cs = LP(RCS); e.sn = LP(RSN);
    const bf16* P8 = (const bf16*)((unsigned char*)LP(HA) + ((size_t)40 << 20));
    gemm_phase<EPI_MLAQ, true>(P8, 320, LP(W_UQ), 192, e, NLAT, 1536, smem);
    GemmEpi e2{}; e2.C8 = rK8; e2.V8T = rV8T; e2.ldc = 2048; e2.n0g = LP(mla_k_nope_norm);
    gemm_phase<EPI_MLAKV, true>(P8 + 192, 320, LP(W_UKV), 128, e2, NTOK, 2048, smem);
  }
  xcd_barrier(bar);
  {
    char* const Rb = LP(R);
    AttnParams a{}; a.Q = rQRAW; a.q_bs = (long)SEQ * 1536; a.q_hs = 128; a.q_ts = 1536; a.q2_off = 1024; a.q2_hs = 64;
    a.K = (const bf16*)rK8; a.k_bs = (long)NKEY * 1024; a.k_hs = 128; a.k_ts = 1024;
    a.K2 = rKPE; a.k2_bs = (long)NKEY * 64; a.k2_ts = 64;
    a.V = nullptr; a.V8 = rV8T; a.v8_bs = (long)8 * (NKEY / 64) * 128 * 64; a.v8_hs = (long)(NKEY / 64) * 128 * 64;
    a.O = LP(HA); a.o_row0 = 0; a.o_bs = SEQ; a.o_col0 = 0; a.sink = nullptr; a.nkeys = NKEY; a.G = 1; a.window = 0;
    a.scale_log2 = 0.07216878364870322f * LOG2E;
    const int xcd = bid & 7, nj = G >> 3;
    for (int t = bid >> 3; t < 256; t += nj) {
      const int bh = (t >> 6) * 8 + xcd;
      attn_item<192, 128, 128, 2, false, true>(a, t & 63, bh & 7, bh >> 3, smem);
    }
  }
  xcd_barrier(bar);
  {
    GemmEpi e{}; e.RES = LP(RES); e.res16 = 1; e.res_lat = nullptr; e.res_ctx = nullptr; e.modl = LP(MOD) + 5 * 6144; e.gchunk = 2;
    gemm_phase<EPI_RESID, true>(LP(HA), 512, LP(W_MOUT), 512, e, NLAT, 1024, smem);
  }
  xcd_barrier(bar);
  {
    const bf16* RESp = LP(RES); const float *g = LP(ffn_norm) + 1024, *M = LP(MOD) + 5 * 6144; unsigned char* H6 = (unsigned char*)LP(HB);
    char* const Rb = LP(R);
    for (int it = bid; it < NLAT / 4; it += G) ffn_norm_item(it, RESp, g, M, 3, rH8, H6);
  }
  xcd_barrier(bar);
  {
    char* const Rb = LP(R);
    GemmEpi e{}; e.SK = LP(SKB) + (size_t)16 * 128 * 128; e.TOP = (float*)Rb;
    gemm_phase<EPI_TOPK, true>((const bf16*)rH8, 512, LP(W_PQ) + (size_t)2048 * 1024, 512, e, NLAT, 2048, smem);
  }
  xcd_barrier(bar);
  {
    char* const Rb = LP(R);
    const float* TOPp = (const float*)Rb; int* IDX = LP(IDX); float* GW = LP(GW);
    for (int item = bid; item < (NLAT / 32) * 2; item += G) peer_select_item(item >> 1, item & 1, TOPp, IDX, GW, smem);
  }
  xcd_barrier(bar);
  {
    const bf16* H = LP(HB); const int* IDX = LP(IDX); const float* GW = LP(GW);
    const unsigned char *U8 = LP(U6) + (size_t)16384 * EROW, *V8 = LP(V6) + (size_t)16384 * EROW;
    bf16* RESp = LP(RES); float* xo = LP(out); const float* M = LP(MOD) + 5 * 6144;
    for (int item = bid; item < NLAT / 4; item += G) peer_u_item(item, H, IDX, (float*)GW, U8, smem);
  }
  xcd_barrier(bar);
  {
    const int* IDX = LP(IDX); const float* GW = LP(GW); const unsigned char* V8 = LP(V6) + (size_t)16384 * EROW; bf16* RESp = LP(RES); float* xo = LP(out);
    const float* M = LP(MOD) + 5 * 6144;
    for (int item = bid; item < NLAT / 4; item += G) peer_v_item<true>(item, IDX, GW, V8, RESp, xo, M);
  }
}

static inline size_t align_up(size_t v, size_t a) { return (v + a - 1) / a * a; }

extern "C" void kernel_launch(void* const* d_in, const int* in_sizes, int n_in,
                              void* d_out, int out_size, void* d_ws, size_t ws_size,
                              hipStream_t stream) {
  MegaParams p{};
  const float** fp = (const float**)&p;
  for (int i = 0; i < 29; ++i) fp[i] = (const float*)d_in[i];
  p.out = (float*)d_out;
  char* w = (char*)d_ws;
  size_t off = 0;
  auto take = [&](size_t bytes) { char* q = w + off; off = align_up(off + bytes, 256); return q; };
  p.bar = (unsigned*)take(XCD_BAR_WORDS * 4);
  p.MOD = (float*)take(2 * 5 * 6144 * 4);
  p.RCS = (float*)take((size_t)SEQ * 32 * 4);
  p.RSN = (float*)take((size_t)SEQ * 32 * 4);
  p.CTXS = (float*)take((size_t)NCTXT * DM * 4);
  p.W_EIN = (bf16*)take((size_t)1536 * 1024 * 2);
  p.W_EOUT = (bf16*)take((size_t)1024 * 1024 * 2);
  p.W_PQ = (bf16*)take((size_t)2 * 2048 * 1024 * 2);
  p.W_MIN = (bf16*)take((size_t)768 * 1024 * 2);
  p.W_UQ = (bf16*)take((size_t)1536 * 384 * 2);
  p.W_UKV = (bf16*)take((size_t)2048 * 256 * 2);
  p.W_MOUT = (bf16*)take((size_t)1024 * 1024 * 2);
  p.SKB = (bf16*)take((size_t)2 * 16 * 128 * 128 * 2);
  p.HA = (bf16*)take((size_t)NTOK * DM * 2);
  p.HB = (bf16*)take((size_t)NTOK * DM * 2);
  p.U6 = (unsigned char*)take((size_t)2 * 16384 * EROW);
  p.V6 = (unsigned char*)take((size_t)2 * 16384 * EROW);
  p.IDX = (int*)take((size_t)NTOK * 128 * 4);
  p.GW = (float*)take((size_t)NTOK * 128 * 4);
  p.R = take((size_t)176 * 1024 * 1024);
  p.RES = (bf16*)take((size_t)NTOK * DM * 2);

  static int grid = 0;
  if (!grid) {
    int dev = 0, cus = 0, per_cu = 0;
    hipGetDevice(&dev);
    hipDeviceGetAttribute(&cus, hipDeviceAttributeMultiprocessorCount, dev);
    hipOccupancyMaxActiveBlocksPerMultiprocessor(&per_cu, mega_kernel, 256, 0);
    if (per_cu > 2) per_cu = 2;
    if (per_cu < 1) per_cu = 1;
    grid = cus * per_cu;
  }
  hipMemsetAsync(p.bar, 0, XCD_BAR_WORDS * 4, stream);
  mega_kernel<<<grid, 256, 0, stream>>>(p);
}
```
